# Optimizing an MI355X kernel written in HIP

```python
import math
import jax, jax.numpy as jnp
from jax import lax
import numpy as np

D_MODEL = 2048
BATCH = 4
SEQ = 4096
DEPTH = 1
DEC_BATCH = 2
DEC_SEQ = 8192
PAST_LEN = 128

N_MEM = 256
DA_HEADS = 8
DA_DIM = 128
DA_V = 2 * DA_DIM
DA_QK_W = DA_HEADS * 2 * DA_DIM
DA_V_W = DA_HEADS * DA_V
Q_BLOCK = 128
GDN_HEADS = 16
GDN_DK = 128
GDN_DV = 128
GDN_W = GDN_HEADS * GDN_DK
GDN_CONV = 5
GDN_CHUNK = 64
XA_HEADS = 4
XA_DIM = 128
XA_W = XA_HEADS * XA_DIM
D_FF = 5632
FFN_CONV = 3
N_BRANCH = 3
EPS = 1e-6
IN_SPLITS = (DA_QK_W, DA_QK_W, DA_V_W, 3 * GDN_W, GDN_W, 4 * GDN_HEADS, XA_W, N_BRANCH * D_MODEL)
W_IN = DA_QK_W + DA_QK_W + DA_V_W + 3 * GDN_W + GDN_W + 4 * GDN_HEADS + XA_W + N_BRANCH * D_MODEL

kernel_name = "hybrid_diffattn_gdn_encoder"


def rmsnorm(x, g):
    xf = x.astype(jnp.float32)
    y = xf * lax.rsqrt(jnp.mean(xf * xf, axis=-1, keepdims=True) + EPS)
    return (y * g.astype(jnp.float32)).astype(x.dtype)


def l2norm(x):
    xf = x.astype(jnp.float32)
    return xf * lax.rsqrt(jnp.sum(xf * xf, axis=-1, keepdims=True) + EPS)


def centred_dwconv(x, w, b):
    K = w.shape[0]
    p = K // 2
    S = x.shape[1]
    xp = jnp.pad(x, ((0, 0), (p, p), (0, 0)))
    out = xp[:, 0:S] * w[0]
    for j in range(1, K):
        out = out + xp[:, j:j + S] * w[j]
    if b is not None:
        out = out + b
    return out


def alibi_slopes(n):
    return jnp.asarray([2.0 ** (-8.0 * (h + 1) / n) for h in range(n)], dtype=jnp.float32)


def diff_attention(q, k, v, lam, slopes):
    B, S = q.shape[0], q.shape[1]
    nb = S // Q_BLOCK
    scale = DA_DIM ** -0.5
    kpos = jnp.arange(S, dtype=jnp.float32)
    qb = q.reshape(B, nb, Q_BLOCK, DA_HEADS, 2, DA_DIM).transpose(1, 0, 2, 3, 4, 5)

    def block(args):
        qi, i = args
        s = jnp.einsum('bqhmd,bkhmd->bhmqk', qi, k, preferred_element_type=jnp.float32) * scale
        qpos = (i * Q_BLOCK + jnp.arange(Q_BLOCK)).astype(jnp.float32)
        bias = -slopes[:, None, None, None] * jnp.abs(qpos[:, None] - kpos[None, :])
        p = jax.nn.softmax(s + bias, axis=-1)
        wts = p[:, :, 0] - lam * p[:, :, 1]
        return jnp.einsum('bhqk,bkhe->bqhe', wts.astype(v.dtype), v)

    out = lax.map(block, (qb, jnp.arange(nb)))
    return out.transpose(1, 0, 2, 3, 4).reshape(B, S, DA_HEADS, DA_V)


def gated_delta_chunked(q, k, v, g, beta):
    B, S, H, DK = q.shape
    DV = v.shape[-1]
    C = GDN_CHUNK
    N = S // C
    q = q.reshape(B, N, C, H, DK).transpose(0, 1, 3, 2, 4)
    k = k.reshape(B, N, C, H, DK).transpose(0, 1, 3, 2, 4)
    v = v.reshape(B, N, C, H, DV).transpose(0, 1, 3, 2, 4)
    g = jnp.cumsum(g.reshape(B, N, C, H).transpose(0, 1, 3, 2), axis=-1)
    beta = beta.reshape(B, N, C, H).transpose(0, 1, 3, 2)
    causal = jnp.tril(jnp.ones((C, C), dtype=bool))
    strict = jnp.tril(jnp.ones((C, C), dtype=bool), -1)
    decay = jnp.exp(jnp.where(causal, g[..., :, None] - g[..., None, :], -jnp.inf))
    kb = k * beta[..., None]
    lmat = jnp.where(strict, jnp.einsum('bnhcd,bnhed->bnhce', kb, k) * decay, 0.0)
    amat = lmat + jnp.eye(C, dtype=jnp.float32)
    rhs = jnp.concatenate([v * beta[..., None], kb * jnp.exp(g)[..., None]], axis=-1)
    sol = lax.linalg.triangular_solve(amat, rhs, left_side=True, lower=True, unit_diagonal=True)
    u = sol[..., :DV]
    w = sol[..., DV:]
    qk = jnp.where(causal, jnp.einsum('bnhcd,bnhed->bnhce', q, k) * decay, 0.0)
    q_dec = q * jnp.exp(g)[..., None]
    g_last = g[..., -1]
    k_dec = k * jnp.exp(g_last[..., None] - g)[..., None]

    def step(state, xs):
        qk_i, qd_i, u_i, w_i, kd_i, gl_i = xs
        v_new = u_i - jnp.einsum('bhcd,bhde->bhce', w_i, state)
        o = jnp.einsum('bhcd,bhde->bhce', qd_i, state) + jnp.einsum('bhce,bhef->bhcf', qk_i, v_new)
        state = state * jnp.exp(gl_i)[..., None, None] + jnp.einsum('bhcd,bhce->bhde', kd_i, v_new)
        return state, o

    xs = tuple(jnp.moveaxis(t, 1, 0) for t in (qk, q_dec, u, w, k_dec, g_last))
    state0 = jnp.zeros((B, H, DK, DV), jnp.float32)
    _, o = lax.scan(step, state0, xs)
    return o.transpose(1, 0, 3, 2, 4).reshape(B, S, H, DV)


def memory_attention(q, mem_n, w_mem_kv, q_norm, k_norm):
    B, M = mem_n.shape[0], mem_n.shape[1]
    kv = mem_n @ w_mem_kv
    mk, mv = jnp.split(kv, 2, axis=-1)
    mk = rmsnorm(mk.reshape(B, M, XA_HEADS, XA_DIM), k_norm)
    mv = mv.reshape(B, M, XA_HEADS, XA_DIM)
    q = rmsnorm(q, q_norm)
    s = jnp.einsum('bshd,bmhd->bhsm', q, mk, preferred_element_type=jnp.float32) * (XA_DIM ** -0.5)
    p = jax.nn.softmax(s, axis=-1)
    o = jnp.einsum('bhsm,bmhd->bshd', p.astype(mv.dtype), mv)
    return o.reshape(q.shape[0], q.shape[1], XA_W)


def encoder_layer(x, mem, lambda_init, g_mix, g_mem, w_in, b_gate, da_q_norm, da_k_norm, da_lambda,
                  da_subln, gdn_conv_w, gdn_A_log, gdn_dt_bias, gdn_out_norm, xa_q_norm, xa_k_norm,
                  w_mem_kv, p_attn, p_gdn, p_mem, w_o, g_ffn, w_up, ffn_conv_w, ffn_conv_b, w_down):
    f32 = jnp.float32
    B, S, _ = x.shape
    h = rmsnorm(x, g_mix)
    proj = h @ w_in
    idx = [int(i) for i in np.cumsum(IN_SPLITS)[:-1]]
    da_q, da_k, da_v, gdn_qkv, gdn_z, gdn_ab, xa_q, gate_logit = jnp.split(proj, idx, axis=-1)
    gates = jax.nn.sigmoid((gate_logit + b_gate).astype(f32)).astype(x.dtype)
    gates = gates.reshape(B, S, N_BRANCH, D_MODEL)

    q = rmsnorm(da_q.reshape(B, S, DA_HEADS, 2, DA_DIM), da_q_norm)
    k = rmsnorm(da_k.reshape(B, S, DA_HEADS, 2, DA_DIM), da_k_norm)
    v = da_v.reshape(B, S, DA_HEADS, DA_V)
    lp = da_lambda.astype(f32)
    lam = jnp.exp(jnp.sum(lp[0] * lp[1])) - jnp.exp(jnp.sum(lp[2] * lp[3])) + lambda_init
    o = diff_attention(q, k, v, lam, alibi_slopes(DA_HEADS))
    a_out = (rmsnorm(o, da_subln) * (1.0 - lambda_init)).reshape(B, S, DA_V_W)

    qkv = jax.nn.silu(centred_dwconv(gdn_qkv, gdn_conv_w, None))
    gq, gk, gv = jnp.split(qkv, 3, axis=-1)
    gq = l2norm(gq.reshape(B, S, GDN_HEADS, GDN_DK)) * (GDN_DK ** -0.5)
    gk = l2norm(gk.reshape(B, S, GDN_HEADS, GDN_DK))
    gv = gv.reshape(B, S, GDN_HEADS, GDN_DV).astype(f32)
    ab = gdn_ab.astype(f32).reshape(B, S, 4, GDN_HEADS)
    beta = jax.nn.sigmoid(ab[:, :, 0:2])
    g = -jnp.exp(gdn_A_log.astype(f32)) * jax.nn.softplus(ab[:, :, 2:4] + gdn_dt_bias.astype(f32))
    o_f = gated_delta_chunked(gq, gk, gv, g[:, :, 0], beta[:, :, 0])
    o_b = jnp.flip(gated_delta_chunked(jnp.flip(gq, 1), jnp.flip(gk, 1), jnp.flip(gv, 1),
                                       jnp.flip(g[:, :, 1], 1), jnp.flip(beta[:, :, 1], 1)), 1)
    od = rmsnorm(o_f + o_b, gdn_out_norm) * jax.nn.silu(gdn_z.reshape(B, S, GDN_HEADS, GDN_DV).astype(f32))
    d_out = od.reshape(B, S, GDN_W).astype(x.dtype)

    c_out = memory_attention(xa_q.reshape(B, S, XA_HEADS, XA_DIM), rmsnorm(mem, g_mem), w_mem_kv,
                             xa_q_norm, xa_k_norm)

    merged = (gates[:, :, 0] * (a_out @ p_attn) + gates[:, :, 1] * (d_out @ p_gdn)
              + gates[:, :, 2] * (c_out @ p_mem))
    x = x + merged @ w_o

    h2 = rmsnorm(x, g_ffn)
    gt, up = jnp.split(h2 @ w_up, 2, axis=-1)
    gt = centred_dwconv(gt, ffn_conv_w, ffn_conv_b)
    x = x + (jax.nn.silu(gt) * up) @ w_down
    return x


def run_trunk(x, mem, g_mix, g_mem, w_in, b_gate, da_q_norm, da_k_norm, da_lambda, da_subln,
              gdn_conv_w, gdn_A_log, gdn_dt_bias, gdn_out_norm, xa_q_norm, xa_k_norm, w_mem_kv,
              p_attn, p_gdn, p_mem, w_o, g_ffn, w_up, ffn_conv_w, ffn_conv_b, w_down):
    for l in range(DEPTH):
        lambda_init = 0.8 - 0.6 * math.exp(-0.3 * l)
        x = encoder_layer(x, mem, lambda_init, g_mix[l], g_mem[l], w_in[l], b_gate[l], da_q_norm[l],
                          da_k_norm[l], da_lambda[l], da_subln[l], gdn_conv_w[l], gdn_A_log[l],
                          gdn_dt_bias[l], gdn_out_norm[l], xa_q_norm[l], xa_k_norm[l], w_mem_kv[l],
                          p_attn[l], p_gdn[l], p_mem[l], w_o[l], g_ffn[l], w_up[l], ffn_conv_w[l],
                          ffn_conv_b[l], w_down[l])
    return x


def setup_inputs(seed: int = 0) -> dict:
    key = jax.random.key(seed)
    ks = jax.random.split(key, 32)
    f32 = jnp.float32
    L = DEPTH

    def nrm(k, shape, scale):
        return jax.random.normal(k, shape, f32) * scale

    def gain(k, shape):
        return 1.0 + 0.01 * jax.random.normal(k, shape, f32)

    dt = jnp.exp(jax.random.uniform(ks[10], (L, 2, GDN_HEADS), f32, math.log(1e-3), math.log(1e-1)))
    return {
        'x_prompt': nrm(ks[0], (BATCH, SEQ, D_MODEL), 1.0),
        'x_sample': nrm(ks[1], (DEC_BATCH, DEC_SEQ, D_MODEL), 1.0),
        'mem_prompt': nrm(ks[2], (BATCH, N_MEM, D_MODEL), 1.0),
        'mem_sample': nrm(ks[3], (DEC_BATCH, N_MEM, D_MODEL), 1.0),
        'g_mix': gain(ks[4], (L, D_MODEL)),
        'g_mem': gain(ks[5], (L, D_MODEL)),
        'w_in': nrm(ks[6], (L, D_MODEL, W_IN), D_MODEL ** -0.5),
        'b_gate': nrm(ks[7], (L, N_BRANCH * D_MODEL), 0.01),
        'da_q_norm': gain(ks[8], (L, DA_DIM)),
        'da_k_norm': gain(ks[9], (L, DA_DIM)),
        'da_lambda': nrm(ks[11], (L, 4, DA_DIM), 0.1),
        'da_subln': gain(ks[12], (L, DA_V)),
        'gdn_conv_w': nrm(ks[13], (L, GDN_CONV, 3 * GDN_W), GDN_CONV ** -0.5),
        'gdn_A_log': jnp.log(jax.random.uniform(ks[14], (L, 2, GDN_HEADS), f32, 1.0, 16.0)),
        'gdn_dt_bias': dt + jnp.log(-jnp.expm1(-dt)),
        'gdn_out_norm': gain(ks[15], (L, GDN_DV)),
        'xa_q_norm': gain(ks[16], (L, XA_DIM)),
        'xa_k_norm': gain(ks[17], (L, XA_DIM)),
        'w_mem_kv': nrm(ks[18], (L, D_MODEL, 2 * XA_W), D_MODEL ** -0.5),
        'p_attn': nrm(ks[19], (L, DA_V_W, D_MODEL), DA_V_W ** -0.5),
        'p_gdn': nrm(ks[20], (L, GDN_W, D_MODEL), GDN_W ** -0.5),
        'p_mem': nrm(ks[21], (L, XA_W, D_MODEL), XA_W ** -0.5),
        'w_o': nrm(ks[22], (L, D_MODEL, D_MODEL), D_MODEL ** -0.5),
        'g_ffn': gain(ks[23], (L, D_MODEL)),
        'w_up': nrm(ks[24], (L, D_MODEL, 2 * D_FF), D_MODEL ** -0.5),
        'ffn_conv_w': nrm(ks[25], (L, FFN_CONV, D_FF), FFN_CONV ** -0.5),
        'ffn_conv_b': nrm(ks[26], (L, D_FF), 0.01),
        'w_down': nrm(ks[27], (L, D_FF, D_MODEL), D_FF ** -0.5),
    }


def reference(x_prompt, x_sample, mem_prompt, mem_sample, g_mix, g_mem, w_in, b_gate, da_q_norm,
              da_k_norm, da_lambda, da_subln, gdn_conv_w, gdn_A_log, gdn_dt_bias, gdn_out_norm,
              xa_q_norm, xa_k_norm, w_mem_kv, p_attn, p_gdn, p_mem, w_o, g_ffn, w_up, ffn_conv_w,
              ffn_conv_b, w_down):
    y_prompt = run_trunk(x_prompt, mem_prompt, g_mix, g_mem, w_in, b_gate, da_q_norm, da_k_norm,
                         da_lambda, da_subln, gdn_conv_w, gdn_A_log, gdn_dt_bias, gdn_out_norm,
                         xa_q_norm, xa_k_norm, w_mem_kv, p_attn, p_gdn, p_mem, w_o, g_ffn, w_up,
                         ffn_conv_w, ffn_conv_b, w_down)
    y_sample = run_trunk(x_sample, mem_sample, g_mix, g_mem, w_in, b_gate, da_q_norm, da_k_norm,
                         da_lambda, da_subln, gdn_conv_w, gdn_A_log, gdn_dt_bias, gdn_out_norm,
                         xa_q_norm, xa_k_norm, w_mem_kv, p_attn, p_gdn, p_mem, w_o, g_ffn, w_up,
                         ffn_conv_w, ffn_conv_b, w_down)
    return (y_prompt, y_sample)
```

```cpp
#include <hip/hip_runtime.h>
#include <hip/hip_cooperative_groups.h>
#include <cstdio>
#include <cstdint>
namespace cg = cooperative_groups;

namespace pg8 {
#define PG8_LAS __attribute__((address_space(3)))
typedef unsigned short bf16_t;
typedef short bf16x8 __attribute__((ext_vector_type(8)));
typedef float f32x4 __attribute__((ext_vector_type(4)));
typedef unsigned u32x4 __attribute__((ext_vector_type(4)));
constexpr int BM = 256, BK = 64, HALF = 128, HTB = HALF * BK * 2  , STAGE_BYTES = 8 * HTB, NXCD = 8, WGM = 8;

__host__ __device__ __forceinline__ int lds_byte(int r, int c) { const int st = (r >> 4) * 2 + (c >> 5), rr = r & 15, cc = c & 31, ob = rr * 64 + cc * 2; return st * 1024 + (ob ^ (((ob >> 9) & 1) << 5)); }
__host__ __device__ __forceinline__ void stage_rc(int b, int& R, int& C) { const int st = b / 1024, sb = b % 1024, swz = sb ^ (((sb >> 9) & 1) << 5); R = (st >> 1) * 16 + swz / 64; C = (st & 1) * 32 + (swz % 64) / 2; }
__host__ __device__ __forceinline__ int perm32(int rho) { const int n = rho >> 4, i = rho & 15; return 8 * (i >> 2) + 4 * n + (i & 3); }

struct Unit { int pm, pn; };
struct Gemm { const bf16_t* A; const bf16_t* Bt; int M, N, K; };

struct StaticOrder {
    int nM, nN, nwg, G, c;
    __host__ __device__ void init(int M, int N, int G_, int c_) { nM = M / BM; nN = N / BM; nwg = nM * nN; G = G_; c = c_; }
    __host__ __device__ bool next(int i, Unit& u) const {
        const long L = (long)i * G + c; if (L >= nwg) return false;
        int wgid = (int)L; { const int q = nwg / NXCD, r = nwg % NXCD, xcd = wgid % NXCD, off = wgid / NXCD; wgid = (xcd < r ? xcd * (q + 1) : r * (q + 1) + (xcd - r) * q) + off; }
        const int nig = WGM * nN, gid = wgid / nig, fm = gid * WGM, gsz = (nM - fm) < WGM ? (nM - fm) : WGM;
        u.pm = fm + ((wgid % nig) % gsz); u.pn = (wgid % nig) / gsz; return true;
    }
    __device__ __forceinline__ void a_ready(const Unit&) const {}
    __device__ __forceinline__ void done(const Unit&) const {}
};

typedef float f32x2_cv __attribute__((ext_vector_type(2))); typedef __bf16 bf16x2_cv __attribute__((ext_vector_type(2)));
__device__ __forceinline__ unsigned cvt_pk_bf16(float lo, float hi) { f32x2_cv v = {lo, hi}; bf16x2_cv b = __builtin_convertvector(v, bf16x2_cv); return __builtin_bit_cast(unsigned, b); }
template <class F> struct EpiRow8 {
    static constexpr bool PERM = true, AFTER_DRAIN = false; F f;
    __device__ __forceinline__ void operator()(const f32x4 (&acc)[2][2][4][2], const Unit& u, int wr, int wc, int fr, int fq) const {
        const int row0 = u.pm * BM + wr * 64 + fr, col0 = u.pn * BM + wc * 32 + 8 * fq;
#pragma unroll
        for (int ai = 0; ai < 2; ++ai)
#pragma unroll
            for (int m = 0; m < 4; ++m)
#pragma unroll
                for (int bj = 0; bj < 2; ++bj) f(row0 + ai * HALF + m * 16, col0 + bj * HALF, acc[ai][bj][m][0], acc[ai][bj][m][1]);
    }
};
template <class Epi, class Sched, bool ALIGN_EPI = false, bool SP2 = false>
__device__ __forceinline__ void gemm_phase(PG8_LAS unsigned char* lds, const Gemm g, const Sched& S, const Epi& E) {
    int tid_ = threadIdx.x; asm volatile("" : "+v"(tid_));
    const int tid = tid_, wid = __builtin_amdgcn_readfirstlane(tid >> 6), lane = tid & 63, wr = wid >> 2, wc = wid & 3, fr = lane & 15, fq = lane >> 4;
    const int K = g.K, nt = K / BK;
    unsigned voffA[2], voffB[2];
#pragma unroll
    for (int i = 0; i < 2; ++i) { int R, C; stage_rc(tid * 16 + i * 8192, R, C); const int Rb = Epi::PERM ? ((R & ~31) + perm32(R & 31)) : R;
        voffA[i] = (unsigned)(R * K + C) * 2u; voffB[i] = (unsigned)(Rb * K + C) * 2u; }
    const size_t kstep = (size_t)(BK * 2);
    const size_t hstep = (size_t)HALF * K * 2;
    const size_t tstep = 2 * hstep;
    const unsigned ldsw = (unsigned)wid * 1024u;
    const int aoff = lds_byte(wr * 64 + fr, fq * 8), boff = lds_byte(wc * 32 + fr, fq * 8);
#define PG8_SA(b, h) (((b) * 2 + (h)) * HTB)
#define PG8_SB(b, h) ((4 + (b) * 2 + (h)) * HTB)
#define PG8_STAGE(bufoff, gbase, voff) do { _Pragma("unroll") for (int _i = 0; _i < 2; ++_i) \
        __builtin_amdgcn_global_load_lds((const unsigned*)((const char*)(gbase) + (voff)[_i]), (PG8_LAS unsigned*)(lds + (bufoff) + ldsw + _i * 8192), 16, 0, 0); } while (0)
#define PG8_LDA(dst, b, h) do { _Pragma("unroll") for (int m = 0; m < 4; ++m) _Pragma("unroll") for (int k = 0; k < 2; ++k) dst[m][k] = *(const PG8_LAS bf16x8*)(lds + PG8_SA(b, h) + aoff + m * 2048 + k * 1024); } while (0)
#define PG8_LDB(dst, b, h) do { _Pragma("unroll") for (int n = 0; n < 2; ++n) _Pragma("unroll") for (int k = 0; k < 2; ++k) dst[n][k] = *(const PG8_LAS bf16x8*)(lds + PG8_SB(b, h) + boff + n * 2048 + k * 1024); } while (0)
#define PG8_MMA(ai, bj, At, Bt) do { __builtin_amdgcn_s_setprio(1); _Pragma("unroll") for (int m = 0; m < 4; ++m) _Pragma("unroll") for (int n = 0; n < 2; ++n) _Pragma("unroll") for (int k = 0; k < 2; ++k) \
        acc[ai][bj][m][n] = __builtin_amdgcn_mfma_f32_16x16x32_bf16(Bt[n][k], At[m][k], acc[ai][bj][m][n], 0, 0, 0); __builtin_amdgcn_s_setprio(0); } while (0)
#define PG8_WAIT_V(n) asm volatile("s_waitcnt vmcnt(" #n ")" ::: "memory")
#define PG8_WAIT_L(n) asm volatile("s_waitcnt lgkmcnt(" #n ")" ::: "memory")
#define PG8_BAR __builtin_amdgcn_s_barrier()
#define PG8_SCHED __builtin_amdgcn_sched_barrier(0)
    Unit cur, nxt; int ui = 0;
    if (!S.next(0, cur)) return;
    f32x4 acc[2][2][4][2];
#pragma unroll
    for (int a = 0; a < 2; ++a)
#pragma unroll
        for (int b = 0; b < 2; ++b)
#pragma unroll
            for (int m = 0; m < 4; ++m)
#pragma unroll
                for (int n = 0; n < 2; ++n) acc[a][b][m][n] = (f32x4){0.f, 0.f, 0.f, 0.f};
    bf16x8 At[4][2], B0[2][2], B1[2][2];
    const char* cA = (const char*)g.A + (size_t)cur.pm * tstep; const char* cB = (const char*)g.Bt + (size_t)cur.pn * tstep;
    S.a_ready(cur);
    if constexpr (SP2) {
        PG8_STAGE(PG8_SB(0, 0), cB, voffB); PG8_STAGE(PG8_SB(0, 1), cB + hstep, voffB); PG8_STAGE(PG8_SA(0, 0), cA, voffA); PG8_STAGE(PG8_SA(0, 1), cA + hstep, voffA);
        if (wr == 1) PG8_BAR;
        PG8_WAIT_V(2); PG8_BAR;
        PG8_STAGE(PG8_SB(1, 0), cB + kstep, voffB); PG8_STAGE(PG8_SA(1, 0), cA + kstep, voffA); PG8_STAGE(PG8_SB(1, 1), cB + hstep + kstep, voffB);
        PG8_WAIT_V(6); PG8_BAR;
    } else {
        PG8_STAGE(PG8_SB(0, 0), cB, voffB); PG8_STAGE(PG8_SA(0, 0), cA, voffA); PG8_STAGE(PG8_SB(0, 1), cB + hstep, voffB); PG8_STAGE(PG8_SA(0, 1), cA + hstep, voffA);
        if (wr == 1) PG8_BAR;
        PG8_WAIT_V(4); PG8_BAR;
        PG8_STAGE(PG8_SB(1, 0), cB + kstep, voffB); PG8_STAGE(PG8_SA(1, 0), cA + kstep, voffA); PG8_STAGE(PG8_SB(1, 1), cB + hstep + kstep, voffB);
        PG8_WAIT_V(6); PG8_BAR;
    }
    for (;;) {
        const bool has_next = S.next(ui + 1, nxt);
        const char* nA = has_next ? (const char*)g.A + (size_t)nxt.pm * tstep : cA; const char* nB = has_next ? (const char*)g.Bt + (size_t)nxt.pn * tstep : cB;
        for (int t = 0; t < nt; t += 2) {
            const bool last = (t == nt - 2);
            const char* a1 = cA + (size_t)(t + 1) * kstep;
            const char* a2 = last ? nA : cA + (size_t)(t + 2) * kstep; const char* b2 = last ? nB : cB + (size_t)(t + 2) * kstep;
            const char* a3 = a2 + kstep; const char* b3 = b2 + kstep;
            if (last && has_next) S.a_ready(nxt);
            if constexpr (SP2) {
            PG8_LDB(B0, 0, 0); PG8_LDB(B1, 0, 1); PG8_SCHED; PG8_LDA(At, 0, 0); PG8_STAGE(PG8_SA(1, 1), a1 + hstep, voffA);
            PG8_WAIT_V(8); PG8_WAIT_L(0); PG8_BAR; PG8_MMA(0, 0, At, B0); PG8_MMA(0, 1, At, B1); PG8_BAR; PG8_SCHED;
            PG8_LDA(At, 0, 1); PG8_STAGE(PG8_SB(0, 0), b2, voffB); PG8_STAGE(PG8_SB(0, 1), b2 + hstep, voffB); PG8_STAGE(PG8_SA(0, 0), a2, voffA);
            PG8_WAIT_V(8); PG8_WAIT_L(0); PG8_BAR; PG8_MMA(1, 0, At, B0); PG8_MMA(1, 1, At, B1); PG8_BAR; PG8_SCHED;
            PG8_LDB(B0, 1, 0); PG8_LDB(B1, 1, 1); PG8_SCHED; PG8_LDA(At, 1, 0); PG8_STAGE(PG8_SA(0, 1), a2 + hstep, voffA);
            PG8_WAIT_V(8); PG8_WAIT_L(0); PG8_BAR; PG8_MMA(0, 0, At, B0); PG8_MMA(0, 1, At, B1); PG8_BAR; PG8_SCHED;
            PG8_LDA(At, 1, 1); PG8_STAGE(PG8_SB(1, 0), b3, voffB); PG8_STAGE(PG8_SB(1, 1), b3 + hstep, voffB); PG8_STAGE(PG8_SA(1, 0), a3, voffA);
            PG8_WAIT_V(8); PG8_WAIT_L(0); PG8_BAR; PG8_MMA(1, 0, At, B0); PG8_MMA(1, 1, At, B1); PG8_BAR; PG8_SCHED;
            } else {
            PG8_LDB(B0, 0, 0); PG8_SCHED; PG8_LDA(At, 0, 0); PG8_STAGE(PG8_SA(1, 1), a1 + hstep, voffA);
            PG8_WAIT_L(8); PG8_BAR; PG8_WAIT_L(0); PG8_MMA(0, 0, At, B0); PG8_BAR; PG8_SCHED;
            PG8_LDB(B1, 0, 1); PG8_STAGE(PG8_SB(0, 0), b2, voffB);
            PG8_BAR; PG8_WAIT_L(0); PG8_MMA(0, 1, At, B1); PG8_BAR;
            PG8_LDA(At, 0, 1); PG8_STAGE(PG8_SA(0, 0), a2, voffA);
            PG8_BAR; PG8_WAIT_L(0); PG8_MMA(1, 0, At, B0); PG8_BAR; PG8_SCHED;
            PG8_STAGE(PG8_SB(0, 1), b2 + hstep, voffB);
            PG8_WAIT_V(6); PG8_BAR; PG8_MMA(1, 1, At, B1); PG8_BAR;
            PG8_LDB(B0, 1, 0); PG8_SCHED; PG8_LDA(At, 1, 0); PG8_STAGE(PG8_SA(0, 1), a2 + hstep, voffA);
            PG8_WAIT_L(8); PG8_BAR; PG8_WAIT_L(0); PG8_MMA(0, 0, At, B0); PG8_BAR; PG8_SCHED;
            PG8_LDB(B1, 1, 1); PG8_STAGE(PG8_SB(1, 0), b3, voffB);
            PG8_BAR; PG8_WAIT_L(0); PG8_MMA(0, 1, At, B1); PG8_BAR;
            PG8_LDA(At, 1, 1); PG8_STAGE(PG8_SA(1, 0), a3, voffA);
            PG8_BAR; PG8_WAIT_L(0); PG8_MMA(1, 0, At, B0); PG8_BAR; PG8_SCHED;
            PG8_STAGE(PG8_SB(1, 1), b3 + hstep, voffB);
            PG8_WAIT_V(6); PG8_BAR; PG8_MMA(1, 1, At, B1); PG8_BAR;
            }
        }
        if constexpr (ALIGN_EPI) { if (wr == 0) PG8_BAR; }
        if constexpr (!Epi::AFTER_DRAIN) { E(acc, cur, wr, wc, fr, fq); S.done(cur); }
        if (!has_next) break;
#pragma unroll
        for (int a = 0; a < 2; ++a)
#pragma unroll
            for (int b = 0; b < 2; ++b)
#pragma unroll
                for (int m = 0; m < 4; ++m)
#pragma unroll
                    for (int n = 0; n < 2; ++n) acc[a][b][m][n] = (f32x4){0.f, 0.f, 0.f, 0.f};
        cur = nxt; cA = nA; cB = nB; ++ui;
        if constexpr (ALIGN_EPI) { if (wr == 1) PG8_BAR; }
    }
    PG8_WAIT_V(0);
    if constexpr (!ALIGN_EPI) { if (wr == 0) PG8_BAR; }
    PG8_BAR;
    if constexpr (Epi::AFTER_DRAIN) { E.fused(acc, cur, wr, wc, fr, fq, lds, wid, lane); S.done(cur); }
#undef PG8_SA
#undef PG8_SB
#undef PG8_STAGE
#undef PG8_LDA
#undef PG8_LDB
#undef PG8_MMA
#undef PG8_WAIT_V
#undef PG8_WAIT_L
#undef PG8_BAR
#undef PG8_SCHED
}
}

#define LAS __attribute__((address_space(3)))
typedef unsigned short bf16;
typedef short bf16x8 __attribute__((ext_vector_type(8)));
typedef short s16x4 __attribute__((ext_vector_type(4)));
typedef float f32x4 __attribute__((ext_vector_type(4)));
typedef float f32x16 __attribute__((ext_vector_type(16)));
typedef unsigned u32x4 __attribute__((ext_vector_type(4)));
typedef unsigned u32x2 __attribute__((ext_vector_type(2)));

constexpr int DM = 2048, TG = 16384, NPROJ = 12800, NP1 = 13056, NP1B = 8192, DFF = 5632;
constexpr int C_DAQ = 0, C_DAK = 2048, C_DAV = 4096, C_GDN = 6144, C_XAQ = 12288;
constexpr float EPS = 1e-6f, LOG2E = 1.4426950408889634f, QSCALE = 0.08838834764831845f * 1.4426950408889634f;
constexpr int NTHR = 512, NWV = 8;

constexpr size_t WS_CTL = 0, WS_H = 65536, WS_AB = WS_H + (size_t)TG * DM * 2, WS_MEMN = WS_AB + (size_t)TG * 64 * 4,
                 WS_MEMKV = WS_MEMN + (size_t)1024 * DM * 2, WS_COUT = WS_MEMKV + (size_t)1024 * 1024 * 2, WS_GDNB = WS_COUT + (size_t)TG * 512 * 2,
                 WS_W = WS_GDNB + (size_t)TG * DM * 2, WS_BIG = WS_W + (size_t)69206016, WS_HALO = WS_BIG + (size_t)TG * NPROJ * 2, WS_SSQ = WS_HALO + (size_t)256 * 4 * 6144 * 2, WS_SS2 = WS_SSQ + (size_t)TG * 16 * 4, WS_END = WS_SS2 + (size_t)TG * 8 * 4;
constexpr size_t W_WINA = 0, W_WMKV = (size_t)NP1 * DM * 2;
constexpr size_t W_WINB = 0, W_PA = (size_t)NP1B * DM * 2, W_PD = W_PA + (size_t)DM * DM * 2, W_PM = W_PD + (size_t)DM * DM * 2, W_WO = W_PM + (size_t)DM * 512 * 2;
constexpr size_t W_UP = 0, W_DOWN = (size_t)2 * DFF * DM * 2;
static_assert(W_WO + (size_t)DM * DM * 2 <= 69206016 && W_DOWN + (size_t)DM * DFF * 2 <= 69206016 && W_WMKV + (size_t)1024 * DM * 2 <= 69206016, "R_W");
constexpr int LDS_BYTES = 159744;

struct Params {
    const float* x[2]; const float* mem[2]; float* out[2];
    const float *g_mix, *g_mem, *w_in, *b_gate, *da_q_norm, *da_k_norm, *da_lambda, *da_subln, *gdn_conv_w, *gdn_A_log, *gdn_dt_bias, *gdn_out_norm,
                *xa_q_norm, *xa_k_norm, *w_mem_kv, *p_attn, *p_gdn, *p_mem, *w_o, *g_ffn, *w_up, *ffn_conv_w, *ffn_conv_b, *w_down;
    unsigned char* ws;
};

constexpr int LDS_TBL = 0, LDS_WQ = 256, LDS_PH = 512;
enum { T_X0, T_X1, T_MEM0, T_MEM1, T_OUT0, T_OUT1, T_GMIX, T_GMEM, T_WIN, T_BGATE, T_DAQN, T_DAKN, T_DALAM, T_DASUB, T_GCONV, T_GALOG, T_GDT, T_GON, T_XQN, T_XKN, T_WMKV, T_PA, T_PD, T_PM, T_WO, T_GFFN, T_WUP, T_FCW, T_FCB, T_WDOWN, T_WS, T_N };
__device__ __forceinline__ const float* tptr(const LAS unsigned char* lds, int i) {
    const LAS unsigned* t = (const LAS unsigned*)(lds + LDS_TBL) + 2 * i; unsigned lo = t[0], hi = t[1];
    lo = __builtin_amdgcn_readfirstlane(lo); hi = __builtin_amdgcn_readfirstlane(hi);
    return (const float*)(((unsigned long long)hi << 32) | (unsigned long long)lo);
}
__device__ __forceinline__ unsigned f2bf(float f) { return pg8::cvt_pk_bf16(f, 0.f) & 0xffffu; }
__device__ __forceinline__ unsigned pk2(float lo, float hi) { return pg8::cvt_pk_bf16(lo, hi); }
__device__ __forceinline__ float bf2f(unsigned short b) { return __builtin_bit_cast(float, (unsigned)b << 16); }
__device__ __forceinline__ float bflo(unsigned w) { return __builtin_bit_cast(float, w << 16); }
__device__ __forceinline__ float bfhi(unsigned w) { return __builtin_bit_cast(float, w & 0xffff0000u); }
__device__ __forceinline__ float wave_sum(float v) {
#pragma unroll
    for (int o = 1; o < 64; o <<= 1) v += __shfl_xor(v, o);
    return v;
}
__device__ __forceinline__ void unpack8(u32x4 w, float* f) { f[0] = bflo(w.x); f[1] = bfhi(w.x); f[2] = bflo(w.y); f[3] = bfhi(w.y); f[4] = bflo(w.z); f[5] = bfhi(w.z); f[6] = bflo(w.w); f[7] = bfhi(w.w); }
__device__ __forceinline__ u32x4 pack8(const float* f) { u32x4 w; w.x = pk2(f[0], f[1]); w.y = pk2(f[2], f[3]); w.z = pk2(f[4], f[5]); w.w = pk2(f[6], f[7]); return w; }
__device__ __forceinline__ float sigmoidf_(float x) { return __builtin_amdgcn_rcpf(1.f + __expf(-x)); }
__device__ __forceinline__ float rsq_(float x) { return __builtin_amdgcn_rsqf(x); }

__device__ __forceinline__ void transpose_job(const float* W, int ldw, int col0, int ncols, int K, bf16* WT, int row0, LAS float* scr, int gw, int NGW, int lane) {
    typedef float f32x2t __attribute__((ext_vector_type(2)));
    const int nblk = ncols / 64, nitems = (K / 64) * nblk;
    const int lr = lane >> 4, lc = (lane & 15) * 4;
    const int sn = lane >> 3, sc = lane & 7;
#ifndef TR_REPS
#define TR_REPS 1
#endif
    for (int rp_ = 0; rp_ < TR_REPS; ++rp_)
    for (int item = gw; item < nitems; item += NGW) {
        const int kb = item / nblk, nb = item - kb * nblk, k0 = 64 * kb, n0 = 64 * nb;
        const float* src = W + (size_t)(k0 + lr) * ldw + col0 + n0 + lc;
        f32x4 v[16];
#pragma unroll
        for (int i = 0; i < 16; ++i) v[i] = *(const f32x4*)(src + (size_t)(4 * i) * ldw);
#pragma unroll
        for (int i = 0; i < 16; ++i) { LAS float* d = scr + (4 * i + lr) * 66 + lc; *(LAS f32x2t*)d = (f32x2t){v[i].x, v[i].y}; *(LAS f32x2t*)(d + 2) = (f32x2t){v[i].z, v[i].w}; }
        asm volatile("s_waitcnt lgkmcnt(0)" ::: "memory");
#pragma unroll
        for (int j = 0; j < 8; ++j) { const int n = sn + 8 * j; const LAS float* s = scr + (8 * sc) * 66 + n;
            u32x4 o; o.x = pk2(s[0 * 66], s[1 * 66]); o.y = pk2(s[2 * 66], s[3 * 66]); o.z = pk2(s[4 * 66], s[5 * 66]); o.w = pk2(s[6 * 66], s[7 * 66]);
            *(u32x4*)(WT + (size_t)(row0 + n0 + n) * K + k0 + 8 * sc) = o; }
        asm volatile("s_waitcnt lgkmcnt(0)" ::: "memory");
    }
}
__device__ __forceinline__ void rms_row(const float* xrow, const float* gain, bf16* orow, int lane) {
    const f32x4* xr = (const f32x4*)xrow + lane; const f32x4* gr = (const f32x4*)gain + lane;
    f32x4 v[8]; float s = 0.f;
#pragma unroll
    for (int j = 0; j < 8; ++j) { v[j] = xr[64 * j]; s += (v[j].x * v[j].x + v[j].y * v[j].y) + (v[j].z * v[j].z + v[j].w * v[j].w); }
    const float inv = rsq_(wave_sum(s) * (1.f / DM) + EPS);
    u32x2* o8 = (u32x2*)orow + lane;
#pragma unroll
    for (int j = 0; j < 8; ++j) { const f32x4 g = gr[64 * j]; u32x2 w; w.x = pk2(v[j].x * inv * g.x, v[j].y * inv * g.y); w.y = pk2(v[j].z * inv * g.z, v[j].w * inv * g.w); o8[64 * j] = w; }
}

__device__ __forceinline__ u32x4 pack_v(f32x4 v0, f32x4 v1) { u32x4 w; w.x = pg8::cvt_pk_bf16(v0[0], v0[1]); w.y = pg8::cvt_pk_bf16(v0[2], v0[3]); w.z = pg8::cvt_pk_bf16(v1[0], v1[1]); w.w = pg8::cvt_pk_bf16(v1[2], v1[3]); return w; }
struct F_P1 { bf16* proj; float* ab;
    __device__ __forceinline__ void operator()(int row, int col, f32x4 v0, f32x4 v1) const {
        if (col < NPROJ) *(u32x4*)(proj + (size_t)row * NPROJ + col) = pack_v(v0, v1);
        else if (col < NPROJ + 64) { float* p = ab + (size_t)row * 64 + (col - NPROJ); *(f32x4*)p = v0; *(f32x4*)(p + 4) = v1; } } };
struct F_Bf16 { bf16* O; int ldc;
    __device__ __forceinline__ void operator()(int row, int col, f32x4 v0, f32x4 v1) const { *(u32x4*)(O + (size_t)row * ldc + col) = pack_v(v0, v1); } };
struct F_P1b { bf16* z; bf16* gates; const float* bg;
    __device__ __forceinline__ void operator()(int row, int col, f32x4 v0, f32x4 v1) const {
        if (col < DM) *(u32x4*)(z + (size_t)row * DM + col) = pack_v(v0, v1);
        else { const int c2 = col - DM; const f32x4 b0 = *(const f32x4*)(bg + c2), b1 = *(const f32x4*)(bg + c2 + 4);
#pragma unroll
            for (int e = 0; e < 4; ++e) { v0[e] = sigmoidf_(v0[e] + b0[e]); v1[e] = sigmoidf_(v1[e] + b1[e]); }
            *(u32x4*)(gates + (size_t)row * 6144 + c2) = pack_v(v0, v1); } } };
struct F_Merge { const bf16* gates; bf16* merged; int first;
    __device__ __forceinline__ void operator()(int row, int col, f32x4 v0, f32x4 v1) const {
        float g[8]; unpack8(*(const u32x4*)(gates + (size_t)row * 6144 + col), g);
        float r[8];
#pragma unroll
        for (int e = 0; e < 4; ++e) { r[e] = g[e] * v0[e]; r[4 + e] = g[4 + e] * v1[e]; }
        bf16* mp = merged + (size_t)row * DM + col;
        if (!first) { float pv[8]; unpack8(*(const u32x4*)mp, pv);
#pragma unroll
            for (int e = 0; e < 8; ++e) r[e] += pv[e]; }
        *(u32x4*)mp = pack8(r); } };
struct F_Wo { const float* x; float* out;
    __device__ __forceinline__ void operator()(int row, int col, f32x4 v0, f32x4 v1) const {
        const size_t o = (size_t)row * DM + col; *(f32x4*)(out + o) = *(const f32x4*)(x + o) + v0; *(f32x4*)(out + o + 4) = *(const f32x4*)(x + o + 4) + v1; } };
struct F_Up { bf16* gt; bf16* up;
    __device__ __forceinline__ void operator()(int row, int col, f32x4 v0, f32x4 v1) const {
        if (col < DFF) *(u32x4*)(gt + (size_t)row * DFF + col) = pack_v(v0, v1); else *(u32x4*)(up + (size_t)row * DFF + (col - DFF)) = pack_v(v0, v1); } };
struct F_Down { float* out;
    __device__ __forceinline__ void operator()(int row, int col, f32x4 v0, f32x4 v1) const {
        const size_t o = (size_t)row * DM + col; *(f32x4*)(out + o) = *(const f32x4*)(out + o) + v0; *(f32x4*)(out + o + 4) = *(const f32x4*)(out + o + 4) + v1; } };

struct EpiP1 {
    static constexpr bool PERM = true, AFTER_DRAIN = false;
    bf16* proj; float* ab; const float* gq; const float* gk; const float* gx; LAS float* exch; bf16* halo;
    __device__ __forceinline__ void operator()(const pg8::f32x4 (&acc)[2][2][4][2], const pg8::Unit& u, int wr, int wc, int fr, int fq) const {
        const int colt = u.pn * 256, row0 = u.pm * 256 + wr * 64 + fr, col0 = colt + wc * 32 + 8 * fq;
        const bool normed = (colt < C_DAV) || (colt >= C_XAQ && colt < NPROJ);
        if (normed) {
#pragma unroll
            for (int ai = 0; ai < 2; ++ai)
#pragma unroll
                for (int m = 0; m < 4; ++m)
#pragma unroll
                    for (int bj = 0; bj < 2; ++bj) { const pg8::f32x4 a = acc[ai][bj][m][0], b = acc[ai][bj][m][1];
                        float s = (a[0] * a[0] + a[1] * a[1]) + (a[2] * a[2] + a[3] * a[3]) + (b[0] * b[0] + b[1] * b[1]) + (b[2] * b[2] + b[3] * b[3]);
                        s += __shfl_xor(s, 16); s += __shfl_xor(s, 32);
                        if (fq == 0) exch[((ai * 128 + wr * 64 + m * 16 + fr) * 2 + bj) * 4 + wc] = s; }
            asm volatile("s_waitcnt lgkmcnt(0)" ::: "memory"); __builtin_amdgcn_s_barrier(); asm volatile("" ::: "memory");
            const float scale = (colt >= C_DAK && colt < C_DAV) ? 1.f : QSCALE; const int go = wc * 32 + 8 * fq;
            f32x4 g0, g1;
            if (colt < C_DAK) { g0 = *(const f32x4*)(gq + go); g1 = *(const f32x4*)(gq + go + 4); }
            else if (colt < C_DAV) { g0 = *(const f32x4*)(gk + go); g1 = *(const f32x4*)(gk + go + 4); }
            else { g0 = *(const f32x4*)(gx + go); g1 = *(const f32x4*)(gx + go + 4); }
#pragma unroll
            for (int ai = 0; ai < 2; ++ai)
#pragma unroll
                for (int m = 0; m < 4; ++m)
#pragma unroll
                    for (int bj = 0; bj < 2; ++bj) { const f32x4 t = *(const LAS f32x4*)(exch + ((ai * 128 + wr * 64 + m * 16 + fr) * 2 + bj) * 4);
                        const float inv = (rsq_(((t[0] + t[1]) + (t[2] + t[3])) * (1.f / 128.f) + EPS)) * scale;
                        pg8::f32x4 a = acc[ai][bj][m][0], b = acc[ai][bj][m][1];
#pragma unroll
                        for (int e = 0; e < 4; ++e) { a[e] *= inv * g0[e]; b[e] *= inv * g1[e]; }
                        *(u32x4*)(proj + (size_t)(row0 + ai * 128 + m * 16) * NPROJ + col0 + bj * 128) = pack_v(a, b); }
        } else {
#pragma unroll
            for (int ai = 0; ai < 2; ++ai)
#pragma unroll
                for (int m = 0; m < 4; ++m)
#pragma unroll
                    for (int bj = 0; bj < 2; ++bj) { const int row = row0 + ai * 128 + m * 16, col = col0 + bj * 128;
                        if (col < NPROJ) { const u32x4 w = pack_v(acc[ai][bj][m][0], acc[ai][bj][m][1]); *(u32x4*)(proj + (size_t)row * NPROJ + col) = w;
                            if (col >= C_GDN && col < C_XAQ) { const int r64 = row & 63;
                                if (r64 < 2 || r64 >= 62) *(u32x4*)(halo + ((size_t)(row >> 6) * 4 + (r64 < 2 ? r64 : r64 - 60)) * 6144 + (col - C_GDN)) = w; } }
                        else if (col < NPROJ + 64) { float* p = ab + (size_t)row * 64 + (col - NPROJ); *(f32x4*)p = acc[ai][bj][m][0]; *(f32x4*)(p + 4) = acc[ai][bj][m][1]; } }
        }
    }
};
struct EpiMKV {
    static constexpr bool PERM = true, AFTER_DRAIN = false;
    bf16* O; const float* gk; LAS float* exch;
    __device__ __forceinline__ void operator()(const pg8::f32x4 (&acc)[2][2][4][2], const pg8::Unit& u, int wr, int wc, int fr, int fq) const {
        const int colt = u.pn * 256, row0 = u.pm * 256 + wr * 64 + fr, col0 = colt + wc * 32 + 8 * fq;
        const bool normed = colt < 512;
        if (normed) {
#pragma unroll
            for (int ai = 0; ai < 2; ++ai)
#pragma unroll
                for (int m = 0; m < 4; ++m)
#pragma unroll
                    for (int bj = 0; bj < 2; ++bj) { const pg8::f32x4 a = acc[ai][bj][m][0], b = acc[ai][bj][m][1];
                        float s = (a[0] * a[0] + a[1] * a[1]) + (a[2] * a[2] + a[3] * a[3]) + (b[0] * b[0] + b[1] * b[1]) + (b[2] * b[2] + b[3] * b[3]);
                        s += __shfl_xor(s, 16); s += __shfl_xor(s, 32);
                        if (fq == 0) exch[((ai * 128 + wr * 64 + m * 16 + fr) * 2 + bj) * 4 + wc] = s; }
            asm volatile("s_waitcnt lgkmcnt(0)" ::: "memory"); __builtin_amdgcn_s_barrier(); asm volatile("" ::: "memory");
        }
        const int go = wc * 32 + 8 * fq; const f32x4 g0 = *(const f32x4*)(gk + go), g1 = *(const f32x4*)(gk + go + 4);
#pragma unroll
        for (int ai = 0; ai < 2; ++ai)
#pragma unroll
            for (int m = 0; m < 4; ++m)
#pragma unroll
                for (int bj = 0; bj < 2; ++bj) { pg8::f32x4 a = acc[ai][bj][m][0], b = acc[ai][bj][m][1];
                    if (normed) { const f32x4 t = *(const LAS f32x4*)(exch + ((ai * 128 + wr * 64 + m * 16 + fr) * 2 + bj) * 4);
                        const float inv = rsq_(((t[0] + t[1]) + (t[2] + t[3])) * (1.f / 128.f) + EPS);
#pragma unroll
                        for (int e = 0; e < 4; ++e) { a[e] *= inv * g0[e]; b[e] *= inv * g1[e]; } }
                    *(u32x4*)(O + (size_t)(row0 + ai * 128 + m * 16) * 1024 + col0 + bj * 128) = pack_v(a, b); }
    }
};
struct EpiWo {
    static constexpr bool PERM = true, AFTER_DRAIN = false;
    const float* x; float* out; bf16* a2; const float* gffn; float* ss; LAS float* exch;
    __device__ __forceinline__ void operator()(const pg8::f32x4 (&acc)[2][2][4][2], const pg8::Unit& u, int wr, int wc, int fr, int fq) const {
        const int row0 = u.pm * 256 + wr * 64 + fr, col0 = u.pn * 256 + wc * 32 + 8 * fq;
        f32x4 g[2][2];
#pragma unroll
        for (int bj = 0; bj < 2; ++bj) { g[bj][0] = *(const f32x4*)(gffn + col0 + bj * 128); g[bj][1] = *(const f32x4*)(gffn + col0 + bj * 128 + 4); }
#pragma unroll
        for (int ai = 0; ai < 2; ++ai)
#pragma unroll
            for (int m = 0; m < 4; ++m) { float s = 0.f;
#pragma unroll
                for (int bj = 0; bj < 2; ++bj) { const size_t o = (size_t)(row0 + ai * 128 + m * 16) * DM + col0 + bj * 128;
                    const f32x4 a = *(const f32x4*)(x + o) + acc[ai][bj][m][0], b = *(const f32x4*)(x + o + 4) + acc[ai][bj][m][1];
                    *(f32x4*)(out + o) = a; *(f32x4*)(out + o + 4) = b;
                    s += (a[0] * a[0] + a[1] * a[1]) + (a[2] * a[2] + a[3] * a[3]) + (b[0] * b[0] + b[1] * b[1]) + (b[2] * b[2] + b[3] * b[3]);
                    *(u32x4*)(a2 + o) = pack_v(a * g[bj][0], b * g[bj][1]); }
                s += __shfl_xor(s, 16); s += __shfl_xor(s, 32);
                if (fq == 0) exch[(ai * 128 + wr * 64 + m * 16 + fr) * 4 + wc] = s; }
        asm volatile("s_waitcnt lgkmcnt(0)" ::: "memory"); __builtin_amdgcn_s_barrier(); asm volatile("" ::: "memory");
        const int t = wr * 256 + wc * 64 + fq * 16 + fr;
        if (t < 256) { const f32x4 p = *(const LAS f32x4*)(exch + t * 4); ss[(size_t)(u.pm * 256 + t) * 8 + u.pn] = (p[0] + p[1]) + (p[2] + p[3]); }
    }
};
struct F_UpN { bf16* gt; bf16* up; const float* ss;
    __device__ __forceinline__ void operator()(int row, int col, f32x4 v0, f32x4 v1) const {
        const f32x4 p0 = *(const f32x4*)(ss + (size_t)row * 8), p1 = *(const f32x4*)(ss + (size_t)row * 8 + 4);
        const float rinv = rsq_((((p0[0] + p0[1]) + (p0[2] + p0[3])) + ((p1[0] + p1[1]) + (p1[2] + p1[3]))) * (1.f / DM) + EPS);
        v0 = v0 * rinv; v1 = v1 * rinv;
        if (col < DFF) *(u32x4*)(gt + (size_t)row * DFF + col) = pack_v(v0, v1); else *(u32x4*)(up + (size_t)row * DFF + (col - DFF)) = pack_v(v0, v1); } };
template <class F> __device__ __forceinline__ void run_gemm(LAS unsigned char* lds, const bf16* A, const bf16* Bt, int M, int N, int K, const F& f) {
    pg8::Gemm g{A, Bt, M, N, K}; pg8::StaticOrder S; S.init(M, N, (int)gridDim.x, (int)blockIdx.x);
    pg8::EpiRow8<F> E{f};
#ifndef NO_GEMM
    pg8::gemm_phase<pg8::EpiRow8<F>, pg8::StaticOrder, true, true>(lds, g, S, E);
#endif
}

namespace att {
constexpr int D = 128, NW = 8, QBLK = 32, KVBLK = 64;
constexpr int SHM_V = KVBLK * D * 2, SHM_K = KVBLK * D * 2, SHM_ATTN = 2 * SHM_V + 2 * SHM_K + NW * 64 * 4;
constexpr int OFF_STASH = SHM_ATTN, OFF_SSQ = OFF_STASH + 65536, ATT_LDS = OFF_SSQ + 1024;
constexpr float THR2 = 11.5f;
#define KSWZ(row, colB) ((row) * 256 + ((colB) ^ (((row) & 7) << 4)))
#define SBAR() __builtin_amdgcn_sched_barrier(0)
__device__ __forceinline__ int crow(int r, int hi) { return (r & 3) + 8 * (r >> 2) + 4 * hi; }
__device__ __forceinline__ unsigned cvtpk(float lo, float hi) { return pg8::cvt_pk_bf16(lo, hi); }

template <bool ALIBI>
__device__ __forceinline__ void partialSM(f32x16& p0, f32x16& p1, float& m_reg, float& mn, float& alpha, float dq, float slope2, int mode) {
  float b0 = 0.f, b1 = 0.f;
  if (ALIBI) {
    if (mode != 0) {
      const float sl = mode > 0 ? slope2 : -slope2;
#pragma unroll
      for (int r = 0; r < 16; ++r) { const float c = (float)((r & 3) + 8 * (r >> 2)); p0[r] = fmaf(sl, c, p0[r]); p1[r] = fmaf(sl, c, p1[r]); }
      b0 = -sl * dq; b1 = -sl * (dq - 32.f);
    } else {
#pragma unroll
      for (int r = 0; r < 16; ++r) { const float c = (float)((r & 3) + 8 * (r >> 2)); p0[r] = fmaf(-slope2, fabsf(dq - c), p0[r]); p1[r] = fmaf(-slope2, fabsf(dq - 32.f - c), p1[r]);
        if ((r & 3) == 3) SBAR(); }
    }
  }
  float pm0 = p0[0], pm1 = p1[0];
#pragma unroll
  for (int r = 1; r < 16; ++r) { pm0 = fmaxf(pm0, p0[r]); pm1 = fmaxf(pm1, p1[r]); }
  float pmax = fmaxf(pm0 + b0, pm1 + b1);
  { auto rr = __builtin_amdgcn_permlane32_swap(__float_as_uint(pmax), __float_as_uint(pmax), false, false);
    pmax = fmaxf(__uint_as_float(rr[0]), __uint_as_float(rr[1])); }
  if (__builtin_expect(__all(pmax - m_reg <= THR2), 1)) { mn = m_reg; alpha = 1.f; }
  else { mn = fmaxf(m_reg, pmax); alpha = __builtin_amdgcn_exp2f(m_reg - mn); m_reg = mn; }
  const float d0 = b0 - mn, d1 = b1 - mn;
#pragma unroll
  for (int r = 0; r < 16; ++r) p0[r] = p0[r] + d0;
#pragma unroll
  for (int r = 0; r < 16; ++r) p1[r] = p1[r] + d1;
#pragma unroll
  for (int r = 0; r < 16; ++r) p0[r] = __builtin_amdgcn_exp2f(p0[r]);
}
__device__ __forceinline__ void finishSM(f32x16& p0, f32x16& p1, float alpha, float& l_reg, bf16x8& pa0, bf16x8& pa1, bf16x8& pa2, bf16x8& pa3) {
#pragma unroll
  for (int r = 0; r < 16; ++r) p1[r] = __builtin_amdgcn_exp2f(p1[r]);
  float ps = 0;
#pragma unroll
  for (int r = 0; r < 16; ++r) ps += p0[r];
#pragma unroll
  for (int r = 0; r < 16; ++r) ps += p1[r];
  { auto rr = __builtin_amdgcn_permlane32_swap(__float_as_uint(ps), __float_as_uint(ps), false, false);
    ps = __uint_as_float(rr[0]) + __uint_as_float(rr[1]); }
  l_reg = l_reg * alpha + ps;
#define PK4(P, BASE, OUT) do { unsigned a0 = cvtpk(P[BASE + 0], P[BASE + 1]), a1 = cvtpk(P[BASE + 2], P[BASE + 3]);   \
    unsigned b0 = cvtpk(P[BASE + 4], P[BASE + 5]), b1 = cvtpk(P[BASE + 6], P[BASE + 7]);                              \
    auto r0 = __builtin_amdgcn_permlane32_swap(a0, b0, false, false); auto r1 = __builtin_amdgcn_permlane32_swap(a1, b1, false, false); \
    u32x4 w = {r0[0], r1[0], r0[1], r1[1]}; OUT = *reinterpret_cast<bf16x8*>(&w); } while (0)
  PK4(p0, 0, pa0); PK4(p0, 8, pa1); PK4(p1, 0, pa2); PK4(p1, 8, pa3);
#undef PK4
}
__device__ __forceinline__ void qkt(f32x16& p0, f32x16& p1, const bf16* Ks, const bf16x8* qr, int r32, int hi) {
  p0 = f32x16{}; p1 = f32x16{};
#pragma unroll
  for (int d0 = 0; d0 < 8; ++d0) { int cb = (d0 * 16 + hi * 8) * 2;
    bf16x8 b0 = *reinterpret_cast<const bf16x8*>((const char*)Ks + KSWZ(r32, cb));
    bf16x8 b1 = *reinterpret_cast<const bf16x8*>((const char*)Ks + KSWZ(32 + r32, cb));
    p0 = __builtin_amdgcn_mfma_f32_32x32x16_bf16(b0, qr[d0], p0, 0, 0, 0);
    p1 = __builtin_amdgcn_mfma_f32_32x32x16_bf16(b1, qr[d0], p1, 0, 0, 0); }
}
__device__ __forceinline__ int v_st(int k, int c) { const int kk = (k & ~0xC) | ((k & 4) << 1) | ((k & 8) >> 1); return ((kk >> 3) * 4 + (c >> 5)) * 512 + ((kk & 7) * 32 + (c & 31)) * 2; }
__device__ __forceinline__ int v_rd_base(int lane) { return ((lane & 3) << 3) | (((lane >> 2) & 3) << 6) | (((lane >> 4) & 1) << 5) | (((lane >> 5) & 1) << 8); }
constexpr int v_rd_off(int d0, int ks, int half) { return d0 * 512 + ks * 4096 + half * 2048; }
template <int OFF> __device__ __forceinline__ s16x4 tr_read(int vb) {
  s16x4 r; asm volatile("ds_read_b64_tr_b16 %0, %1 offset:%2" : "=&v"(r) : "v"(vb), "i"(OFF) : "memory"); return r;
}
template <int D0> __device__ __forceinline__ void pv_one(f32x16& od, int vb, bf16x8 pa0, bf16x8 pa1, bf16x8 pa2, bf16x8 pa3) {
  const s16x4 l0 = tr_read<v_rd_off(D0, 0, 0)>(vb), h0 = tr_read<v_rd_off(D0, 0, 1)>(vb), l1 = tr_read<v_rd_off(D0, 1, 0)>(vb), h1 = tr_read<v_rd_off(D0, 1, 1)>(vb);
  const s16x4 l2 = tr_read<v_rd_off(D0, 2, 0)>(vb), h2 = tr_read<v_rd_off(D0, 2, 1)>(vb), l3 = tr_read<v_rd_off(D0, 3, 0)>(vb), h3 = tr_read<v_rd_off(D0, 3, 1)>(vb);
  asm volatile("s_waitcnt lgkmcnt(0)" ::: "memory"); SBAR();
#define PK(L, H) (bf16x8){L[0], L[1], L[2], L[3], H[0], H[1], H[2], H[3]}
  od = __builtin_amdgcn_mfma_f32_32x32x16_bf16(pa0, PK(l0, h0), od, 0, 0, 0);
  od = __builtin_amdgcn_mfma_f32_32x32x16_bf16(pa1, PK(l1, h1), od, 0, 0, 0);
  od = __builtin_amdgcn_mfma_f32_32x32x16_bf16(pa2, PK(l2, h2), od, 0, 0, 0);
  od = __builtin_amdgcn_mfma_f32_32x32x16_bf16(pa3, PK(l3, h3), od, 0, 0, 0);
#undef PK
}
__device__ __forceinline__ void pv_d0(f32x16* o, int vb, bf16x8 pa0, bf16x8 pa1, bf16x8 pa2, bf16x8 pa3) {
  pv_one<0>(o[0], vb, pa0, pa1, pa2, pa3); pv_one<1>(o[1], vb, pa0, pa1, pa2, pa3); pv_one<2>(o[2], vb, pa0, pa1, pa2, pa3); pv_one<3>(o[3], vb, pa0, pa1, pa2, pa3);
}

template <bool ALIBI>
__device__ __forceinline__ void attn_core(const bf16* __restrict__ Qb, int ldq, const bf16* __restrict__ Kh, const bf16* __restrict__ Vh, int ldk, int jlo, int jhi, char* lds,
                                          float slope2, int qpos0, f32x16 (&o)[4]) {
  int tid_ = threadIdx.x; asm volatile("" : "+v"(tid_));
  const int tid = tid_, wid = tid >> 6, lane = tid & 63, r32 = lane & 31, hi = lane >> 5;
  bf16* V_lds = (bf16*)lds; bf16* K_lds = (bf16*)(lds + 2 * SHM_V);
  float* ws = (float*)(lds + 2 * SHM_V + 2 * SHM_K) + wid * 64; float* li_l = ws; float* al_l = ws + 32;
  float m_reg = -1e30f, l_reg = 0; bf16x8 qr[8];
#pragma unroll
  for (int d = 0; d < 4; ++d) o[d] = f32x16{};
  const bf16* Qw = Qb + (long)(wid * QBLK + r32) * ldq + hi * 8;
#pragma unroll
  for (int d0 = 0; d0 < 8; ++d0) qr[d0] = *reinterpret_cast<const bf16x8*>(Qw + d0 * 16);
  const float dq0 = (float)(qpos0 + wid * QBLK + r32 - 4 * hi);
  const int qmin_w = __builtin_amdgcn_readfirstlane(qpos0 + wid * QBLK);
#define AMODE(j) ((((j) * KVBLK + 63) <= qmin_w) ? 1 : ((((j) * KVBLK) >= qmin_w + 31) ? -1 : 0))
  const int sr = tid >> 4, sc = (tid & 15) * 8, vst0 = v_st(sr, sc), vst1 = v_st(32 + sr, sc);
  const int vb0 = (int)(uintptr_t)V_lds + v_rd_base(lane);
  struct { bf16x8 vs0, vs1, ks0, ks1; } sr_[1];
  const unsigned voff = (unsigned)(sr * ldk + sc) * 2u;
#define SLOAD(i, k0) do { const char* vt_ = (const char*)Vh + (size_t)(k0) * ldk * 2; const char* kt_ = (const char*)Kh + (size_t)(k0) * ldk * 2; const size_t h32_ = (size_t)32 * ldk * 2; \
    sr_[i].vs0 = *reinterpret_cast<const bf16x8*>(vt_ + voff); sr_[i].vs1 = *reinterpret_cast<const bf16x8*>(vt_ + h32_ + voff); \
    sr_[i].ks0 = *reinterpret_cast<const bf16x8*>(kt_ + voff); sr_[i].ks1 = *reinterpret_cast<const bf16x8*>(kt_ + h32_ + voff); } while (0)
#define SWRITE(b, i) do { *(bf16x8*)((char*)V_lds + (b) * SHM_V + vst0) = sr_[i].vs0;          \
    *(bf16x8*)((char*)V_lds + (b) * SHM_V + vst1) = sr_[i].vs1; int kc = sc * 2;               \
    *(bf16x8*)((char*)K_lds + (b) * SHM_K + KSWZ(sr, kc)) = sr_[i].ks0;                       \
    *(bf16x8*)((char*)K_lds + (b) * SHM_K + KSWZ(32 + sr, kc)) = sr_[i].ks1; } while (0)
#define SWAIT() asm volatile("s_waitcnt vmcnt(0)" ::: "memory")
#define RESC(a) do { if (__any((a) < 1.f)) { if (hi == 0) al_l[r32] = (a); asm volatile("s_waitcnt lgkmcnt(0)" ::: "memory"); \
    _Pragma("unroll") for (int d = 0; d < 4; ++d) _Pragma("unroll") for (int r = 0; r < 16; ++r) o[d][r] *= al_l[crow(r, hi)]; } } while (0)
#ifdef ATT_SIMPLE
  f32x16 p0, p1; float mn, al; bf16x8 pa0, pa1, pa2, pa3;
  SLOAD(0, jlo * KVBLK); asm volatile("s_waitcnt vmcnt(0)" ::: "memory"); SWRITE(0, 0); __syncthreads();
#pragma unroll 1
  for (int j = jlo; j < jhi; ++j) {
    const int bsel = (j - jlo) & 1;
    if (j + 1 < jhi) SLOAD(0, (j + 1) * KVBLK);
    SBAR(); qkt(p0, p1, (bf16*)((char*)K_lds + bsel * SHM_K), qr, r32, hi);
    partialSM<ALIBI>(p0, p1, m_reg, mn, al, dq0 - (float)(j * KVBLK), slope2, AMODE(j));
    finishSM(p0, p1, al, l_reg, pa0, pa1, pa2, pa3);
    RESC(al); SBAR();
    pv_d0(o, vb0 + bsel * (int)SHM_V, pa0, pa1, pa2, pa3);
    if (j + 1 < jhi) { SWAIT(); SWRITE(bsel ^ 1, 0); }
    __syncthreads();
  }
#else
  f32x16 pA0, pA1, pB0, pB1; float mnA, mnB, alA, alB; bf16x8 pa0, pa1, pa2, pa3;
  SLOAD(0, jlo * KVBLK); asm volatile("s_waitcnt vmcnt(0)" ::: "memory"); SWRITE(0, 0); __syncthreads();
  qkt(pA0, pA1, K_lds, qr, r32, hi); partialSM<ALIBI>(pA0, pA1, m_reg, mnA, alA, dq0 - (float)(jlo * KVBLK), slope2, AMODE(jlo));
  SLOAD(0, (jlo + 1) * KVBLK);
  SWAIT(); SWRITE(1, 0); __syncthreads();
#pragma unroll 1
  for (int j = jlo + 1; j + 1 < jhi; j += 2) {
    SBAR(); qkt(pB0, pB1, (bf16*)((char*)K_lds + SHM_K), qr, r32, hi);
    finishSM(pA0, pA1, alA, l_reg, pa0, pa1, pa2, pa3); SBAR();
    SLOAD(0, (j + 1) * KVBLK); SBAR();
    pv_d0(o, vb0, pa0, pa1, pa2, pa3); partialSM<ALIBI>(pB0, pB1, m_reg, mnB, alB, dq0 - (float)(j * KVBLK), slope2, AMODE(j));
    __syncthreads(); SWAIT(); SWRITE(0, 0);
    RESC(alB); __syncthreads();
    SBAR(); qkt(pA0, pA1, K_lds, qr, r32, hi);
    finishSM(pB0, pB1, alB, l_reg, pa0, pa1, pa2, pa3); SBAR();
    SLOAD(0, (j + 2) * KVBLK); SBAR();
    pv_d0(o, vb0 + (int)SHM_V, pa0, pa1, pa2, pa3); partialSM<ALIBI>(pA0, pA1, m_reg, mnA, alA, dq0 - (float)((j + 1) * KVBLK), slope2, AMODE(j + 1));
    __syncthreads(); SWAIT(); SWRITE(1, 0);
    RESC(alA); __syncthreads();
  }
  SBAR(); qkt(pB0, pB1, (bf16*)((char*)K_lds + SHM_K), qr, r32, hi);
  finishSM(pA0, pA1, alA, l_reg, pa0, pa1, pa2, pa3); SBAR();
  pv_d0(o, vb0, pa0, pa1, pa2, pa3); partialSM<ALIBI>(pB0, pB1, m_reg, mnB, alB, dq0 - (float)((jhi - 1) * KVBLK), slope2, AMODE(jhi - 1));
  __syncthreads(); RESC(alB);
  finishSM(pB0, pB1, alB, l_reg, pa0, pa1, pa2, pa3); SBAR();
  pv_d0(o, vb0 + (int)SHM_V, pa0, pa1, pa2, pa3);
  __syncthreads();
#endif
  if (hi == 0) li_l[r32] = l_reg; asm volatile("s_waitcnt lgkmcnt(0)" ::: "memory");
#pragma unroll
  for (int r = 0; r < 16; ++r) { const float rl = __builtin_amdgcn_rcpf(li_l[crow(r, hi)]);
#pragma unroll
    for (int d = 0; d < 4; ++d) o[d][r] *= rl; }
#undef AMODE
#undef SLOAD
#undef SWRITE
#undef SWAIT
#undef RESC
}
}

namespace gdn {
constexpr int SA = 272, SB = 144;
constexpr int OFF_X0 = 0, OFF_X1 = 17408, OFF_KBG = 34816, OFF_VBT = 53248, OFF_QD = 71680, OFF_QKM = 89088, OFF_KDT = 98304, OFF_ST = 116736, OFF_SM = 151552, OFF_Y = 154112, GDN_LDS = OFF_Y + 4096;
constexpr int SMB = 1280;
using att::crow;
template <int KS> __device__ __forceinline__ void tile_mma(f32x16& acc, const LAS char* A, int sa, int ra, const LAS char* B, int sb, int rb, int r32, int hi) {
    const LAS char* ap = A + (ra + r32) * sa + hi * 16; const LAS char* bp = B + (rb + r32) * sb + hi * 16;
#pragma unroll
    for (int ks = 0; ks < KS; ++ks) { const bf16x8 a = *(const LAS bf16x8*)(ap + ks * 32), b = *(const LAS bf16x8*)(bp + ks * 32); acc = __builtin_amdgcn_mfma_f32_32x32x16_bf16(a, b, acc, 0, 0, 0); }
}
typedef float f32x2_ __attribute__((ext_vector_type(2)));
__device__ __forceinline__ void st_bf16(LAS char* p, float v) { *(LAS unsigned short*)p = (unsigned short)f2bf(v); }
__device__ __forceinline__ float bfsel(const u32x4& w, int e) { const unsigned x = (e < 2) ? w.x : (e < 4) ? w.y : (e < 6) ? w.z : w.w; return (e & 1) ? bfhi(x) : bflo(x); }

__device__ __forceinline__ void chunk_scalars(float bl, float a, float Aexp, float dtb, LAS float* sm, int lane) {
    const float xx = a + dtb; const float sp = xx > 20.f ? xx : log1pf(__expf(xx));
    float v = -Aexp * sp;
#pragma unroll
    for (int o = 1; o < 64; o <<= 1) { const float n = __shfl_up(v, o); if (lane >= o) v += n; }
    const float gl = __shfl(v, 63);
    sm[lane] = v; sm[64 + lane] = sigmoidf_(bl); sm[128 + lane] = __expf(v); sm[192 + lane] = __expf(gl - v); if (lane == 0) sm[256] = __expf(gl);
}
#define GDN_LOADAB(cc, ln, BL, AA) do { const int t_ = (cc) * 64 + (dir ? 63 - (ln) : (ln)); const float* abr_ = AB + (size_t)(sb + t_) * 64; BL = abr_[dir * 16 + h]; AA = abr_[32 + dir * 16 + h]; } while (0)

template <int DIRT> __device__ __forceinline__ void gdn_unit(const float* A_log, const float* dt_bias, int S, int sb, int h, const bf16* proj, const float* AB, bf16* outp, LAS char* L) {
    constexpr int dir = DIRT;
    int tid_ = threadIdx.x; asm volatile("" : "+v"(tid_));
    const float Aexp = __expf(A_log[dir * 16 + h]), dtb = dt_bias[dir * 16 + h];
    const int N = S / 64;
    const int cgp = tid_ % 48, run = tid_ / 48, part = cgp >> 4, c0 = (cgp & 15) * 8, ccol = part * 2048 + h * 128 + c0;
    const bool convt = tid_ < 384;
    u32x4 raw[8];
#define GDN_LOADRAW(cc, tsrc) do { if (convt) { const unsigned voff_ = ((unsigned)((tsrc) / 48) * 8u * (unsigned)NPROJ + (unsigned)(((tsrc) % 48) >> 4) * 2048u + (unsigned)(((tsrc) % 48) & 15) * 8u) * 2u; \
        _Pragma("unroll") for (int k_ = 0; k_ < 8; ++k_) { const char* rb_ = (const char*)proj + ((size_t)(sb + (cc) * 64 + k_) * NPROJ + C_GDN + h * 128) * 2; \
            raw[k_] = *(const u32x4*)(rb_ + voff_); } } } while (0)
    GDN_LOADRAW(dir ? N - 1 : 0, tid_);
    f32x16 st[2]; st[0] = f32x16{}; st[1] = f32x16{};
    for (int i = tid_; i < 34816 / 4; i += NTHR) ((LAS unsigned*)(L + OFF_ST))[i] = 0u;
    float ab_bl = 0.f, ab_a = 0.f;
    if ((tid_ >> 6) == 7) { GDN_LOADAB(dir ? N - 1 : 0, tid_ & 63, ab_bl, ab_a); chunk_scalars(ab_bl, ab_a, Aexp, dtb, (LAS float*)(L + OFF_SM), tid_ & 63); }
    __syncthreads();
#pragma unroll 1
    for (int ci = 0; ci < N; ++ci) {
        const int c = dir ? N - 1 - ci : ci;
        int tq = tid_; asm volatile("" : "+v"(tq));
        const int tid = tq, wid = __builtin_amdgcn_readfirstlane(tid >> 6), lane = tid & 63, r32 = lane & 31, hi = lane >> 5;
        LAS float* gcs = (LAS float*)(L + OFF_SM + (ci & 1) * SMB); LAS float* bet = gcs + 64; LAS float* eg = gcs + 128; LAS float* ekd = gcs + 192;
        if (wid == 7 && ci + 1 < N) GDN_LOADAB(dir ? c - 1 : c + 1, lane, ab_bl, ab_a);
        if (convt) {
            asm volatile("s_waitcnt vmcnt(0)" ::: "memory");
            float y[8][8];
#pragma unroll
            for (int rr = 0; rr < 8; ++rr) unpack8(raw[rr], y[rr]);
            u32x4 rawc[8];
#pragma unroll
            for (int rr = 0; rr < 8; ++rr) rawc[rr] = raw[rr];
            if (ci + 1 < N) GDN_LOADRAW(dir ? c - 1 : c + 1, tid);
            const int i0 = dir ? 56 - run * 8 : run * 8;
            float bi[8], egi[8], eki[8];
            { const f32x4 a0 = *(const LAS f32x4*)(bet + i0), a1 = *(const LAS f32x4*)(bet + i0 + 4), b0 = *(const LAS f32x4*)(eg + i0), b1 = *(const LAS f32x4*)(eg + i0 + 4), c0v = *(const LAS f32x4*)(ekd + i0), c1v = *(const LAS f32x4*)(ekd + i0 + 4);
#pragma unroll
              for (int p = 0; p < 4; ++p) { bi[p] = a0[p]; bi[4 + p] = a1[p]; egi[p] = b0[p]; egi[4 + p] = b1[p]; eki[p] = c0v[p]; eki[4 + p] = c1v[p]; } }
#define GDN_PK8(v) (u32x4){pg8::cvt_pk_bf16((v)[0], (v)[1]), pg8::cvt_pk_bf16((v)[2], (v)[3]), pg8::cvt_pk_bf16((v)[4], (v)[5]), pg8::cvt_pk_bf16((v)[6], (v)[7])}
            if (part == 0) {
#pragma unroll
                for (int rr = 0; rr < 8; ++rr) { const int p = dir ? 7 - rr : rr, i = i0 + p; float qd[8];
#pragma unroll
                    for (int e = 0; e < 8; ++e) qd[e] = y[rr][e] * egi[p];
                    *(LAS u32x4*)(L + OFF_X0 + i * SA + c0 * 2) = rawc[rr]; *(LAS u32x4*)(L + OFF_QD + i * SA + c0 * 2) = GDN_PK8(qd); }
            } else if (part == 1) {
#pragma unroll
                for (int rr = 0; rr < 8; ++rr) { const int p = dir ? 7 - rr : rr, i = i0 + p; *(LAS u32x4*)(L + OFF_X1 + i * SA + c0 * 2) = rawc[rr]; }
#pragma unroll
                for (int e = 0; e < 8; ++e) { float kb[8], kd[8];
#pragma unroll
                    for (int p = 0; p < 8; ++p) { const int rr = dir ? 7 - p : p; kb[p] = y[rr][e] * (bi[p] * egi[p]); kd[p] = y[rr][e] * eki[p]; }
                    *(LAS u32x4*)(L + OFF_KBG + (c0 + e) * SB + i0 * 2) = GDN_PK8(kb); *(LAS u32x4*)(L + OFF_KDT + (c0 + e) * SB + i0 * 2) = GDN_PK8(kd); }
            } else {
#pragma unroll
                for (int e = 0; e < 8; ++e) { float vb[8];
#pragma unroll
                    for (int p = 0; p < 8; ++p) { const int rr = dir ? 7 - p : p; vb[p] = y[rr][e] * bi[p]; }
                    *(LAS u32x4*)(L + OFF_VBT + (c0 + e) * SB + i0 * 2) = GDN_PK8(vb); }
            }
        }
        __syncthreads();
        {
            f32x16 acc = f32x16{};
            const int w4 = wid & 3, ma = w4 >> 1, nb = w4 & 1;
            if (wid < 4) { if (!(ma == 0 && nb == 1)) tile_mma<8>(acc, L + OFF_X1, SA, 32 * ma, L + OFF_X1, SA, 32 * nb, r32, hi); }
            else         { if (!(ma == 1 && nb == 0)) tile_mma<8>(acc, L + OFF_X1, SA, 32 * ma, L + OFF_X0, SA, 32 * nb, r32, hi); }
            __syncthreads();
            if (wid < 4) {
                if (!(ma == 0 && nb == 1)) {
                    const int j = 32 * nb + r32; const float gj = gcs[j];
#pragma unroll
                    for (int r = 0; r < 16; ++r) { const int i = 32 * ma + crow(r, hi); const float v = (i > j) ? bet[i] * acc[r] * __expf(gcs[i] - gj) : 0.f; *(LAS float*)(L + OFF_X1 + (i * 68 + j) * 4) = v; }
                }
            } else {
                const int i = 32 * nb + r32; const float gi = gcs[i];
#pragma unroll
                for (int r4 = 0; r4 < 4; ++r4) { float v[4];
#pragma unroll
                    for (int e = 0; e < 4; ++e) { const int j = 32 * ma + 8 * r4 + 4 * hi + e; v[e] = (i >= j) ? acc[4 * r4 + e] * __expf(gi - gcs[j]) : 0.f; }
                    u32x2 w; w.x = pk2(v[0], v[1]); w.y = pk2(v[2], v[3]); *(LAS u32x2*)(L + OFF_QKM + i * SB + (32 * ma + 8 * r4 + 4 * hi) * 2) = w; }
            }
        }
        __syncthreads();
        {
            const LAS float* Lf = (const LAS float*)(L + OFF_X1); LAS float* Tf = (LAS float*)(L + OFF_X0); LAS float* Yf = (LAS float*)(L + OFF_Y);
            if (tid < 64) { const int b = tid >> 4, cc = tid & 15; const LAS float* Lb = Lf + (16 * b) * 68 + 16 * b; float x[16];
#pragma unroll
                for (int i = 0; i < 16; ++i) { float s = (i == cc) ? 1.f : 0.f;
#pragma unroll
                    for (int j = 0; j < i; ++j) s = fmaf(-Lb[i * 68 + j], x[j], s);
                    x[i] = s; }
#pragma unroll
                for (int i = 0; i < 16; ++i) Tf[(16 * b + i) * 68 + 16 * b + cc] = x[i]; }
            if (wid == 7 && ci + 1 < N) chunk_scalars(ab_bl, ab_a, Aexp, dtb, (LAS float*)(L + OFF_SM + ((ci + 1) & 1) * SMB), lane);
            __syncthreads();
            { const int pr = tid >> 8, i = (tid >> 4) & 15, j = tid & 15, a = 2 * pr, b = 2 * pr + 1; float y = 0.f;
#pragma unroll
              for (int k = 0; k < 16; ++k) y = fmaf(Lf[(16 * b + i) * 68 + 16 * a + k], Tf[(16 * a + k) * 68 + 16 * a + j], y);
              Yf[tid] = y; __syncthreads();
              float z = 0.f;
#pragma unroll
              for (int k = 0; k < 16; ++k) z = fmaf(-Tf[(16 * b + i) * 68 + 16 * b + k], Yf[(pr * 16 + k) * 16 + j], z);
              Tf[(16 * b + i) * 68 + 16 * a + j] = z; Tf[(16 * a + i) * 68 + 16 * b + j] = 0.f; }
            __syncthreads();
            { const int i = tid >> 4, j0 = (tid & 15) * 2; float y0 = 0.f, y1 = 0.f;
#pragma unroll
              for (int k4 = 0; k4 < 8; ++k4) { const f32x4 l = *(const LAS f32x4*)(Lf + (32 + i) * 68 + 4 * k4);
#pragma unroll
                  for (int e = 0; e < 4; ++e) { const f32x2_ t = *(const LAS f32x2_*)(Tf + (4 * k4 + e) * 68 + j0); y0 = fmaf(l[e], t.x, y0); y1 = fmaf(l[e], t.y, y1); } }
              *(LAS f32x2_*)(Yf + i * 32 + j0) = (f32x2_){y0, y1}; __syncthreads();
              float z0 = 0.f, z1 = 0.f;
#pragma unroll
              for (int k4 = 0; k4 < 8; ++k4) { const f32x4 tb = *(const LAS f32x4*)(Tf + (32 + i) * 68 + 32 + 4 * k4);
#pragma unroll
                  for (int e = 0; e < 4; ++e) { const f32x2_ yv = *(const LAS f32x2_*)(Yf + (4 * k4 + e) * 32 + j0); z0 = fmaf(-tb[e], yv.x, z0); z1 = fmaf(-tb[e], yv.y, z1); } }
              *(LAS f32x2_*)(Tf + (32 + i) * 68 + j0) = (f32x2_){z0, z1}; }
            __syncthreads();
            { const int i = tid >> 3, j0 = (tid & 7) * 8; float v[8];
#pragma unroll
              for (int e = 0; e < 8; ++e) { const int j = j0 + e; v[e] = (j <= i) ? Tf[i * 68 + j] : 0.f; }
              *(LAS u32x4*)(L + OFF_X1 + i * SB + j0 * 2) = pack8(v); }
        }
        __syncthreads();
        const int mi = wid >> 2, ni = wid & 3;
        f32x16 accU = f32x16{};
        tile_mma<4>(accU, L + OFF_X1, SB, 32 * mi, L + OFF_VBT, SB, 32 * ni, r32, hi);
        { f32x16 accW = f32x16{};
          tile_mma<4>(accW, L + OFF_KBG, SB, 32 * ni, L + OFF_X1, SB, 32 * mi, r32, hi);
          const int tok = 32 * mi + r32;
#pragma unroll
          for (int r4 = 0; r4 < 4; ++r4) { u32x2 w; w.x = pk2(accW[4 * r4], accW[4 * r4 + 1]); w.y = pk2(accW[4 * r4 + 2], accW[4 * r4 + 3]);
              *(LAS u32x2*)(L + OFF_X0 + tok * SA + (32 * ni + 8 * r4 + 4 * hi) * 2) = w; } }
        __syncthreads();
        {
            f32x16 accV = f32x16{}, accO = f32x16{};
            {
                const LAS char* wp = L + OFF_X0 + (32 * mi + r32) * SA + hi * 16; const LAS char* qp = L + OFF_QD + (32 * mi + r32) * SA + hi * 16; const LAS char* sp = L + OFF_ST + (32 * ni + r32) * SA + hi * 16;
#pragma unroll
                for (int ks = 0; ks < 8; ++ks) { const bf16x8 b = *(const LAS bf16x8*)(sp + ks * 32), aw = *(const LAS bf16x8*)(wp + ks * 32), aq = *(const LAS bf16x8*)(qp + ks * 32);
                    accV = __builtin_amdgcn_mfma_f32_32x32x16_bf16(aw, b, accV, 0, 0, 0); accO = __builtin_amdgcn_mfma_f32_32x32x16_bf16(aq, b, accO, 0, 0, 0); }
            }
            const int dv = 32 * ni + r32;
#pragma unroll
            for (int r4 = 0; r4 < 4; ++r4) { u32x2 w; w.x = pk2(accU[4 * r4] - accV[4 * r4], accU[4 * r4 + 1] - accV[4 * r4 + 1]); w.y = pk2(accU[4 * r4 + 2] - accV[4 * r4 + 2], accU[4 * r4 + 3] - accV[4 * r4 + 3]);
                *(LAS u32x2*)(L + OFF_VBT + dv * SB + (32 * mi + 8 * r4 + 4 * hi) * 2) = w; }
            __syncthreads();
            tile_mma<4>(accO, L + OFF_QKM, SB, 32 * mi, L + OFF_VBT, SB, 32 * ni, r32, hi);
#pragma unroll
            for (int r = 0; r < 16; ++r) { const int tok = 32 * mi + crow(r, hi); const int t = c * 64 + (dir ? 63 - tok : tok);
                outp[(size_t)(sb + t) * DM + h * 128 + dv] = (bf16)f2bf(accO[r]); }
            const float egl = gcs[256]; const int mi2 = wid & 3;
#pragma unroll
            for (int xx = 0; xx < 2; ++xx) { const int ni2 = (wid >> 2) * 2 + xx;
#pragma unroll
                for (int r = 0; r < 16; ++r) st[xx][r] *= egl;
                tile_mma<4>(st[xx], L + OFF_KDT, SB, 32 * mi2, L + OFF_VBT, SB, 32 * ni2, r32, hi);
                const int dv2 = 32 * ni2 + r32;
#pragma unroll
                for (int r4 = 0; r4 < 4; ++r4) { u32x2 w; w.x = pk2(st[xx][4 * r4], st[xx][4 * r4 + 1]); w.y = pk2(st[xx][4 * r4 + 2], st[xx][4 * r4 + 3]);
                    *(LAS u32x2*)(L + OFF_ST + dv2 * SA + (32 * mi2 + 8 * r4 + 4 * hi) * 2) = w; }
            }
        }
        __syncthreads();
    }
#undef GDN_LOADRAW
#undef GDN_LOADAB
}
}

__device__ __forceinline__ void diffattn_unit(const float* da_lambda, const float* gqn, const float* gkn, int S, int sb, int h, int qb, int vh, const bf16* proj, bf16* aout, float* ssqg, char* lds) {
    using namespace att;
    int tid_ = threadIdx.x; asm volatile("" : "+v"(tid_));
    const int tid = tid_, wid = tid >> 6, lane = tid & 63;
    const int t0 = sb + qb * 256;
    const float slope2 = exp2f(-(float)(h + 1)) * LOG2E;
    int jlo, jhi;
    { float gq = fmaxf(fabsf(gqn[lane]), fabsf(gqn[64 + lane])), gk = fmaxf(fabsf(gkn[lane]), fabsf(gkn[64 + lane]));
#pragma unroll
      for (int o_ = 1; o_ < 64; o_ <<= 1) { gq = fmaxf(gq, __shfl_xor(gq, o_)); gk = fmaxf(gk, __shfl_xor(gk, o_)); }
      const float smax2 = 11.313708499f * gq * gk * LOG2E * 1.02f;
      const float Wf = fminf((2.f * smax2 + 40.f) / slope2, 1.0e6f); const int W = __builtin_amdgcn_readfirstlane((int)Wf + 1), q0 = qb * 256;
      const int lo = q0 - W, hi_ = q0 + 255 + W, NT = S / 64;
      jlo = lo > 0 ? (lo >> 6) : 0; jhi = (hi_ >> 6) + 1; jhi = jhi < NT ? jhi : NT;
      if ((jhi - jlo) & 1) { if (jlo > 0) --jlo; else ++jhi; } }
    unsigned* stash = (unsigned*)(lds + OFF_STASH);
#pragma unroll 1
    for (int map = 0; map < 2; ++map) {
        f32x16 o[4];
        attn_core<true>(proj + (size_t)t0 * NPROJ + C_DAQ + (h * 2 + map) * 128, NPROJ, proj + (size_t)sb * NPROJ + C_DAK + (h * 2 + map) * 128,
                        proj + (size_t)sb * NPROJ + C_DAV + h * 256 + vh * 128, NPROJ, jlo, jhi, lds, slope2, qb * 256, o);
        if (map == 0) {
#pragma unroll
            for (int d = 0; d < 4; ++d)
#pragma unroll
                for (int r2 = 0; r2 < 8; ++r2) stash[(d * 8 + r2) * NTHR + tid] = pk2(o[d][2 * r2], o[d][2 * r2 + 1]);
        } else {
            float lam;
            { const float* lp = da_lambda; const float s1 = wave_sum(lp[lane] * lp[128 + lane] + lp[64 + lane] * lp[192 + lane]), s2 = wave_sum(lp[256 + lane] * lp[384 + lane] + lp[320 + lane] * lp[448 + lane]);
              lam = __expf(s1) - __expf(s2) + 0.2f; }
            float ss[16];
#pragma unroll
            for (int r = 0; r < 16; ++r) ss[r] = 0.f;
#pragma unroll
            for (int d = 0; d < 4; ++d)
#pragma unroll
                for (int r2 = 0; r2 < 8; ++r2) { const unsigned w = stash[(d * 8 + r2) * NTHR + tid];
                    const float a = bflo(w) - lam * o[d][2 * r2], b = bfhi(w) - lam * o[d][2 * r2 + 1]; o[d][2 * r2] = a; o[d][2 * r2 + 1] = b; ss[2 * r2] += a * a; ss[2 * r2 + 1] += b * b; }
#pragma unroll
            for (int r = 0; r < 16; ++r) { float s = ss[r]; s += __shfl_xor(s, 1); s += __shfl_xor(s, 2); s += __shfl_xor(s, 4); s += __shfl_xor(s, 8); s += __shfl_xor(s, 16); ss[r] = s; }
            int lz = lane; asm volatile("" : "+v"(lz));
            const int r32 = lz & 31, hi = lz >> 5;
            bf16* orow = aout + (size_t)(t0 + wid * 32) * DM + h * 256 + vh * 128 + r32;
            if (r32 == 0) {
#pragma unroll
                for (int r = 0; r < 16; ++r) ssqg[(size_t)(t0 + wid * 32 + crow(r, hi)) * 16 + h * 2 + vh] = ss[r]; }
#pragma unroll
            for (int r = 0; r < 16; ++r)
#pragma unroll
                for (int d = 0; d < 4; ++d) orow[(size_t)crow(r, hi) * DM + d * 32] = (bf16)f2bf(o[d][r]);
        }
        __syncthreads();
    }
}
__device__ __forceinline__ void xattn_unit(int sb, int bl, int xh, int qb, const bf16* proj, const bf16* memkv, bf16* cout, char* lds) {
    using namespace att;
    int tid_ = threadIdx.x; asm volatile("" : "+v"(tid_));
    const int tid = tid_, wid = tid >> 6, lane = tid & 63, r32 = lane & 31, hi = lane >> 5;
    const int t0 = sb + qb * 256;
    f32x16 o[4];
    attn_core<false>(proj + (size_t)t0 * NPROJ + C_XAQ + xh * 128, NPROJ, memkv + (size_t)bl * 256 * 1024 + xh * 128, memkv + (size_t)bl * 256 * 1024 + 512 + xh * 128, 1024, 0, 4, lds, 0.f, 0, o);
    bf16* orow = cout + (size_t)(t0 + wid * 32) * 512 + xh * 128 + r32;
#pragma unroll
    for (int r = 0; r < 16; ++r)
#pragma unroll
        for (int d = 0; d < 4; ++d) orow[(size_t)crow(r, hi) * 512 + d * 32] = (bf16)f2bf(o[d][r]);
}

__device__ __forceinline__ void seg_norm_fin(bf16* p, u32x4 raw, const float* gain, float scale, int l16) {
    float v[8]; unpack8(raw, v);
    float ss = 0.f;
#pragma unroll
    for (int e = 0; e < 8; ++e) ss += v[e] * v[e];
    ss += __shfl_xor(ss, 1); ss += __shfl_xor(ss, 2); ss += __shfl_xor(ss, 4); ss += __shfl_xor(ss, 8);
    const float inv = (rsq_(ss * (1.f / 128.f) + EPS)) * scale;
    const f32x4 g0 = *(const f32x4*)(gain + l16 * 8), g1 = *(const f32x4*)(gain + l16 * 8 + 4);
#pragma unroll
    for (int e = 0; e < 4; ++e) { v[e] *= inv * g0[e]; v[4 + e] *= inv * g1[e]; }
    *(u32x4*)(p + l16 * 8) = pack8(v);
}
__device__ __forceinline__ void seg_norm(bf16* p, const float* gain, float scale, int l16) { seg_norm_fin(p, *(const u32x4*)(p + l16 * 8), gain, scale, l16); }

__device__ __forceinline__ void gdn_conv_item(bf16* proj, const bf16* halo, const float* conv_w, int S, int c, int cg, int l16dummy) {
    (void)l16dummy;
    const int part = cg >> 8, col = cg * 8;
    const int s0 = (c * 64) & (S - 1);
    f32x4 wc[5][2];
#pragma unroll
    for (int j = 0; j < 5; ++j) { wc[j][0] = *(const f32x4*)(conv_w + j * 6144 + col); wc[j][1] = *(const f32x4*)(conv_w + j * 6144 + col + 4); }
    bf16* base = proj + (size_t)c * 64 * NPROJ + C_GDN + col;
    const u32x4 zero4 = (u32x4){0u, 0u, 0u, 0u};
    u32x4 raw[12];
    raw[0] = (s0 == 0) ? zero4 : *(const u32x4*)(halo + ((size_t)(c - 1) * 4 + 2) * 6144 + col);
    raw[1] = (s0 == 0) ? zero4 : *(const u32x4*)(halo + ((size_t)(c - 1) * 4 + 3) * 6144 + col);
    raw[2] = *(const u32x4*)(base); raw[3] = *(const u32x4*)(base + NPROJ);
#pragma unroll 1
    for (int b = 0; b < 8; ++b) {
#pragma unroll
        for (int k = 0; k < 8; ++k) { const int r = 8 * b + 2 + k;
            raw[4 + k] = (r < 64) ? *(const u32x4*)(base + (size_t)r * NPROJ) : ((s0 + 64 == S) ? zero4 : *(const u32x4*)(halo + ((size_t)(c + 1) * 4 + (r - 64)) * 6144 + col)); }
        float y[8][8];
#pragma unroll
        for (int e = 0; e < 8; ++e) { float xr[12];
#pragma unroll
            for (int k = 0; k < 12; ++k) xr[k] = gdn::bfsel(raw[k], e);
#pragma unroll
            for (int rr = 0; rr < 8; ++rr) { float s = 0.f;
#pragma unroll
                for (int j = 0; j < 5; ++j) s = fmaf(wc[j][e >> 2][e & 3], xr[rr + j], s);
                y[rr][e] = s * sigmoidf_(s); } }
#pragma unroll
        for (int rr = 0; rr < 8; ++rr) { float sc = 1.f;
            if (part < 2) { float ss = 0.f;
#pragma unroll
                for (int e = 0; e < 8; ++e) ss += y[rr][e] * y[rr][e];
                ss += __shfl_xor(ss, 1); ss += __shfl_xor(ss, 2); ss += __shfl_xor(ss, 4); ss += __shfl_xor(ss, 8);
                sc = (rsq_(ss + EPS)) * (part == 0 ? 0.08838834764831845f : 1.f); }
            u32x4 w; w.x = pg8::cvt_pk_bf16(y[rr][0] * sc, y[rr][1] * sc); w.y = pg8::cvt_pk_bf16(y[rr][2] * sc, y[rr][3] * sc); w.z = pg8::cvt_pk_bf16(y[rr][4] * sc, y[rr][5] * sc); w.w = pg8::cvt_pk_bf16(y[rr][6] * sc, y[rr][7] * sc);
            *(u32x4*)(base + (size_t)(8 * b + rr) * NPROJ) = w; }
        raw[0] = raw[8]; raw[1] = raw[9]; raw[2] = raw[10]; raw[3] = raw[11];
    }
}


#define XB_TMO      128
#define XB_XCNT(j)  (256  + 64 * (j))
#define XB_XSUB(j)  (1280 + 64 * (j))
#define XB_XGEN(j)  (2304 + 64 * (j))
#define XB_TOP      3328
#define XB_TOPGEN   3392
#define XCD_BAR_WORDS 3456
#define XB_SPIN_CAP (1u << 18)

__device__ __forceinline__ unsigned xb_ld(unsigned* p)              { return __hip_atomic_load(p, __ATOMIC_RELAXED, __HIP_MEMORY_SCOPE_AGENT); }
__device__ __forceinline__ unsigned xb_add(unsigned* p, unsigned v) { return __hip_atomic_fetch_add(p, v, __ATOMIC_RELAXED, __HIP_MEMORY_SCOPE_AGENT); }
__device__ __forceinline__ unsigned xb_xcc_id() { return (unsigned)__builtin_amdgcn_s_getreg((3 << 11) | 20) & 0xFu; }
#define XB_SPIN(cond, bar) do { unsigned _sp = 0; while (cond) { __builtin_amdgcn_s_sleep(1); \
    if ((++_sp & 255u) == 0u) { if (xb_ld(&(bar)[XB_TMO])) break; if (_sp > XB_SPIN_CAP) { atomicAdd(&(bar)[XB_TMO], 1u); break; } } } } while (0)

struct XcdBarrier {
    unsigned* bar; unsigned x;
    volatile LAS unsigned* st;
};

__device__ __forceinline__ XcdBarrier xcd_barrier_post(unsigned* bar, volatile LAS unsigned* st) {
    XcdBarrier b; b.bar = bar; b.x = xb_xcc_id(); b.st = st;
    if (threadIdx.x == 0) (void)xb_add(&bar[XB_XCNT(b.x)], 1u);
    return b;
}
__device__ __forceinline__ void xcd_barrier_complete(unsigned* bar, unsigned x, unsigned& nloc, unsigned& nx) {
    const unsigned G = gridDim.x * gridDim.y * gridDim.z;
    unsigned sum, cnt, mine, sp = 0u;
    for (;;) {
        sum = 0u; cnt = 0u; mine = 0u;
#pragma unroll
        for (unsigned j = 0; j < 16; ++j) { const unsigned c = xb_ld(&bar[XB_XCNT(j)]); sum += c; cnt += (c > 0u) ? 1u : 0u; mine = (j == x) ? c : mine; }
        if (sum == G) break;
        __builtin_amdgcn_s_sleep(1);
        if ((++sp & 255u) == 0u) { if (xb_ld(&bar[XB_TMO])) break; if (sp > XB_SPIN_CAP) { atomicAdd(&bar[XB_TMO], 1u); break; } }
    }
    nloc = mine > 0u ? mine : 1u; nx = cnt > 0u ? cnt : 1u;
}

__device__ __forceinline__ void xcd_barrier(const XcdBarrier& b) {
    asm volatile("s_waitcnt vmcnt(0)" ::: "memory");
    __syncthreads();
    if (threadIdx.x == 0) {
        unsigned* bar = b.bar;
        __builtin_amdgcn_s_waitcnt(0);
        unsigned nloc = b.st[0], nx = b.st[1];
        if (nloc == 0u) { xcd_barrier_complete(bar, b.x, nloc, nx); b.st[0] = nloc; b.st[1] = nx; }
        const unsigned old = xb_add(&bar[XB_XSUB(b.x)], 1u);
        const unsigned gen = old / nloc;
        if (old + 1u == (gen + 1u) * nloc) {
            __builtin_amdgcn_fence(__ATOMIC_RELEASE, "agent");
            asm volatile("s_waitcnt vmcnt(0)" ::: "memory");
            const unsigned og = xb_add(&bar[XB_TOP], 1u);
            const unsigned tg = og / nx;
            if (og + 1u == (tg + 1u) * nx) xb_add(&bar[XB_TOPGEN], 1u);
            else XB_SPIN(xb_ld(&bar[XB_TOPGEN]) == tg, bar);
            __builtin_amdgcn_fence(__ATOMIC_ACQUIRE, "agent");
            xb_add(&bar[XB_XGEN(b.x)], 1u);
            asm volatile("s_waitcnt vmcnt(0)" ::: "memory");
        } else {
            XB_SPIN(xb_ld(&bar[XB_XGEN(b.x)]) == gen, bar);
            __builtin_amdgcn_fence(__ATOMIC_ACQUIRE, "agent");
            asm volatile("s_waitcnt vmcnt(0)" ::: "memory");
        }
    }
    __syncthreads();
}


__device__ __forceinline__ void p0_phase(LAS unsigned char* lds, int gg, int NGW) {
    int tq = threadIdx.x; asm volatile("" : "+v"(tq));
    const int lane = tq & 63, wave = __builtin_amdgcn_readfirstlane(tq >> 6), gw = blockIdx.x * NWV + wave;
    LAS float* scr = (LAS float*)(lds + LDS_PH + wave * 16896);
    unsigned char* wsb = (unsigned char*)tptr(lds, T_WS);
    bf16* WA = (bf16*)(wsb + WS_W + W_WINA); const float* win = tptr(lds, T_WIN);
    transpose_job(win, 21056, 0, 12288, DM, WA, 0, scr, gw, NGW, lane);
    transpose_job(win, 21056, 14400, 512, DM, WA, 12288, scr, gw, NGW, lane);
    transpose_job(win, 21056, 14336, 64, DM, WA, 12800, scr, gw, NGW, lane);
    transpose_job(tptr(lds, T_WMKV), 1024, 0, 1024, DM, (bf16*)(wsb + WS_W + W_WMKV), 0, scr, gw, NGW, lane);
    { const float* x = tptr(lds, T_X0 + gg); const float* gm = tptr(lds, T_GMIX); bf16* h = (bf16*)(wsb + WS_H);
      for (int m = gw; m < TG; m += NGW) rms_row(x + (size_t)m * DM, gm, h + (size_t)m * DM, lane); }
    { const int nmem = (gg ? 2 : 4) * 256; const float* mx = tptr(lds, T_MEM0 + gg); const float* gm = tptr(lds, T_GMEM); bf16* mn = (bf16*)(wsb + WS_MEMN);
      for (int m = gw; m < nmem; m += NGW) rms_row(mx + (size_t)m * DM, gm, mn + (size_t)m * DM, lane); }
}
__global__ void __launch_bounds__(NTHR, 2) hybrid_fwd(Params P) {
    extern __shared__ __attribute__((aligned(16))) unsigned char lds_raw[];
    cg::grid_group grid = cg::this_grid();
    LAS unsigned char* lds = (LAS unsigned char*)lds_raw;
    const int NGW = gridDim.x * NWV;
    if (threadIdx.x == 0) {
        LAS unsigned long long* t = (LAS unsigned long long*)(lds + LDS_TBL);
        t[T_X0] = (unsigned long long)P.x[0];
        t[T_X1] = (unsigned long long)P.x[1];
        t[T_MEM0] = (unsigned long long)P.mem[0];
        t[T_MEM1] = (unsigned long long)P.mem[1];
        t[T_OUT0] = (unsigned long long)P.out[0];
        t[T_OUT1] = (unsigned long long)P.out[1];
        t[T_GMIX] = (unsigned long long)P.g_mix;
        t[T_GMEM] = (unsigned long long)P.g_mem;
        t[T_WIN] = (unsigned long long)P.w_in;
        t[T_BGATE] = (unsigned long long)P.b_gate;
        t[T_DAQN] = (unsigned long long)P.da_q_norm;
        t[T_DAKN] = (unsigned long long)P.da_k_norm;
        t[T_DALAM] = (unsigned long long)P.da_lambda;
        t[T_DASUB] = (unsigned long long)P.da_subln;
        t[T_GCONV] = (unsigned long long)P.gdn_conv_w;
        t[T_GALOG] = (unsigned long long)P.gdn_A_log;
        t[T_GDT] = (unsigned long long)P.gdn_dt_bias;
        t[T_GON] = (unsigned long long)P.gdn_out_norm;
        t[T_XQN] = (unsigned long long)P.xa_q_norm;
        t[T_XKN] = (unsigned long long)P.xa_k_norm;
        t[T_WMKV] = (unsigned long long)P.w_mem_kv;
        t[T_PA] = (unsigned long long)P.p_attn;
        t[T_PD] = (unsigned long long)P.p_gdn;
        t[T_PM] = (unsigned long long)P.p_mem;
        t[T_WO] = (unsigned long long)P.w_o;
        t[T_GFFN] = (unsigned long long)P.g_ffn;
        t[T_WUP] = (unsigned long long)P.w_up;
        t[T_FCW] = (unsigned long long)P.ffn_conv_w;
        t[T_FCB] = (unsigned long long)P.ffn_conv_b;
        t[T_WDOWN] = (unsigned long long)P.w_down;
        t[T_WS] = (unsigned long long)P.ws;
    }
    if (threadIdx.x == 0) { ((LAS unsigned*)(lds + 272))[0] = 0u; ((LAS unsigned*)(lds + 272))[1] = 0u; }
    __syncthreads();
#define TP(i) tptr(lds, i)
    const XcdBarrier xbar = xcd_barrier_post((unsigned*)(P.ws + WS_CTL) + 1024, (volatile LAS unsigned*)(lds + 272));
#define GSYNC() xcd_barrier(xbar)
#define WSB ((unsigned char*)TP(T_WS))
#define H ((bf16*)(WSB + WS_H))
#define AB ((float*)(WSB + WS_AB))
#define MEMN ((bf16*)(WSB + WS_MEMN))
#define MEMKV ((bf16*)(WSB + WS_MEMKV))
#define COUT ((bf16*)(WSB + WS_COUT))
#define GDNB ((bf16*)(WSB + WS_GDNB))
#define RW (WSB + WS_W)
#define PROJ ((bf16*)(WSB + WS_BIG))
#define HALO ((bf16*)(WSB + WS_HALO))
#define SSQ ((float*)(WSB + WS_SSQ))
#define SS2 ((float*)(WSB + WS_SS2))
#define H2 ((bf16*)(WSB + WS_GDNB))
#define ZB ((bf16*)(WSB + WS_BIG))
#define GATES (ZB + (size_t)TG * DM)
#define GT ((bf16*)(WSB + WS_BIG))
#define UP (GT + (size_t)TG * DFF)
#define WDN ((bf16*)(WSB + WS_BIG + (size_t)369098752))
#define PHASE_IDS() int tq = threadIdx.x; asm volatile("" : "+v"(tq));   \
    const int tid = tq, lane = tid & 63, wave = __builtin_amdgcn_readfirstlane(tid >> 6), gw = blockIdx.x * NWV + wave; \
    LAS float* scr = (LAS float*)(lds + LDS_PH + wave * 16896); (void)lane; (void)gw; (void)scr; (void)tid
#pragma unroll 1
    for (int g = 0; g < 2; ++g) {
        const int B = g ? 2 : 4, S = g ? 8192 : 4096, NMEM = B * 256;

#define X (TP(T_X0 + g))
#define OUT ((float*)TP(T_OUT0 + g))
#define MEMX (TP(T_MEM0 + g))
#define GDNF ((bf16*)OUT)
#define AOUT (GDNF + (size_t)TG * DM)
        p0_phase(lds, g, NGW);
        GSYNC();
        if (gridDim.x == 0x7fffffffu) grid.sync();
#ifndef GEMM_REPS
#define GEMM_REPS 1
#endif
        for (int rp = 0; rp < GEMM_REPS; ++rp)
        { pg8::Gemm gm{H, (const bf16*)(RW + W_WINA), TG, NP1, DM}; pg8::StaticOrder So; So.init(TG, NP1, (int)gridDim.x, (int)blockIdx.x);
          EpiP1 Ep{PROJ, AB, TP(T_DAQN), TP(T_DAKN), TP(T_XQN), (LAS float*)(lds + LDS_PH + 131072), HALO};
          pg8::gemm_phase<EpiP1, pg8::StaticOrder, true, true>(lds + LDS_PH, gm, So, Ep); }
        GSYNC();
#ifndef P3_GDN_ONLY
#define P3_GDN_ONLY 0
#endif
        {
            { pg8::Gemm gm{MEMN, (const bf16*)(RW + W_WMKV), 1024, 1024, DM}; pg8::StaticOrder So; So.init(1024, 1024, (int)gridDim.x, (int)blockIdx.x);
              EpiMKV Ep{MEMKV, TP(T_XKN), (LAS float*)(lds + LDS_PH + 131072)};
              pg8::gemm_phase<EpiMKV, pg8::StaticOrder, true, true>(lds + LDS_PH, gm, So, Ep); }
            PHASE_IDS();
            volatile LAS unsigned* wq = (volatile LAS unsigned*)(lds + LDS_WQ);
            for (;;) {
                __syncthreads();
                if (tid == 0) wq[0] = atomicAdd((unsigned*)(WSB + WS_CTL) + 64 * g + 48, 1u);
                __syncthreads();
                const int ck = (int)wq[0];
                if (ck >= 256 * 768 / NTHR) break;
                const int it = ck * NTHR + tid;
                gdn_conv_item(PROJ, HALO, TP(T_GCONV), S, it / 768, it % 768, 0);
            }
        }
        GSYNC();
#ifndef P3_REPS
#define P3_REPS 1
#endif
        for (int rep = 0; rep < P3_REPS; ++rep) {
            PHASE_IDS();
            const int nG = B * 32, nA = B * 16 * (S / 256), nX = B * 4 * (S / 256), total = (rep > 0 && P3_GDN_ONLY) ? nG : nG + nA + nX;
            volatile LAS unsigned* wq = (volatile LAS unsigned*)(lds + LDS_WQ);
            for (;;) {
                __syncthreads();
                if (tid == 0) wq[0] = atomicAdd((unsigned*)(WSB + WS_CTL) + 64 * g + 16 * rep, 1u);
                __syncthreads();
                const int item = (int)wq[0];
                if (item >= total) break;
#ifndef NO_GDN
                if (item < nG) { const int dir = item & 1, h = (item >> 1) & 15, bl = item >> 5;
                    if (dir) gdn::gdn_unit<1>(TP(T_GALOG), TP(T_GDT), S, bl * S, h, PROJ, AB, GDNB, (LAS char*)lds + LDS_PH); else gdn::gdn_unit<0>(TP(T_GALOG), TP(T_GDT), S, bl * S, h, PROJ, AB, GDNF, (LAS char*)lds + LDS_PH);
                } else
#endif
#ifndef NO_DATT
                if (item < nG + nA) { const int u = item - nG, lq = g ? 5 : 4, lb = g ? 1 : 2, qb = u & ((1 << lq) - 1), bl = (u >> lq) & (B - 1), hv = u >> (lq + lb), h = 7 - (hv >> 1), vh = hv & 1;
                    diffattn_unit(TP(T_DALAM), TP(T_DAQN), TP(T_DAKN), S, bl * S, h, qb, vh, PROJ, AOUT, SSQ, (char*)lds_raw + LDS_PH);
                } else
#endif
#ifndef NO_XATT
                if (item >= nG + nA) { const int u = item - nG - nA, lq = g ? 5 : 4, qb = u & ((1 << lq) - 1), xh = (u >> lq) & 3, bl = u >> (lq + 2);
                    xattn_unit(bl * S, bl, xh, qb, PROJ, MEMKV, COUT, (char*)lds_raw + LDS_PH); }
#endif
                {}
            }
            if (rep == 0) {
                constexpr int NSL = 128;
                for (;;) {
                    __syncthreads();
                    if (tid == 0) wq[0] = atomicAdd((unsigned*)(WSB + WS_CTL) + 64 * g + 32, 1u);
                    __syncthreads();
                    const int sl = (int)wq[0];
                    if (sl >= NSL) break;
                    const int gw = sl * NWV + wave; const int NGW = NSL * NWV;
                    transpose_job(TP(T_WIN), 21056, 12288, 2048, DM, (bf16*)(RW + W_WINB), 0, scr, gw, NGW, lane);
                    transpose_job(TP(T_WIN), 21056, 14912, 6144, DM, (bf16*)(RW + W_WINB), 2048, scr, gw, NGW, lane);
                    transpose_job(TP(T_PA), DM, 0, DM, DM, (bf16*)(RW + W_PA), 0, scr, gw, NGW, lane);
                    transpose_job(TP(T_PD), DM, 0, DM, DM, (bf16*)(RW + W_PD), 0, scr, gw, NGW, lane);
                    transpose_job(TP(T_PM), DM, 0, DM, 512, (bf16*)(RW + W_PM), 0, scr, gw, NGW, lane);
                    transpose_job(TP(T_WO), DM, 0, DM, DM, (bf16*)(RW + W_WO), 0, scr, gw, NGW, lane);
                }
            }
            if (rep + 1 < P3_REPS) GSYNC();
        }
        GSYNC();
        for (int rp = 0; rp < GEMM_REPS; ++rp)
        run_gemm(lds + LDS_PH, H, (const bf16*)(RW + W_WINB), TG, NP1B, DM, F_P1b{ZB, GATES, TP(T_BGATE)});
        GSYNC();
        {
            PHASE_IDS();
            const int l16 = lane & 15, sub = lane >> 4; const float* gon = TP(T_GON);
            { bf16* gf = GDNF; const bf16* gb = GDNB; const bf16* zb = ZB;
              for (int it0 = gw; it0 < TG * 4; it0 += 4 * NGW) {
                size_t off[4]; u32x4 ra[4], rb[4], rz[4];
#pragma unroll
                for (int u = 0; u < 4; ++u) { const int it = it0 + u * NGW, row = it >> 2, hd = (it & 3) * 4 + sub; off[u] = (size_t)row * DM + hd * 128 + l16 * 8;
                    ra[u] = *(const u32x4*)(gf + off[u]); rb[u] = *(const u32x4*)(gb + off[u]); rz[u] = *(const u32x4*)(zb + off[u]); }
#pragma unroll
                for (int u = 0; u < 4; ++u) { float a[8], b[8], z[8]; unpack8(ra[u], a); unpack8(rb[u], b); unpack8(rz[u], z);
                    float ss = 0.f;
#pragma unroll
                    for (int e = 0; e < 8; ++e) { a[e] += b[e]; ss += a[e] * a[e]; }
                    ss += __shfl_xor(ss, 1); ss += __shfl_xor(ss, 2); ss += __shfl_xor(ss, 4); ss += __shfl_xor(ss, 8);
                    const float inv = rsq_(ss * (1.f / 128.f) + EPS);
#pragma unroll
                    for (int e = 0; e < 8; ++e) a[e] = a[e] * inv * gon[l16 * 8 + e] * (z[e] * sigmoidf_(z[e]));
                    *(u32x4*)(gf + off[u]) = pack8(a); } } }
        }
        {
            PHASE_IDS();
            const int l32 = lane & 31, sub = lane >> 5; const float* subln = TP(T_DASUB);
            { bf16* ao = AOUT; const float* sq = SSQ; const f32x4 g0 = *(const f32x4*)(subln + l32 * 8), g1 = *(const f32x4*)(subln + l32 * 8 + 4);
              for (int it0 = gw; it0 < TG * 4; it0 += 8 * NGW) {
                bf16* ap[8]; u32x4 ra[8]; float t0[8], t1[8];
#pragma unroll
                for (int u = 0; u < 8; ++u) { const int it = it0 + u * NGW, row = it >> 2, hd = (it & 3) * 2 + sub; ap[u] = ao + (size_t)row * DM + hd * 256 + l32 * 8;
                    ra[u] = *(const u32x4*)ap[u]; t0[u] = sq[(size_t)row * 16 + hd * 2]; t1[u] = sq[(size_t)row * 16 + hd * 2 + 1]; }
#pragma unroll
                for (int u = 0; u < 8; ++u) { float a[8]; unpack8(ra[u], a);
                    const float rinv = (rsq_((t0[u] + t1[u]) * (1.f / 256.f) + EPS)) * 0.8f;
#pragma unroll
                    for (int e = 0; e < 4; ++e) { a[e] *= rinv * g0[e]; a[4 + e] *= rinv * g1[e]; }
                    *(u32x4*)ap[u] = pack8(a); } } }
        }
        GSYNC();
        for (int rp = 0; rp < GEMM_REPS; ++rp) {
        run_gemm(lds + LDS_PH, AOUT, (const bf16*)(RW + W_PA), TG, DM, DM, F_Merge{GATES, H, 1});
        run_gemm(lds + LDS_PH, GDNF, (const bf16*)(RW + W_PD), TG, DM, DM, F_Merge{GATES + DM, H, 0});
        run_gemm(lds + LDS_PH, COUT, (const bf16*)(RW + W_PM), TG, DM, 512, F_Merge{GATES + 2 * DM, H, 0}); }
        GSYNC();
        for (int rp = 0; rp < GEMM_REPS; ++rp)
        { pg8::Gemm gm{H, (const bf16*)(RW + W_WO), TG, DM, DM}; pg8::StaticOrder So; So.init(TG, DM, (int)gridDim.x, (int)blockIdx.x);
          EpiWo Ep{X, OUT, H2, TP(T_GFFN), SS2, (LAS float*)(lds + LDS_PH + 131072)};
          pg8::gemm_phase<EpiWo, pg8::StaticOrder, true, true>(lds + LDS_PH, gm, So, Ep); }
        GSYNC();
        {
            PHASE_IDS();
            transpose_job(TP(T_WUP), 2 * DFF, 0, 2 * DFF, DM, (bf16*)(RW + W_UP), 0, scr, gw, NGW, lane);
            transpose_job(TP(T_WDOWN), DM, 0, DM, DFF, WDN, 0, scr, gw, NGW, lane);
        }
        GSYNC();
        for (int rp = 0; rp < GEMM_REPS; ++rp)
        run_gemm(lds + LDS_PH, H2, (const bf16*)(RW + W_UP), TG, 2 * DFF, DM, F_UpN{GT, UP, SS2});
        GSYNC();
        {
            PHASE_IDS();
            const int ncg = DFF / 8;
            const float* fcw = TP(T_FCW); const float* fcb = TP(T_FCB); const bf16* gt = GT; bf16* up = UP;
            for (int it = blockIdx.x * NTHR + tid; it < (TG / 8) * ncg; it += gridDim.x * NTHR) { const int run = it / ncg, c0 = (it - run * ncg) * 8, row0 = run * 8, t0 = row0 & (S - 1);
                u32x4 g[10], uu[8];
                const u32x4 zero4 = (u32x4){0u, 0u, 0u, 0u};
#pragma unroll
                for (int r = 0; r < 10; ++r) { const int tt = t0 + r - 1; g[r] = (tt >= 0 && tt < S) ? *(const u32x4*)(gt + (size_t)(row0 + r - 1) * DFF + c0) : zero4; }
#pragma unroll
                for (int r = 0; r < 8; ++r) uu[r] = *(const u32x4*)(up + (size_t)(row0 + r) * DFF + c0);
                f32x4 w[3][2];
#pragma unroll
                for (int j = 0; j < 3; ++j) { w[j][0] = *(const f32x4*)(fcw + j * DFF + c0); w[j][1] = *(const f32x4*)(fcw + j * DFF + c0 + 4); }
                const f32x4 b0 = *(const f32x4*)(fcb + c0), b1 = *(const f32x4*)(fcb + c0 + 4);
#pragma unroll
                for (int r = 0; r < 8; ++r) { float acc[8], u[8], xv[8];
#pragma unroll
                    for (int e = 0; e < 4; ++e) { acc[e] = b0[e]; acc[4 + e] = b1[e]; }
#pragma unroll
                    for (int j = 0; j < 3; ++j) { unpack8(g[r + j], xv);
#pragma unroll
                        for (int e = 0; e < 4; ++e) { acc[e] = fmaf(w[j][0][e], xv[e], acc[e]); acc[4 + e] = fmaf(w[j][1][e], xv[4 + e], acc[4 + e]); } }
                    unpack8(uu[r], u);
#pragma unroll
                    for (int e = 0; e < 8; ++e) u[e] *= acc[e] * sigmoidf_(acc[e]);
                    *(u32x4*)(up + (size_t)(row0 + r) * DFF + c0) = pack8(u); } }
        }
        GSYNC();
        run_gemm(lds + LDS_PH, UP, (const bf16*)WDN, TG, DM, DFF, F_Down{OUT});
        GSYNC();
    }
}

extern "C" void kernel_launch(void* const* d_in, const int* in_sizes, int n_in, void* d_out, int out_size, void* d_ws, size_t ws_size, hipStream_t stream) {
    static int grid_blocks = 0;
    if (grid_blocks == 0) {
        if (n_in != 28 || ws_size < WS_END || out_size != 2 * TG * DM) { fprintf(stderr, "kernel_launch: unexpected shapes: n_in %d out %d ws %zu (need %zu)\n", n_in, out_size, ws_size, (size_t)WS_END); grid_blocks = -1; return; }
        int dev = 0, cus = 0, per_cu = 0;
        hipGetDevice(&dev); hipDeviceGetAttribute(&cus, hipDeviceAttributeMultiprocessorCount, dev);
        if (hipFuncSetAttribute((const void*)hybrid_fwd, hipFuncAttributeMaxDynamicSharedMemorySize, LDS_BYTES) != hipSuccess) { fprintf(stderr, "kernel_launch: hipFuncSetAttribute failed\n"); grid_blocks = -1; return; }
        if (hipOccupancyMaxActiveBlocksPerMultiprocessor(&per_cu, (const void*)hybrid_fwd, NTHR, LDS_BYTES) != hipSuccess || per_cu < 1) { fprintf(stderr, "kernel_launch: occupancy query gave %d\n", per_cu); per_cu = 1; }
        (void)hipGetLastError();
        grid_blocks = cus * 1;
        fprintf(stderr, "kernel_launch: grid %d (cus %d, per_cu %d), ws %zu need %zu\n", grid_blocks, cus, per_cu, ws_size, (size_t)WS_END);
    }
    if (grid_blocks < 0) return;
    hipMemsetAsync((char*)d_ws + WS_CTL, 0, 65536, stream);
    Params p{};
    const float* const* in = (const float* const*)d_in;
    p.x[0] = in[0]; p.x[1] = in[1]; p.mem[0] = in[2]; p.mem[1] = in[3]; p.out[0] = (float*)d_out; p.out[1] = (float*)d_out + (size_t)TG * DM;
    p.g_mix = in[4]; p.g_mem = in[5]; p.w_in = in[6]; p.b_gate = in[7]; p.da_q_norm = in[8]; p.da_k_norm = in[9]; p.da_lambda = in[10]; p.da_subln = in[11];
    p.gdn_conv_w = in[12]; p.gdn_A_log = in[13]; p.gdn_dt_bias = in[14]; p.gdn_out_norm = in[15]; p.xa_q_norm = in[16]; p.xa_k_norm = in[17]; p.w_mem_kv = in[18];
    p.p_attn = in[19]; p.p_gdn = in[20]; p.p_mem = in[21]; p.w_o = in[22]; p.g_ffn = in[23]; p.w_up = in[24]; p.ffn_conv_w = in[25]; p.ffn_conv_b = in[26]; p.w_down = in[27];
    p.ws = (unsigned char*)d_ws;
    void* args[] = {&p};
    hipError_t e = hipLaunchCooperativeKernel((const void*)hybrid_fwd, dim3(grid_blocks), dim3(NTHR), args, LDS_BYTES, stream);
    if (e != hipSuccess) fprintf(stderr, "cooperative launch failed: %s (grid %d)\n", hipGetErrorString(e), grid_blocks);
}
```

```cpp
#include <hip/hip_runtime.h>
#include <hip/hip_cooperative_groups.h>
#include <cstdio>
#include <cstdint>
namespace cg = cooperative_groups;

namespace pg8 {
#define PG8_LAS __attribute__((address_space(3)))
typedef unsigned short bf16_t;
typedef short bf16x8 __attribute__((ext_vector_type(8)));
typedef float f32x4 __attribute__((ext_vector_type(4)));
typedef unsigned u32x4 __attribute__((ext_vector_type(4)));
constexpr int BM = 256, BK = 64, HALF = 128, HTB = HALF * BK * 2  , STAGE_BYTES = 8 * HTB, NXCD = 8, WGM = 8;

__host__ __device__ __forceinline__ int lds_byte(int r, int c) { const int st = (r >> 4) * 2 + (c >> 5), rr = r & 15, cc = c & 31, ob = rr * 64 + cc * 2; return st * 1024 + (ob ^ (((ob >> 9) & 1) << 5)); }
__host__ __device__ __forceinline__ void stage_rc(int b, int& R, int& C) { const int st = b / 1024, sb = b % 1024, swz = sb ^ (((sb >> 9) & 1) << 5); R = (st >> 1) * 16 + swz / 64; C = (st & 1) * 32 + (swz % 64) / 2; }
__host__ __device__ __forceinline__ int perm32(int rho) { const int n = rho >> 4, i = rho & 15; return 8 * (i >> 2) + 4 * n + (i & 3); }

struct Unit { int pm, pn; };
struct Gemm { const bf16_t* A; const bf16_t* Bt; int M, N, K; };

struct StaticOrder {
    int nM, nN, nwg, G, c;
    __host__ __device__ void init(int M, int N, int G_, int c_) { nM = M / BM; nN = N / BM; nwg = nM * nN; G = G_; c = c_; }
    __host__ __device__ bool next(int i, Unit& u) const {
        const long L = (long)i * G + c; if (L >= nwg) return false;
        int wgid = (int)L; { const int q = nwg / NXCD, r = nwg % NXCD, xcd = wgid % NXCD, off = wgid / NXCD; wgid = (xcd < r ? xcd * (q + 1) : r * (q + 1) + (xcd - r) * q) + off; }
        const int nig = WGM * nN, gid = wgid / nig, fm = gid * WGM, gsz = (nM - fm) < WGM ? (nM - fm) : WGM;
        u.pm = fm + ((wgid % nig) % gsz); u.pn = (wgid % nig) / gsz; return true;
    }
    __device__ __forceinline__ void a_ready(const Unit&) const {}
    __device__ __forceinline__ void done(const Unit&) const {}
};

typedef float f32x2_cv __attribute__((ext_vector_type(2))); typedef __bf16 bf16x2_cv __attribute__((ext_vector_type(2)));
__device__ __forceinline__ unsigned cvt_pk_bf16(float lo, float hi) { f32x2_cv v = {lo, hi}; bf16x2_cv b = __builtin_convertvector(v, bf16x2_cv); return __builtin_bit_cast(unsigned, b); }
template <class F> struct EpiRow8L {
    static constexpr bool PERM = true, AFTER_DRAIN = false; F f;
    __device__ __forceinline__ void operator()(const f32x4 (&acc)[2][2][4][2], const Unit& u, int wr, int wc, int fr, int fq) const {
        const int row0 = u.pm * BM + wr * 64 + fr, col0 = u.pn * BM + wc * 32 + 8 * fq;
#pragma unroll
        for (int ai = 0; ai < 2; ++ai) { typename F::Ctx c[4][2];
#pragma unroll
            for (int m = 0; m < 4; ++m)
#pragma unroll
                for (int bj = 0; bj < 2; ++bj) c[m][bj] = f.load(row0 + ai * HALF + m * 16, col0 + bj * HALF);
#pragma unroll
            for (int m = 0; m < 4; ++m)
#pragma unroll
                for (int bj = 0; bj < 2; ++bj) f.apply(c[m][bj], row0 + ai * HALF + m * 16, col0 + bj * HALF, acc[ai][bj][m][0], acc[ai][bj][m][1]); }
    }
};
template <class F> struct EpiRow8 {
    static constexpr bool PERM = true, AFTER_DRAIN = false; F f;
    __device__ __forceinline__ void operator()(const f32x4 (&acc)[2][2][4][2], const Unit& u, int wr, int wc, int fr, int fq) const {
        const int row0 = u.pm * BM + wr * 64 + fr, col0 = u.pn * BM + wc * 32 + 8 * fq;
#pragma unroll
        for (int ai = 0; ai < 2; ++ai)
#pragma unroll
            for (int m = 0; m < 4; ++m)
#pragma unroll
                for (int bj = 0; bj < 2; ++bj) f(row0 + ai * HALF + m * 16, col0 + bj * HALF, acc[ai][bj][m][0], acc[ai][bj][m][1]);
    }
};
template <class Epi, class Sched, bool ALIGN_EPI = false, bool SP2 = false>
__device__ __forceinline__ void gemm_phase(PG8_LAS unsigned char* lds, const Gemm g, const Sched& S, const Epi& E) {
    int tid_ = threadIdx.x; asm volatile("" : "+v"(tid_));
    const int tid = tid_, wid = __builtin_amdgcn_readfirstlane(tid >> 6), lane = tid & 63, wr = wid >> 2, wc = wid & 3, fr = lane & 15, fq = lane >> 4;
    const int K = g.K, nt = K / BK;
    unsigned voffA[2], voffB[2];
#pragma unroll
    for (int i = 0; i < 2; ++i) { int R, C; stage_rc(tid * 16 + i * 8192, R, C); const int Rb = Epi::PERM ? ((R & ~31) + perm32(R & 31)) : R;
        voffA[i] = (unsigned)(R * K + C) * 2u; voffB[i] = (unsigned)(Rb * K + C) * 2u; }
    const size_t kstep = (size_t)(BK * 2);
    const size_t hstep = (size_t)HALF * K * 2;
    const size_t tstep = 2 * hstep;
    const unsigned ldsw = (unsigned)wid * 1024u;
    const int aoff = lds_byte(wr * 64 + fr, fq * 8), boff = lds_byte(wc * 32 + fr, fq * 8);
#define PG8_SA(b, h) (((b) * 2 + (h)) * HTB)
#define PG8_SB(b, h) ((4 + (b) * 2 + (h)) * HTB)
#define PG8_STAGE(bufoff, gbase, voff) do { _Pragma("unroll") for (int _i = 0; _i < 2; ++_i) \
        __builtin_amdgcn_global_load_lds((const unsigned*)((const char*)(gbase) + (voff)[_i]), (PG8_LAS unsigned*)(lds + (bufoff) + ldsw + _i * 8192), 16, 0, 0); } while (0)
#define PG8_LDA(dst, b, h) do { _Pragma("unroll") for (int m = 0; m < 4; ++m) _Pragma("unroll") for (int k = 0; k < 2; ++k) dst[m][k] = *(const PG8_LAS bf16x8*)(lds + PG8_SA(b, h) + aoff + m * 2048 + k * 1024); } while (0)
#define PG8_LDB(dst, b, h) do { _Pragma("unroll") for (int n = 0; n < 2; ++n) _Pragma("unroll") for (int k = 0; k < 2; ++k) dst[n][k] = *(const PG8_LAS bf16x8*)(lds + PG8_SB(b, h) + boff + n * 2048 + k * 1024); } while (0)
#define PG8_MMA(ai, bj, At, Bt) do { __builtin_amdgcn_s_setprio(1); _Pragma("unroll") for (int m = 0; m < 4; ++m) _Pragma("unroll") for (int n = 0; n < 2; ++n) _Pragma("unroll") for (int k = 0; k < 2; ++k) \
        acc[ai][bj][m][n] = __builtin_amdgcn_mfma_f32_16x16x32_bf16(Bt[n][k], At[m][k], acc[ai][bj][m][n], 0, 0, 0); __builtin_amdgcn_s_setprio(0); } while (0)
#define PG8_WAIT_V(n) asm volatile("s_waitcnt vmcnt(" #n ")" ::: "memory")
#define PG8_WAIT_L(n) asm volatile("s_waitcnt lgkmcnt(" #n ")" ::: "memory")
#define PG8_BAR __builtin_amdgcn_s_barrier()
#define PG8_SCHED __builtin_amdgcn_sched_barrier(0)
    Unit cur, nxt; int ui = 0;
    if (!S.next(0, cur)) return;
    f32x4 acc[2][2][4][2];
#pragma unroll
    for (int a = 0; a < 2; ++a)
#pragma unroll
        for (int b = 0; b < 2; ++b)
#pragma unroll
            for (int m = 0; m < 4; ++m)
#pragma unroll
                for (int n = 0; n < 2; ++n) acc[a][b][m][n] = (f32x4){0.f, 0.f, 0.f, 0.f};
    bf16x8 At[4][2], B0[2][2], B1[2][2];
    const char* cA = (const char*)g.A + (size_t)cur.pm * tstep; const char* cB = (const char*)g.Bt + (size_t)cur.pn * tstep;
    S.a_ready(cur);
    if constexpr (SP2) {
        PG8_STAGE(PG8_SB(0, 0), cB, voffB); PG8_STAGE(PG8_SB(0, 1), cB + hstep, voffB); PG8_STAGE(PG8_SA(0, 0), cA, voffA); PG8_STAGE(PG8_SA(0, 1), cA + hstep, voffA);
        if (wr == 1) PG8_BAR;
        PG8_WAIT_V(2); PG8_BAR;
        PG8_STAGE(PG8_SB(1, 0), cB + kstep, voffB); PG8_STAGE(PG8_SA(1, 0), cA + kstep, voffA); PG8_STAGE(PG8_SB(1, 1), cB + hstep + kstep, voffB);
        PG8_WAIT_V(6); PG8_BAR;
    } else {
        PG8_STAGE(PG8_SB(0, 0), cB, voffB); PG8_STAGE(PG8_SA(0, 0), cA, voffA); PG8_STAGE(PG8_SB(0, 1), cB + hstep, voffB); PG8_STAGE(PG8_SA(0, 1), cA + hstep, voffA);
        if (wr == 1) PG8_BAR;
        PG8_WAIT_V(4); PG8_BAR;
        PG8_STAGE(PG8_SB(1, 0), cB + kstep, voffB); PG8_STAGE(PG8_SA(1, 0), cA + kstep, voffA); PG8_STAGE(PG8_SB(1, 1), cB + hstep + kstep, voffB);
        PG8_WAIT_V(6); PG8_BAR;
    }
    for (;;) {
        const bool has_next = S.next(ui + 1, nxt);
        const char* nA = has_next ? (const char*)g.A + (size_t)nxt.pm * tstep : cA; const char* nB = has_next ? (const char*)g.Bt + (size_t)nxt.pn * tstep : cB;
        for (int t = 0; t < nt; t += 2) {
            const bool last = (t == nt - 2);
            const char* a1 = cA + (size_t)(t + 1) * kstep;
            const char* a2 = last ? nA : cA + (size_t)(t + 2) * kstep; const char* b2 = last ? nB : cB + (size_t)(t + 2) * kstep;
            const char* a3 = a2 + kstep; const char* b3 = b2 + kstep;
            if (last && has_next) S.a_ready(nxt);
            if constexpr (SP2) {
            PG8_LDB(B0, 0, 0); PG8_LDB(B1, 0, 1); PG8_SCHED; PG8_LDA(At, 0, 0); PG8_STAGE(PG8_SA(1, 1), a1 + hstep, voffA);
            PG8_WAIT_V(8); PG8_WAIT_L(0); PG8_BAR; PG8_MMA(0, 0, At, B0); PG8_MMA(0, 1, At, B1); PG8_BAR; PG8_SCHED;
            PG8_LDA(At, 0, 1); PG8_STAGE(PG8_SB(0, 0), b2, voffB); PG8_STAGE(PG8_SB(0, 1), b2 + hstep, voffB); PG8_STAGE(PG8_SA(0, 0), a2, voffA);
            PG8_WAIT_V(8); PG8_WAIT_L(0); PG8_BAR; PG8_MMA(1, 0, At, B0); PG8_MMA(1, 1, At, B1); PG8_BAR; PG8_SCHED;
            PG8_LDB(B0, 1, 0); PG8_LDB(B1, 1, 1); PG8_SCHED; PG8_LDA(At, 1, 0); PG8_STAGE(PG8_SA(0, 1), a2 + hstep, voffA);
            PG8_WAIT_V(8); PG8_WAIT_L(0); PG8_BAR; PG8_MMA(0, 0, At, B0); PG8_MMA(0, 1, At, B1); PG8_BAR; PG8_SCHED;
            PG8_LDA(At, 1, 1); PG8_STAGE(PG8_SB(1, 0), b3, voffB); PG8_STAGE(PG8_SB(1, 1), b3 + hstep, voffB); PG8_STAGE(PG8_SA(1, 0), a3, voffA);
            PG8_WAIT_V(8); PG8_WAIT_L(0); PG8_BAR; PG8_MMA(1, 0, At, B0); PG8_MMA(1, 1, At, B1); PG8_BAR; PG8_SCHED;
            } else {
            PG8_LDB(B0, 0, 0); PG8_SCHED; PG8_LDA(At, 0, 0); PG8_STAGE(PG8_SA(1, 1), a1 + hstep, voffA);
            PG8_WAIT_L(8); PG8_BAR; PG8_WAIT_L(0); PG8_MMA(0, 0, At, B0); PG8_BAR; PG8_SCHED;
            PG8_LDB(B1, 0, 1); PG8_STAGE(PG8_SB(0, 0), b2, voffB);
            PG8_BAR; PG8_WAIT_L(0); PG8_MMA(0, 1, At, B1); PG8_BAR;
            PG8_LDA(At, 0, 1); PG8_STAGE(PG8_SA(0, 0), a2, voffA);
            PG8_BAR; PG8_WAIT_L(0); PG8_MMA(1, 0, At, B0); PG8_BAR; PG8_SCHED;
            PG8_STAGE(PG8_SB(0, 1), b2 + hstep, voffB);
            PG8_WAIT_V(6); PG8_BAR; PG8_MMA(1, 1, At, B1); PG8_BAR;
            PG8_LDB(B0, 1, 0); PG8_SCHED; PG8_LDA(At, 1, 0); PG8_STAGE(PG8_SA(0, 1), a2 + hstep, voffA);
            PG8_WAIT_L(8); PG8_BAR; PG8_WAIT_L(0); PG8_MMA(0, 0, At, B0); PG8_BAR; PG8_SCHED;
            PG8_LDB(B1, 1, 1); PG8_STAGE(PG8_SB(1, 0), b3, voffB);
            PG8_BAR; PG8_WAIT_L(0); PG8_MMA(0, 1, At, B1); PG8_BAR;
            PG8_LDA(At, 1, 1); PG8_STAGE(PG8_SA(1, 0), a3, voffA);
            PG8_BAR; PG8_WAIT_L(0); PG8_MMA(1, 0, At, B0); PG8_BAR; PG8_SCHED;
            PG8_STAGE(PG8_SB(1, 1), b3 + hstep, voffB);
            PG8_WAIT_V(6); PG8_BAR; PG8_MMA(1, 1, At, B1); PG8_BAR;
            }
        }
        if constexpr (ALIGN_EPI) { if (wr == 0) PG8_BAR; }
        if constexpr (!Epi::AFTER_DRAIN) { E(acc, cur, wr, wc, fr, fq); S.done(cur); }
        if (!has_next) break;
#pragma unroll
        for (int a = 0; a < 2; ++a)
#pragma unroll
            for (int b = 0; b < 2; ++b)
#pragma unroll
                for (int m = 0; m < 4; ++m)
#pragma unroll
                    for (int n = 0; n < 2; ++n) acc[a][b][m][n] = (f32x4){0.f, 0.f, 0.f, 0.f};
        cur = nxt; cA = nA; cB = nB; ++ui;
        if constexpr (ALIGN_EPI) { if (wr == 1) PG8_BAR; }
    }
    PG8_WAIT_V(0);
    if constexpr (!ALIGN_EPI) { if (wr == 0) PG8_BAR; }
    PG8_BAR;
    if constexpr (Epi::AFTER_DRAIN) { E.fused(acc, cur, wr, wc, fr, fq, lds, wid, lane); S.done(cur); }
#undef PG8_SA
#undef PG8_SB
#undef PG8_STAGE
#undef PG8_LDA
#undef PG8_LDB
#undef PG8_MMA
#undef PG8_WAIT_V
#undef PG8_WAIT_L
#undef PG8_BAR
#undef PG8_SCHED
}
}

#define LAS __attribute__((address_space(3)))
typedef unsigned short bf16;
typedef short bf16x8 __attribute__((ext_vector_type(8)));
typedef short s16x4 __attribute__((ext_vector_type(4)));
typedef float f32x4 __attribute__((ext_vector_type(4)));
typedef float f32x16 __attribute__((ext_vector_type(16)));
typedef unsigned u32x4 __attribute__((ext_vector_type(4)));
typedef unsigned u32x2 __attribute__((ext_vector_type(2)));

constexpr int DM = 2048, TG = 16384, NPROJ = 12800, NP1 = 13056, NP1B = 8192, DFF = 5632;
constexpr int C_DAQ = 0, C_DAK = 2048, C_DAV = 4096, C_GDN = 6144, C_XAQ = 12288;
constexpr float EPS = 1e-6f, LOG2E = 1.4426950408889634f, QSCALE = 0.08838834764831845f * 1.4426950408889634f;
constexpr int NTHR = 512, NWV = 8;

constexpr size_t WS_CTL = 0, WS_H = 65536, WS_AB = WS_H + (size_t)TG * DM * 2, WS_MEMN = WS_AB + (size_t)TG * 64 * 4,
                 WS_MEMKV = WS_MEMN + (size_t)1024 * DM * 2, WS_COUT = WS_MEMKV + (size_t)1024 * 1024 * 2, WS_GDNB = WS_COUT + (size_t)TG * 512 * 2,
                 WS_W = WS_GDNB + (size_t)TG * DM * 2, WS_BIG = WS_W + (size_t)69206016, WS_HALO = WS_BIG + (size_t)TG * NPROJ * 2, WS_SSQ = WS_HALO + (size_t)256 * 4 * 6144 * 2, WS_END = WS_SSQ + (size_t)TG * 16 * 4;
constexpr size_t W_WINA = 0, W_WMKV = (size_t)NP1 * DM * 2;
constexpr size_t W_WINB = 0, W_PA = (size_t)NP1B * DM * 2, W_PD = W_PA + (size_t)DM * DM * 2, W_PM = W_PD + (size_t)DM * DM * 2, W_WO = W_PM + (size_t)DM * 512 * 2;
constexpr size_t W_UP = 0, W_DOWN = (size_t)2 * DFF * DM * 2;
static_assert(W_WO + (size_t)DM * DM * 2 <= 69206016 && W_DOWN + (size_t)DM * DFF * 2 <= 69206016 && W_WMKV + (size_t)1024 * DM * 2 <= 69206016, "R_W");
constexpr int LDS_BYTES = 159744;

struct Params {
    const float* x[2]; const float* mem[2]; float* out[2];
    const float *g_mix, *g_mem, *w_in, *b_gate, *da_q_norm, *da_k_norm, *da_lambda, *da_subln, *gdn_conv_w, *gdn_A_log, *gdn_dt_bias, *gdn_out_norm,
                *xa_q_norm, *xa_k_norm, *w_mem_kv, *p_attn, *p_gdn, *p_mem, *w_o, *g_ffn, *w_up, *ffn_conv_w, *ffn_conv_b, *w_down;
    unsigned char* ws;
};

constexpr int LDS_TBL = 0, LDS_WQ = 256, LDS_PH = 512;
enum { T_X0, T_X1, T_MEM0, T_MEM1, T_OUT0, T_OUT1, T_GMIX, T_GMEM, T_WIN, T_BGATE, T_DAQN, T_DAKN, T_DALAM, T_DASUB, T_GCONV, T_GALOG, T_GDT, T_GON, T_XQN, T_XKN, T_WMKV, T_PA, T_PD, T_PM, T_WO, T_GFFN, T_WUP, T_FCW, T_FCB, T_WDOWN, T_WS, T_N };
__device__ __forceinline__ const float* tptr(const LAS unsigned char* lds, int i) {
    const LAS unsigned* t = (const LAS unsigned*)(lds + LDS_TBL) + 2 * i; unsigned lo = t[0], hi = t[1];
    lo = __builtin_amdgcn_readfirstlane(lo); hi = __builtin_amdgcn_readfirstlane(hi);
    return (const float*)(((unsigned long long)hi << 32) | (unsigned long long)lo);
}
__device__ __forceinline__ unsigned f2bf(float f) { return pg8::cvt_pk_bf16(f, 0.f) & 0xffffu; }
__device__ __forceinline__ unsigned pk2(float lo, float hi) { return pg8::cvt_pk_bf16(lo, hi); }
__device__ __forceinline__ float bf2f(unsigned short b) { return __builtin_bit_cast(float, (unsigned)b << 16); }
__device__ __forceinline__ float bflo(unsigned w) { return __builtin_bit_cast(float, w << 16); }
__device__ __forceinline__ float bfhi(unsigned w) { return __builtin_bit_cast(float, w & 0xffff0000u); }
__device__ __forceinline__ float wave_sum(float v) {
#pragma unroll
    for (int o = 1; o < 64; o <<= 1) v += __shfl_xor(v, o);
    return v;
}
__device__ __forceinline__ void unpack8(u32x4 w, float* f) { f[0] = bflo(w.x); f[1] = bfhi(w.x); f[2] = bflo(w.y); f[3] = bfhi(w.y); f[4] = bflo(w.z); f[5] = bfhi(w.z); f[6] = bflo(w.w); f[7] = bfhi(w.w); }
__device__ __forceinline__ u32x4 pack8(const float* f) { u32x4 w; w.x = pk2(f[0], f[1]); w.y = pk2(f[2], f[3]); w.z = pk2(f[4], f[5]); w.w = pk2(f[6], f[7]); return w; }
__device__ __forceinline__ float sigmoidf_(float x) { return __builtin_amdgcn_rcpf(1.f + __expf(-x)); }
__device__ __forceinline__ float rsq_(float x) { return __builtin_amdgcn_rsqf(x); }

__device__ __forceinline__ void transpose_job(const float* W, int ldw, int col0, int ncols, int K, bf16* WT, int row0, LAS float* scr, int gw, int NGW, int lane) {
    typedef float f32x2t __attribute__((ext_vector_type(2)));
    const int nblk = ncols / 64, nitems = (K / 64) * nblk;
    const int lr = lane >> 4, lc = (lane & 15) * 4;
    const int sn = lane >> 3, sc = lane & 7;
#ifndef TR_REPS
#define TR_REPS 1
#endif
    for (int rp_ = 0; rp_ < TR_REPS; ++rp_)
    for (int item = gw; item < nitems; item += NGW) {
        const int kb = item / nblk, nb = item - kb * nblk, k0 = 64 * kb, n0 = 64 * nb;
        const float* src = W + (size_t)(k0 + lr) * ldw + col0 + n0 + lc;
        f32x4 v[16];
#pragma unroll
        for (int i = 0; i < 16; ++i) v[i] = *(const f32x4*)(src + (size_t)(4 * i) * ldw);
#pragma unroll
        for (int i = 0; i < 16; ++i) { LAS float* d = scr + (4 * i + lr) * 66 + lc; *(LAS f32x2t*)d = (f32x2t){v[i].x, v[i].y}; *(LAS f32x2t*)(d + 2) = (f32x2t){v[i].z, v[i].w}; }
        asm volatile("s_waitcnt lgkmcnt(0)" ::: "memory");
#pragma unroll
        for (int j = 0; j < 8; ++j) { const int n = sn + 8 * j; const LAS float* s = scr + (8 * sc) * 66 + n;
            u32x4 o; o.x = pk2(s[0 * 66], s[1 * 66]); o.y = pk2(s[2 * 66], s[3 * 66]); o.z = pk2(s[4 * 66], s[5 * 66]); o.w = pk2(s[6 * 66], s[7 * 66]);
            *(u32x4*)(WT + (size_t)(row0 + n0 + n) * K + k0 + 8 * sc) = o; }
        asm volatile("s_waitcnt lgkmcnt(0)" ::: "memory");
    }
}
__device__ __forceinline__ void rms_row(const float* xrow, const float* gain, bf16* orow, int lane) {
    const f32x4* xr = (const f32x4*)xrow + lane; const f32x4* gr = (const f32x4*)gain + lane;
    f32x4 v[8]; float s = 0.f;
#pragma unroll
    for (int j = 0; j < 8; ++j) { v[j] = xr[64 * j]; s += (v[j].x * v[j].x + v[j].y * v[j].y) + (v[j].z * v[j].z + v[j].w * v[j].w); }
    const float inv = rsq_(wave_sum(s) * (1.f / DM) + EPS);
    u32x2* o8 = (u32x2*)orow + lane;
#pragma unroll
    for (int j = 0; j < 8; ++j) { const f32x4 g = gr[64 * j]; u32x2 w; w.x = pk2(v[j].x * inv * g.x, v[j].y * inv * g.y); w.y = pk2(v[j].z * inv * g.z, v[j].w * inv * g.w); o8[64 * j] = w; }
}

__device__ __forceinline__ u32x4 pack_v(f32x4 v0, f32x4 v1) { u32x4 w; w.x = pg8::cvt_pk_bf16(v0[0], v0[1]); w.y = pg8::cvt_pk_bf16(v0[2], v0[3]); w.z = pg8::cvt_pk_bf16(v1[0], v1[1]); w.w = pg8::cvt_pk_bf16(v1[2], v1[3]); return w; }
struct F_P1 { bf16* proj; float* ab;
    __device__ __forceinline__ void operator()(int row, int col, f32x4 v0, f32x4 v1) const {
        if (col < NPROJ) *(u32x4*)(proj + (size_t)row * NPROJ + col) = pack_v(v0, v1);
        else if (col < NPROJ + 64) { float* p = ab + (size_t)row * 64 + (col - NPROJ); *(f32x4*)p = v0; *(f32x4*)(p + 4) = v1; } } };
struct F_Bf16 { bf16* O; int ldc;
    __device__ __forceinline__ void operator()(int row, int col, f32x4 v0, f32x4 v1) const { *(u32x4*)(O + (size_t)row * ldc + col) = pack_v(v0, v1); } };
struct F_P1b { bf16* z; bf16* gates; const float* bg;
    struct Ctx { f32x4 b0, b1; };
    __device__ __forceinline__ Ctx load(int row, int col) const { Ctx c; const int c2 = col < DM ? 0 : col - DM; c.b0 = *(const f32x4*)(bg + c2); c.b1 = *(const f32x4*)(bg + c2 + 4); return c; }
    __device__ __forceinline__ void apply(const Ctx& c, int row, int col, f32x4 v0, f32x4 v1) const {
        if (col < DM) *(u32x4*)(z + (size_t)row * DM + col) = pack_v(v0, v1);
        else { const int c2 = col - DM;
#pragma unroll
            for (int e = 0; e < 4; ++e) { v0[e] = sigmoidf_(v0[e] + c.b0[e]); v1[e] = sigmoidf_(v1[e] + c.b1[e]); }
            *(u32x4*)(gates + (size_t)row * 6144 + c2) = pack_v(v0, v1); } } };
struct F_Merge { const bf16* gates; bf16* merged; int first;
    struct Ctx { u32x4 g, p; };
    __device__ __forceinline__ Ctx load(int row, int col) const { Ctx c; c.g = *(const u32x4*)(gates + (size_t)row * 6144 + col); c.p = first ? (u32x4){0u, 0u, 0u, 0u} : *(const u32x4*)(merged + (size_t)row * DM + col); return c; }
    __device__ __forceinline__ void apply(const Ctx& c, int row, int col, f32x4 v0, f32x4 v1) const {
        float g[8], pv[8], r[8]; unpack8(c.g, g); unpack8(c.p, pv);
#pragma unroll
        for (int e = 0; e < 4; ++e) { r[e] = fmaf(g[e], v0[e], pv[e]); r[4 + e] = fmaf(g[4 + e], v1[e], pv[4 + e]); }
        *(u32x4*)(merged + (size_t)row * DM + col) = pack8(r); } };
struct F_Wo { const float* x; float* out;
    struct Ctx { f32x4 a, b; };
    __device__ __forceinline__ Ctx load(int row, int col) const { Ctx c; const size_t o = (size_t)row * DM + col; c.a = *(const f32x4*)(x + o); c.b = *(const f32x4*)(x + o + 4); return c; }
    __device__ __forceinline__ void apply(const Ctx& c, int row, int col, f32x4 v0, f32x4 v1) const {
        const size_t o = (size_t)row * DM + col; *(f32x4*)(out + o) = c.a + v0; *(f32x4*)(out + o + 4) = c.b + v1; } };
struct F_Up { bf16* gt; bf16* up;
    __device__ __forceinline__ void operator()(int row, int col, f32x4 v0, f32x4 v1) const {
        if (col < DFF) *(u32x4*)(gt + (size_t)row * DFF + col) = pack_v(v0, v1); else *(u32x4*)(up + (size_t)row * DFF + (col - DFF)) = pack_v(v0, v1); } };
struct F_Down { float* out;
    struct Ctx { f32x4 a, b; };
    __device__ __forceinline__ Ctx load(int row, int col) const { Ctx c; const size_t o = (size_t)row * DM + col; c.a = *(const f32x4*)(out + o); c.b = *(const f32x4*)(out + o + 4); return c; }
    __device__ __forceinline__ void apply(const Ctx& c, int row, int col, f32x4 v0, f32x4 v1) const {
        const size_t o = (size_t)row * DM + col; *(f32x4*)(out + o) = c.a + v0; *(f32x4*)(out + o + 4) = c.b + v1; } };

struct EpiP1 {
    static constexpr bool PERM = true, AFTER_DRAIN = false;
    bf16* proj; float* ab; const float* gq; const float* gk; const float* gx; LAS float* exch; bf16* halo;
    __device__ __forceinline__ void operator()(const pg8::f32x4 (&acc)[2][2][4][2], const pg8::Unit& u, int wr, int wc, int fr, int fq) const {
        const int colt = u.pn * 256, row0 = u.pm * 256 + wr * 64 + fr, col0 = colt + wc * 32 + 8 * fq;
        const bool normed = (colt < C_DAV) || (colt >= C_XAQ && colt < NPROJ);
        if (normed) {
#pragma unroll
            for (int ai = 0; ai < 2; ++ai)
#pragma unroll
                for (int m = 0; m < 4; ++m)
#pragma unroll
                    for (int bj = 0; bj < 2; ++bj) { const pg8::f32x4 a = acc[ai][bj][m][0], b = acc[ai][bj][m][1];
                        float s = (a[0] * a[0] + a[1] * a[1]) + (a[2] * a[2] + a[3] * a[3]) + (b[0] * b[0] + b[1] * b[1]) + (b[2] * b[2] + b[3] * b[3]);
                        s += __shfl_xor(s, 16); s += __shfl_xor(s, 32);
                        if (fq == 0) exch[((ai * 128 + wr * 64 + m * 16 + fr) * 2 + bj) * 4 + wc] = s; }
            asm volatile("s_waitcnt lgkmcnt(0)" ::: "memory"); __builtin_amdgcn_s_barrier(); asm volatile("" ::: "memory");
            const float scale = (colt >= C_DAK && colt < C_DAV) ? 1.f : QSCALE; const int go = wc * 32 + 8 * fq;
            f32x4 g0, g1;
            if (colt < C_DAK) { g0 = *(const f32x4*)(gq + go); g1 = *(const f32x4*)(gq + go + 4); }
            else if (colt < C_DAV) { g0 = *(const f32x4*)(gk + go); g1 = *(const f32x4*)(gk + go + 4); }
            else { g0 = *(const f32x4*)(gx + go); g1 = *(const f32x4*)(gx + go + 4); }
#pragma unroll
            for (int ai = 0; ai < 2; ++ai)
#pragma unroll
                for (int m = 0; m < 4; ++m)
#pragma unroll
                    for (int bj = 0; bj < 2; ++bj) { const f32x4 t = *(const LAS f32x4*)(exch + ((ai * 128 + wr * 64 + m * 16 + fr) * 2 + bj) * 4);
                        const float inv = (rsq_(((t[0] + t[1]) + (t[2] + t[3])) * (1.f / 128.f) + EPS)) * scale;
                        pg8::f32x4 a = acc[ai][bj][m][0], b = acc[ai][bj][m][1];
#pragma unroll
                        for (int e = 0; e < 4; ++e) { a[e] *= inv * g0[e]; b[e] *= inv * g1[e]; }
                        *(u32x4*)(proj + (size_t)(row0 + ai * 128 + m * 16) * NPROJ + col0 + bj * 128) = pack_v(a, b); }
        } else {
#pragma unroll
            for (int ai = 0; ai < 2; ++ai)
#pragma unroll
                for (int m = 0; m < 4; ++m)
#pragma unroll
                    for (int bj = 0; bj < 2; ++bj) { const int row = row0 + ai * 128 + m * 16, col = col0 + bj * 128;
                        if (col < NPROJ) { const u32x4 w = pack_v(acc[ai][bj][m][0], acc[ai][bj][m][1]); *(u32x4*)(proj + (size_t)row * NPROJ + col) = w;
                            if (col >= C_GDN && col < C_XAQ) { const int r64 = row & 63;
                                if (r64 < 2 || r64 >= 62) *(u32x4*)(halo + ((size_t)(row >> 6) * 4 + (r64 < 2 ? r64 : r64 - 60)) * 6144 + (col - C_GDN)) = w; } }
                        else if (col < NPROJ + 64) { float* p = ab + (size_t)row * 64 + (col - NPROJ); *(f32x4*)p = acc[ai][bj][m][0]; *(f32x4*)(p + 4) = acc[ai][bj][m][1]; } }
        }
    }
};
struct EpiMKV {
    static constexpr bool PERM = true, AFTER_DRAIN = false;
    bf16* O; const float* gk; LAS float* exch;
    __device__ __forceinline__ void operator()(const pg8::f32x4 (&acc)[2][2][4][2], const pg8::Unit& u, int wr, int wc, int fr, int fq) const {
        const int colt = u.pn * 256, row0 = u.pm * 256 + wr * 64 + fr, col0 = colt + wc * 32 + 8 * fq;
        const bool normed = colt < 512;
        if (normed) {
#pragma unroll
            for (int ai = 0; ai < 2; ++ai)
#pragma unroll
                for (int m = 0; m < 4; ++m)
#pragma unroll
                    for (int bj = 0; bj < 2; ++bj) { const pg8::f32x4 a = acc[ai][bj][m][0], b = acc[ai][bj][m][1];
                        float s = (a[0] * a[0] + a[1] * a[1]) + (a[2] * a[2] + a[3] * a[3]) + (b[0] * b[0] + b[1] * b[1]) + (b[2] * b[2] + b[3] * b[3]);
                        s += __shfl_xor(s, 16); s += __shfl_xor(s, 32);
                        if (fq == 0) exch[((ai * 128 + wr * 64 + m * 16 + fr) * 2 + bj) * 4 + wc] = s; }
            asm volatile("s_waitcnt lgkmcnt(0)" ::: "memory"); __builtin_amdgcn_s_barrier(); asm volatile("" ::: "memory");
        }
        const int go = wc * 32 + 8 * fq; const f32x4 g0 = *(const f32x4*)(gk + go), g1 = *(const f32x4*)(gk + go + 4);
#pragma unroll
        for (int ai = 0; ai < 2; ++ai)
#pragma unroll
            for (int m = 0; m < 4; ++m)
#pragma unroll
                for (int bj = 0; bj < 2; ++bj) { pg8::f32x4 a = acc[ai][bj][m][0], b = acc[ai][bj][m][1];
                    if (normed) { const f32x4 t = *(const LAS f32x4*)(exch + ((ai * 128 + wr * 64 + m * 16 + fr) * 2 + bj) * 4);
                        const float inv = rsq_(((t[0] + t[1]) + (t[2] + t[3])) * (1.f / 128.f) + EPS);
#pragma unroll
                        for (int e = 0; e < 4; ++e) { a[e] *= inv * g0[e]; b[e] *= inv * g1[e]; } }
                    *(u32x4*)(O + (size_t)(row0 + ai * 128 + m * 16) * 1024 + col0 + bj * 128) = pack_v(a, b); }
    }
};
template <class F> __device__ __forceinline__ void run_gemm(LAS unsigned char* lds, const bf16* A, const bf16* Bt, int M, int N, int K, const F& f) {
    pg8::Gemm g{A, Bt, M, N, K}; pg8::StaticOrder S; S.init(M, N, (int)gridDim.x, (int)blockIdx.x);
    pg8::EpiRow8<F> E{f};
#ifndef NO_GEMM
    pg8::gemm_phase<pg8::EpiRow8<F>, pg8::StaticOrder, true, true>(lds, g, S, E);
#endif
}
template <class F> __device__ __forceinline__ void run_gemm_l(LAS unsigned char* lds, const bf16* A, const bf16* Bt, int M, int N, int K, const F& f) {
    pg8::Gemm g{A, Bt, M, N, K}; pg8::StaticOrder S; S.init(M, N, (int)gridDim.x, (int)blockIdx.x);
    pg8::EpiRow8L<F> E{f};
#ifndef NO_GEMM
    pg8::gemm_phase<pg8::EpiRow8L<F>, pg8::StaticOrder, true, true>(lds, g, S, E);
#endif
}

namespace att {
constexpr int D = 128, NW = 8, QBLK = 32, KVBLK = 64;
constexpr int SHM_V = KVBLK * D * 2, SHM_K = KVBLK * D * 2, SHM_ATTN = 2 * SHM_V + 2 * SHM_K + NW * 64 * 4;
constexpr int OFF_STASH = SHM_ATTN, OFF_SSQ = OFF_STASH + 65536, ATT_LDS = OFF_SSQ + 1024;
constexpr float THR2 = 11.5f;
#define KSWZ(row, colB) ((row) * 256 + ((colB) ^ (((row) & 7) << 4)))
#define SBAR() __builtin_amdgcn_sched_barrier(0)
__device__ __forceinline__ int crow(int r, int hi) { return (r & 3) + 8 * (r >> 2) + 4 * hi; }
__device__ __forceinline__ unsigned cvtpk(float lo, float hi) { return pg8::cvt_pk_bf16(lo, hi); }

template <bool ALIBI>
__device__ __forceinline__ void partialSM(f32x16& p0, f32x16& p1, float& m_reg, float& mn, float& alpha, float dq, float slope2, int mode) {
  float b0 = 0.f, b1 = 0.f;
  if (ALIBI) {
    if (mode != 0) {
      const float sl = mode > 0 ? slope2 : -slope2;
#pragma unroll
      for (int r = 0; r < 16; ++r) { const float c = (float)((r & 3) + 8 * (r >> 2)); p0[r] = fmaf(sl, c, p0[r]); p1[r] = fmaf(sl, c, p1[r]); }
      b0 = -sl * dq; b1 = -sl * (dq - 32.f);
    } else {
#pragma unroll
      for (int r = 0; r < 16; ++r) { const float c = (float)((r & 3) + 8 * (r >> 2)); p0[r] = fmaf(-slope2, fabsf(dq - c), p0[r]); p1[r] = fmaf(-slope2, fabsf(dq - 32.f - c), p1[r]);
        if ((r & 3) == 3) SBAR(); }
    }
  }
  float pm0 = p0[0], pm1 = p1[0];
#pragma unroll
  for (int r = 1; r < 16; ++r) { pm0 = fmaxf(pm0, p0[r]); pm1 = fmaxf(pm1, p1[r]); }
  float pmax = fmaxf(pm0 + b0, pm1 + b1);
  { auto rr = __builtin_amdgcn_permlane32_swap(__float_as_uint(pmax), __float_as_uint(pmax), false, false);
    pmax = fmaxf(__uint_as_float(rr[0]), __uint_as_float(rr[1])); }
  if (__builtin_expect(__all(pmax - m_reg <= THR2), 1)) { mn = m_reg; alpha = 1.f; }
  else { mn = fmaxf(m_reg, pmax); alpha = __builtin_amdgcn_exp2f(m_reg - mn); m_reg = mn; }
  const float d0 = b0 - mn, d1 = b1 - mn;
#pragma unroll
  for (int r = 0; r < 16; ++r) p0[r] = p0[r] + d0;
#pragma unroll
  for (int r = 0; r < 16; ++r) p1[r] = p1[r] + d1;
#pragma unroll
  for (int r = 0; r < 16; ++r) p0[r] = __builtin_amdgcn_exp2f(p0[r]);
}
__device__ __forceinline__ void finishSM(f32x16& p0, f32x16& p1, float alpha, float& l_reg, bf16x8& pa0, bf16x8& pa1, bf16x8& pa2, bf16x8& pa3) {
#pragma unroll
  for (int r = 0; r < 16; ++r) p1[r] = __builtin_amdgcn_exp2f(p1[r]);
  float ps = 0;
#pragma unroll
  for (int r = 0; r < 16; ++r) ps += p0[r];
#pragma unroll
  for (int r = 0; r < 16; ++r) ps += p1[r];
  { auto rr = __builtin_amdgcn_permlane32_swap(__float_as_uint(ps), __float_as_uint(ps), false, false);
    ps = __uint_as_float(rr[0]) + __uint_as_float(rr[1]); }
  l_reg = l_reg * alpha + ps;
#define PK4(P, BASE, OUT) do { unsigned a0 = cvtpk(P[BASE + 0], P[BASE + 1]), a1 = cvtpk(P[BASE + 2], P[BASE + 3]);   \
    unsigned b0 = cvtpk(P[BASE + 4], P[BASE + 5]), b1 = cvtpk(P[BASE + 6], P[BASE + 7]);                              \
    auto r0 = __builtin_amdgcn_permlane32_swap(a0, b0, false, false); auto r1 = __builtin_amdgcn_permlane32_swap(a1, b1, false, false); \
    u32x4 w = {r0[0], r1[0], r0[1], r1[1]}; OUT = *reinterpret_cast<bf16x8*>(&w); } while (0)
  PK4(p0, 0, pa0); PK4(p0, 8, pa1); PK4(p1, 0, pa2); PK4(p1, 8, pa3);
#undef PK4
}
__device__ __forceinline__ void qkt(f32x16& p0, f32x16& p1, const bf16* Ks, const bf16x8* qr, int r32, int hi) {
  p0 = f32x16{}; p1 = f32x16{};
#pragma unroll
  for (int d0 = 0; d0 < 8; ++d0) { int cb = (d0 * 16 + hi * 8) * 2;
    bf16x8 b0 = *reinterpret_cast<const bf16x8*>((const char*)Ks + KSWZ(r32, cb));
    bf16x8 b1 = *reinterpret_cast<const bf16x8*>((const char*)Ks + KSWZ(32 + r32, cb));
    p0 = __builtin_amdgcn_mfma_f32_32x32x16_bf16(b0, qr[d0], p0, 0, 0, 0);
    p1 = __builtin_amdgcn_mfma_f32_32x32x16_bf16(b1, qr[d0], p1, 0, 0, 0); }
}
__device__ __forceinline__ int v_st(int k, int c) { const int kk = (k & ~0xC) | ((k & 4) << 1) | ((k & 8) >> 1); return ((kk >> 3) * 4 + (c >> 5)) * 512 + ((kk & 7) * 32 + (c & 31)) * 2; }
__device__ __forceinline__ int v_rd_base(int lane) { return ((lane & 3) << 3) | (((lane >> 2) & 3) << 6) | (((lane >> 4) & 1) << 5) | (((lane >> 5) & 1) << 8); }
constexpr int v_rd_off(int d0, int ks, int half) { return d0 * 512 + ks * 4096 + half * 2048; }
template <int OFF> __device__ __forceinline__ s16x4 tr_read(int vb) {
  s16x4 r; asm volatile("ds_read_b64_tr_b16 %0, %1 offset:%2" : "=&v"(r) : "v"(vb), "i"(OFF) : "memory"); return r;
}
template <int D0> __device__ __forceinline__ void pv_one(f32x16& od, int vb, bf16x8 pa0, bf16x8 pa1, bf16x8 pa2, bf16x8 pa3) {
  const s16x4 l0 = tr_read<v_rd_off(D0, 0, 0)>(vb), h0 = tr_read<v_rd_off(D0, 0, 1)>(vb), l1 = tr_read<v_rd_off(D0, 1, 0)>(vb), h1 = tr_read<v_rd_off(D0, 1, 1)>(vb);
  const s16x4 l2 = tr_read<v_rd_off(D0, 2, 0)>(vb), h2 = tr_read<v_rd_off(D0, 2, 1)>(vb), l3 = tr_read<v_rd_off(D0, 3, 0)>(vb), h3 = tr_read<v_rd_off(D0, 3, 1)>(vb);
  asm volatile("s_waitcnt lgkmcnt(0)" ::: "memory"); SBAR();
#define PK(L, H) (bf16x8){L[0], L[1], L[2], L[3], H[0], H[1], H[2], H[3]}
  od = __builtin_amdgcn_mfma_f32_32x32x16_bf16(pa0, PK(l0, h0), od, 0, 0, 0);
  od = __builtin_amdgcn_mfma_f32_32x32x16_bf16(pa1, PK(l1, h1), od, 0, 0, 0);
  od = __builtin_amdgcn_mfma_f32_32x32x16_bf16(pa2, PK(l2, h2), od, 0, 0, 0);
  od = __builtin_amdgcn_mfma_f32_32x32x16_bf16(pa3, PK(l3, h3), od, 0, 0, 0);
#undef PK
}
__device__ __forceinline__ void pv_d0(f32x16* o, int vb, bf16x8 pa0, bf16x8 pa1, bf16x8 pa2, bf16x8 pa3) {
  pv_one<0>(o[0], vb, pa0, pa1, pa2, pa3); pv_one<1>(o[1], vb, pa0, pa1, pa2, pa3); pv_one<2>(o[2], vb, pa0, pa1, pa2, pa3); pv_one<3>(o[3], vb, pa0, pa1, pa2, pa3);
}

template <bool ALIBI>
__device__ __forceinline__ void attn_core(const bf16* __restrict__ Qb, int ldq, const bf16* __restrict__ Kh, const bf16* __restrict__ Vh, int ldk, int jlo, int jhi, char* lds,
                                          float slope2, int qpos0, f32x16 (&o)[4]) {
  int tid_ = threadIdx.x; asm volatile("" : "+v"(tid_));
  const int tid = tid_, wid = tid >> 6, lane = tid & 63, r32 = lane & 31, hi = lane >> 5;
  bf16* V_lds = (bf16*)lds; bf16* K_lds = (bf16*)(lds + 2 * SHM_V);
  float* ws = (float*)(lds + 2 * SHM_V + 2 * SHM_K) + wid * 64; float* li_l = ws; float* al_l = ws + 32;
  float m_reg = -1e30f, l_reg = 0; bf16x8 qr[8];
#pragma unroll
  for (int d = 0; d < 4; ++d) o[d] = f32x16{};
  const bf16* Qw = Qb + (long)(wid * QBLK + r32) * ldq + hi * 8;
#pragma unroll
  for (int d0 = 0; d0 < 8; ++d0) qr[d0] = *reinterpret_cast<const bf16x8*>(Qw + d0 * 16);
  const float dq0 = (float)(qpos0 + wid * QBLK + r32 - 4 * hi);
  const int qmin_w = __builtin_amdgcn_readfirstlane(qpos0 + wid * QBLK);
#define AMODE(j) ((((j) * KVBLK + 63) <= qmin_w) ? 1 : ((((j) * KVBLK) >= qmin_w + 31) ? -1 : 0))
  const int sr = tid >> 4, sc = (tid & 15) * 8, vst0 = v_st(sr, sc), vst1 = v_st(32 + sr, sc);
  const int vb0 = (int)(uintptr_t)V_lds + v_rd_base(lane);
  struct { bf16x8 vs0, vs1, ks0, ks1; } sr_[1];
  const unsigned voff = (unsigned)(sr * ldk + sc) * 2u;
#define SLOAD(i, k0) do { const char* vt_ = (const char*)Vh + (size_t)(k0) * ldk * 2; const char* kt_ = (const char*)Kh + (size_t)(k0) * ldk * 2; const size_t h32_ = (size_t)32 * ldk * 2; \
    sr_[i].vs0 = *reinterpret_cast<const bf16x8*>(vt_ + voff); sr_[i].vs1 = *reinterpret_cast<const bf16x8*>(vt_ + h32_ + voff); \
    sr_[i].ks0 = *reinterpret_cast<const bf16x8*>(kt_ + voff); sr_[i].ks1 = *reinterpret_cast<const bf16x8*>(kt_ + h32_ + voff); } while (0)
#define SWRITE(b, i) do { *(bf16x8*)((char*)V_lds + (b) * SHM_V + vst0) = sr_[i].vs0;          \
    *(bf16x8*)((char*)V_lds + (b) * SHM_V + vst1) = sr_[i].vs1; int kc = sc * 2;               \
    *(bf16x8*)((char*)K_lds + (b) * SHM_K + KSWZ(sr, kc)) = sr_[i].ks0;                       \
    *(bf16x8*)((char*)K_lds + (b) * SHM_K + KSWZ(32 + sr, kc)) = sr_[i].ks1; } while (0)
#define SWAIT() asm volatile("s_waitcnt vmcnt(0)" ::: "memory")
#define RESC(a) do { if (__any((a) < 1.f)) { if (hi == 0) al_l[r32] = (a); asm volatile("s_waitcnt lgkmcnt(0)" ::: "memory"); \
    _Pragma("unroll") for (int d = 0; d < 4; ++d) _Pragma("unroll") for (int r = 0; r < 16; ++r) o[d][r] *= al_l[crow(r, hi)]; } } while (0)
#ifdef ATT_SIMPLE
  f32x16 p0, p1; float mn, al; bf16x8 pa0, pa1, pa2, pa3;
  SLOAD(0, jlo * KVBLK); asm volatile("s_waitcnt vmcnt(0)" ::: "memory"); SWRITE(0, 0); __syncthreads();
#pragma unroll 1
  for (int j = jlo; j < jhi; ++j) {
    const int bsel = (j - jlo) & 1;
    if (j + 1 < jhi) SLOAD(0, (j + 1) * KVBLK);
    SBAR(); qkt(p0, p1, (bf16*)((char*)K_lds + bsel * SHM_K), qr, r32, hi);
    partialSM<ALIBI>(p0, p1, m_reg, mn, al, dq0 - (float)(j * KVBLK), slope2, AMODE(j));
    finishSM(p0, p1, al, l_reg, pa0, pa1, pa2, pa3);
    RESC(al); SBAR();
    pv_d0(o, vb0 + bsel * (int)SHM_V, pa0, pa1, pa2, pa3);
    if (j + 1 < jhi) { SWAIT(); SWRITE(bsel ^ 1, 0); }
    __syncthreads();
  }
#else
  f32x16 pA0, pA1, pB0, pB1; float mnA, mnB, alA, alB; bf16x8 pa0, pa1, pa2, pa3;
  SLOAD(0, jlo * KVBLK); asm volatile("s_waitcnt vmcnt(0)" ::: "memory"); SWRITE(0, 0); __syncthreads();
  qkt(pA0, pA1, K_lds, qr, r32, hi); partialSM<ALIBI>(pA0, pA1, m_reg, mnA, alA, dq0 - (float)(jlo * KVBLK), slope2, AMODE(jlo));
  SLOAD(0, (jlo + 1) * KVBLK);
  SWAIT(); SWRITE(1, 0); __syncthreads();
#pragma unroll 1
  for (int j = jlo + 1; j + 1 < jhi; j += 2) {
    SBAR(); qkt(pB0, pB1, (bf16*)((char*)K_lds + SHM_K), qr, r32, hi);
    finishSM(pA0, pA1, alA, l_reg, pa0, pa1, pa2, pa3); SBAR();
    SLOAD(0, (j + 1) * KVBLK); SBAR();
    pv_d0(o, vb0, pa0, pa1, pa2, pa3); partialSM<ALIBI>(pB0, pB1, m_reg, mnB, alB, dq0 - (float)(j * KVBLK), slope2, AMODE(j));
    __syncthreads(); SWAIT(); SWRITE(0, 0);
    RESC(alB); __syncthreads();
    SBAR(); qkt(pA0, pA1, K_lds, qr, r32, hi);
    finishSM(pB0, pB1, alB, l_reg, pa0, pa1, pa2, pa3); SBAR();
    SLOAD(0, (j + 2) * KVBLK); SBAR();
    pv_d0(o, vb0 + (int)SHM_V, pa0, pa1, pa2, pa3); partialSM<ALIBI>(pA0, pA1, m_reg, mnA, alA, dq0 - (float)((j + 1) * KVBLK), slope2, AMODE(j + 1));
    __syncthreads(); SWAIT(); SWRITE(1, 0);
    RESC(alA); __syncthreads();
  }
  SBAR(); qkt(pB0, pB1, (bf16*)((char*)K_lds + SHM_K), qr, r32, hi);
  finishSM(pA0, pA1, alA, l_reg, pa0, pa1, pa2, pa3); SBAR();
  pv_d0(o, vb0, pa0, pa1, pa2, pa3); partialSM<ALIBI>(pB0, pB1, m_reg, mnB, alB, dq0 - (float)((jhi - 1) * KVBLK), slope2, AMODE(jhi - 1));
  __syncthreads(); RESC(alB);
  finishSM(pB0, pB1, alB, l_reg, pa0, pa1, pa2, pa3); SBAR();
  pv_d0(o, vb0 + (int)SHM_V, pa0, pa1, pa2, pa3);
  __syncthreads();
#endif
  if (hi == 0) li_l[r32] = l_reg; asm volatile("s_waitcnt lgkmcnt(0)" ::: "memory");
#pragma unroll
  for (int r = 0; r < 16; ++r) { const float rl = __builtin_amdgcn_rcpf(li_l[crow(r, hi)]);
#pragma unroll
    for (int d = 0; d < 4; ++d) o[d][r] *= rl; }
#undef AMODE
#undef SLOAD
#undef SWRITE
#undef SWAIT
#undef RESC
}
}

namespace gdn {
constexpr int SA = 272, SB = 144;
constexpr int OFF_X0 = 0, OFF_X1 = 17408, OFF_KBG = 34816, OFF_VBT = 53248, OFF_QD = 71680, OFF_QKM = 89088, OFF_KDT = 98304, OFF_ST = 116736, OFF_SM = 151552, OFF_Y = 154112, GDN_LDS = OFF_Y + 4096;
constexpr int SMB = 1280;
using att::crow;
template <int KS> __device__ __forceinline__ void tile_mma(f32x16& acc, const LAS char* A, int sa, int ra, const LAS char* B, int sb, int rb, int r32, int hi) {
    const LAS char* ap = A + (ra + r32) * sa + hi * 16; const LAS char* bp = B + (rb + r32) * sb + hi * 16;
#pragma unroll
    for (int ks = 0; ks < KS; ++ks) { const bf16x8 a = *(const LAS bf16x8*)(ap + ks * 32), b = *(const LAS bf16x8*)(bp + ks * 32); acc = __builtin_amdgcn_mfma_f32_32x32x16_bf16(a, b, acc, 0, 0, 0); }
}
typedef float f32x2_ __attribute__((ext_vector_type(2)));
__device__ __forceinline__ void st_bf16(LAS char* p, float v) { *(LAS unsigned short*)p = (unsigned short)f2bf(v); }
__device__ __forceinline__ float bfsel(const u32x4& w, int e) { const unsigned x = (e < 2) ? w.x : (e < 4) ? w.y : (e < 6) ? w.z : w.w; return (e & 1) ? bfhi(x) : bflo(x); }

__device__ __forceinline__ void chunk_scalars(float bl, float a, float Aexp, float dtb, LAS float* sm, int lane) {
    const float xx = a + dtb; const float sp = xx > 20.f ? xx : log1pf(__expf(xx));
    float v = -Aexp * sp;
#pragma unroll
    for (int o = 1; o < 64; o <<= 1) { const float n = __shfl_up(v, o); if (lane >= o) v += n; }
    const float gl = __shfl(v, 63);
    sm[lane] = v; sm[64 + lane] = sigmoidf_(bl); sm[128 + lane] = __expf(v); sm[192 + lane] = __expf(gl - v); if (lane == 0) sm[256] = __expf(gl);
}
#define GDN_LOADAB(cc, ln, BL, AA) do { const int t_ = (cc) * 64 + (dir ? 63 - (ln) : (ln)); const float* abr_ = AB + (size_t)(sb + t_) * 64; BL = abr_[dir * 16 + h]; AA = abr_[32 + dir * 16 + h]; } while (0)

template <int DIRT> __device__ __forceinline__ void gdn_unit(const float* A_log, const float* dt_bias, int S, int sb, int h, const bf16* proj, const float* AB, bf16* outp, LAS char* L) {
    constexpr int dir = DIRT;
    int tid_ = threadIdx.x; asm volatile("" : "+v"(tid_));
    const float Aexp = __expf(A_log[dir * 16 + h]), dtb = dt_bias[dir * 16 + h];
    const int N = S / 64;
    const int cgp = tid_ % 48, run = tid_ / 48, part = cgp >> 4, c0 = (cgp & 15) * 8, ccol = part * 2048 + h * 128 + c0;
    const bool convt = tid_ < 384;
    u32x4 raw[8];
#define GDN_LOADRAW(cc, tsrc) do { if (convt) { const unsigned voff_ = ((unsigned)((tsrc) / 48) * 8u * (unsigned)NPROJ + (unsigned)(((tsrc) % 48) >> 4) * 2048u + (unsigned)(((tsrc) % 48) & 15) * 8u) * 2u; \
        _Pragma("unroll") for (int k_ = 0; k_ < 8; ++k_) { const char* rb_ = (const char*)proj + ((size_t)(sb + (cc) * 64 + k_) * NPROJ + C_GDN + h * 128) * 2; \
            raw[k_] = *(const u32x4*)(rb_ + voff_); } } } while (0)
    GDN_LOADRAW(dir ? N - 1 : 0, tid_);
    f32x16 st[2]; st[0] = f32x16{}; st[1] = f32x16{};
    for (int i = tid_; i < 34816 / 4; i += NTHR) ((LAS unsigned*)(L + OFF_ST))[i] = 0u;
    float ab_bl = 0.f, ab_a = 0.f;
    if ((tid_ >> 6) == 7) { GDN_LOADAB(dir ? N - 1 : 0, tid_ & 63, ab_bl, ab_a); chunk_scalars(ab_bl, ab_a, Aexp, dtb, (LAS float*)(L + OFF_SM), tid_ & 63); }
    __syncthreads();
#pragma unroll 1
    for (int ci = 0; ci < N; ++ci) {
        const int c = dir ? N - 1 - ci : ci;
        int tq = tid_; asm volatile("" : "+v"(tq));
        const int tid = tq, wid = __builtin_amdgcn_readfirstlane(tid >> 6), lane = tid & 63, r32 = lane & 31, hi = lane >> 5;
        LAS float* gcs = (LAS float*)(L + OFF_SM + (ci & 1) * SMB); LAS float* bet = gcs + 64; LAS float* eg = gcs + 128; LAS float* ekd = gcs + 192;
        if (wid == 7 && ci + 1 < N) GDN_LOADAB(dir ? c - 1 : c + 1, lane, ab_bl, ab_a);
        if (convt) {
            asm volatile("s_waitcnt vmcnt(0)" ::: "memory");
            float y[8][8];
#pragma unroll
            for (int rr = 0; rr < 8; ++rr) unpack8(raw[rr], y[rr]);
            u32x4 rawc[8];
#pragma unroll
            for (int rr = 0; rr < 8; ++rr) rawc[rr] = raw[rr];
            if (ci + 1 < N) GDN_LOADRAW(dir ? c - 1 : c + 1, tid);
            const int i0 = dir ? 56 - run * 8 : run * 8;
            float bi[8], egi[8], eki[8];
            { const f32x4 a0 = *(const LAS f32x4*)(bet + i0), a1 = *(const LAS f32x4*)(bet + i0 + 4), b0 = *(const LAS f32x4*)(eg + i0), b1 = *(const LAS f32x4*)(eg + i0 + 4), c0v = *(const LAS f32x4*)(ekd + i0), c1v = *(const LAS f32x4*)(ekd + i0 + 4);
#pragma unroll
              for (int p = 0; p < 4; ++p) { bi[p] = a0[p]; bi[4 + p] = a1[p]; egi[p] = b0[p]; egi[4 + p] = b1[p]; eki[p] = c0v[p]; eki[4 + p] = c1v[p]; } }
#define GDN_PK8(v) (u32x4){pg8::cvt_pk_bf16((v)[0], (v)[1]), pg8::cvt_pk_bf16((v)[2], (v)[3]), pg8::cvt_pk_bf16((v)[4], (v)[5]), pg8::cvt_pk_bf16((v)[6], (v)[7])}
            if (part == 0) {
#pragma unroll
                for (int rr = 0; rr < 8; ++rr) { const int p = dir ? 7 - rr : rr, i = i0 + p; float qd[8];
#pragma unroll
                    for (int e = 0; e < 8; ++e) qd[e] = y[rr][e] * egi[p];
                    *(LAS u32x4*)(L + OFF_X0 + i * SA + c0 * 2) = rawc[rr]; *(LAS u32x4*)(L + OFF_QD + i * SA + c0 * 2) = GDN_PK8(qd); }
            } else if (part == 1) {
#pragma unroll
                for (int rr = 0; rr < 8; ++rr) { const int p = dir ? 7 - rr : rr, i = i0 + p; *(LAS u32x4*)(L + OFF_X1 + i * SA + c0 * 2) = rawc[rr]; }
#pragma unroll
                for (int e = 0; e < 8; ++e) { float kb[8], kd[8];
#pragma unroll
                    for (int p = 0; p < 8; ++p) { const int rr = dir ? 7 - p : p; kb[p] = y[rr][e] * (bi[p] * egi[p]); kd[p] = y[rr][e] * eki[p]; }
                    *(LAS u32x4*)(L + OFF_KBG + (c0 + e) * SB + i0 * 2) = GDN_PK8(kb); *(LAS u32x4*)(L + OFF_KDT + (c0 + e) * SB + i0 * 2) = GDN_PK8(kd); }
            } else {
#pragma unroll
                for (int e = 0; e < 8; ++e) { float vb[8];
#pragma unroll
                    for (int p = 0; p < 8; ++p) { const int rr = dir ? 7 - p : p; vb[p] = y[rr][e] * bi[p]; }
                    *(LAS u32x4*)(L + OFF_VBT + (c0 + e) * SB + i0 * 2) = GDN_PK8(vb); }
            }
        }
        __syncthreads();
        {
            f32x16 acc = f32x16{};
            const int w4 = wid & 3, ma = w4 >> 1, nb = w4 & 1;
            if (wid < 4) { if (!(ma == 0 && nb == 1)) tile_mma<8>(acc, L + OFF_X1, SA, 32 * ma, L + OFF_X1, SA, 32 * nb, r32, hi); }
            else         { if (!(ma == 1 && nb == 0)) tile_mma<8>(acc, L + OFF_X1, SA, 32 * ma, L + OFF_X0, SA, 32 * nb, r32, hi); }
            __syncthreads();
            if (wid < 4) {
                if (!(ma == 0 && nb == 1)) {
                    const int j = 32 * nb + r32; const float gj = gcs[j];
#pragma unroll
                    for (int r = 0; r < 16; ++r) { const int i = 32 * ma + crow(r, hi); const float v = (i > j) ? bet[i] * acc[r] * __expf(gcs[i] - gj) : 0.f; *(LAS float*)(L + OFF_X1 + (i * 68 + j) * 4) = v; }
                }
            } else {
                const int i = 32 * nb + r32; const float gi = gcs[i];
#pragma unroll
                for (int r4 = 0; r4 < 4; ++r4) { float v[4];
#pragma unroll
                    for (int e = 0; e < 4; ++e) { const int j = 32 * ma + 8 * r4 + 4 * hi + e; v[e] = (i >= j) ? acc[4 * r4 + e] * __expf(gi - gcs[j]) : 0.f; }
                    u32x2 w; w.x = pk2(v[0], v[1]); w.y = pk2(v[2], v[3]); *(LAS u32x2*)(L + OFF_QKM + i * SB + (32 * ma + 8 * r4 + 4 * hi) * 2) = w; }
            }
        }
        __syncthreads();
        {
            const LAS float* Lf = (const LAS float*)(L + OFF_X1); LAS float* Tf = (LAS float*)(L + OFF_X0); LAS float* Yf = (LAS float*)(L + OFF_Y);
            if (tid < 64) { const int b = tid >> 4, cc = tid & 15; const LAS float* Lb = Lf + (16 * b) * 68 + 16 * b; float x[16];
#pragma unroll
                for (int i = 0; i < 16; ++i) { float s = (i == cc) ? 1.f : 0.f;
#pragma unroll
                    for (int j = 0; j < i; ++j) s = fmaf(-Lb[i * 68 + j], x[j], s);
                    x[i] = s; }
#pragma unroll
                for (int i = 0; i < 16; ++i) Tf[(16 * b + i) * 68 + 16 * b + cc] = x[i]; }
            if (wid == 7 && ci + 1 < N) chunk_scalars(ab_bl, ab_a, Aexp, dtb, (LAS float*)(L + OFF_SM + ((ci + 1) & 1) * SMB), lane);
            __syncthreads();
            { const int pr = tid >> 8, i = (tid >> 4) & 15, j = tid & 15, a = 2 * pr, b = 2 * pr + 1; float y = 0.f;
#pragma unroll
              for (int k = 0; k < 16; ++k) y = fmaf(Lf[(16 * b + i) * 68 + 16 * a + k], Tf[(16 * a + k) * 68 + 16 * a + j], y);
              Yf[tid] = y; __syncthreads();
              float z = 0.f;
#pragma unroll
              for (int k = 0; k < 16; ++k) z = fmaf(-Tf[(16 * b + i) * 68 + 16 * b + k], Yf[(pr * 16 + k) * 16 + j], z);
              Tf[(16 * b + i) * 68 + 16 * a + j] = z; Tf[(16 * a + i) * 68 + 16 * b + j] = 0.f; }
            __syncthreads();
            { const int i = tid >> 4, j0 = (tid & 15) * 2; float y0 = 0.f, y1 = 0.f;
#pragma unroll
              for (int k4 = 0; k4 < 8; ++k4) { const f32x4 l = *(const LAS f32x4*)(Lf + (32 + i) * 68 + 4 * k4);
#pragma unroll
                  for (int e = 0; e < 4; ++e) { const f32x2_ t = *(const LAS f32x2_*)(Tf + (4 * k4 + e) * 68 + j0); y0 = fmaf(l[e], t.x, y0); y1 = fmaf(l[e], t.y, y1); } }
              *(LAS f32x2_*)(Yf + i * 32 + j0) = (f32x2_){y0, y1}; __syncthreads();
              float z0 = 0.f, z1 = 0.f;
#pragma unroll
              for (int k4 = 0; k4 < 8; ++k4) { const f32x4 tb = *(const LAS f32x4*)(Tf + (32 + i) * 68 + 32 + 4 * k4);
#pragma unroll
                  for (int e = 0; e < 4; ++e) { const f32x2_ yv = *(const LAS f32x2_*)(Yf + (4 * k4 + e) * 32 + j0); z0 = fmaf(-tb[e], yv.x, z0); z1 = fmaf(-tb[e], yv.y, z1); } }
              *(LAS f32x2_*)(Tf + (32 + i) * 68 + j0) = (f32x2_){z0, z1}; }
            __syncthreads();
            { const int i = tid >> 3, j0 = (tid & 7) * 8; float v[8];
#pragma unroll
              for (int e = 0; e < 8; ++e) { const int j = j0 + e; v[e] = (j <= i) ? Tf[i * 68 + j] : 0.f; }
              *(LAS u32x4*)(L + OFF_X1 + i * SB + j0 * 2) = pack8(v); }
        }
        __syncthreads();
        const int mi = wid >> 2, ni = wid & 3;
        f32x16 accU = f32x16{};
        tile_mma<4>(accU, L + OFF_X1, SB, 32 * mi, L + OFF_VBT, SB, 32 * ni, r32, hi);
        { f32x16 accW = f32x16{};
          tile_mma<4>(accW, L + OFF_KBG, SB, 32 * ni, L + OFF_X1, SB, 32 * mi, r32, hi);
          const int tok = 32 * mi + r32;
#pragma unroll
          for (int r4 = 0; r4 < 4; ++r4) { u32x2 w; w.x = pk2(accW[4 * r4], accW[4 * r4 + 1]); w.y = pk2(accW[4 * r4 + 2], accW[4 * r4 + 3]);
              *(LAS u32x2*)(L + OFF_X0 + tok * SA + (32 * ni + 8 * r4 + 4 * hi) * 2) = w; } }
        __syncthreads();
        {
            f32x16 accV = f32x16{}, accO = f32x16{};
            {
                const LAS char* wp = L + OFF_X0 + (32 * mi + r32) * SA + hi * 16; const LAS char* qp = L + OFF_QD + (32 * mi + r32) * SA + hi * 16; const LAS char* sp = L + OFF_ST + (32 * ni + r32) * SA + hi * 16;
#pragma unroll
                for (int ks = 0; ks < 8; ++ks) { const bf16x8 b = *(const LAS bf16x8*)(sp + ks * 32), aw = *(const LAS bf16x8*)(wp + ks * 32), aq = *(const LAS bf16x8*)(qp + ks * 32);
                    accV = __builtin_amdgcn_mfma_f32_32x32x16_bf16(aw, b, accV, 0, 0, 0); accO = __builtin_amdgcn_mfma_f32_32x32x16_bf16(aq, b, accO, 0, 0, 0); }
            }
            const int dv = 32 * ni + r32;
#pragma unroll
            for (int r4 = 0; r4 < 4; ++r4) { u32x2 w; w.x = pk2(accU[4 * r4] - accV[4 * r4], accU[4 * r4 + 1] - accV[4 * r4 + 1]); w.y = pk2(accU[4 * r4 + 2] - accV[4 * r4 + 2], accU[4 * r4 + 3] - accV[4 * r4 + 3]);
                *(LAS u32x2*)(L + OFF_VBT + dv * SB + (32 * mi + 8 * r4 + 4 * hi) * 2) = w; }
            __syncthreads();
            tile_mma<4>(accO, L + OFF_QKM, SB, 32 * mi, L + OFF_VBT, SB, 32 * ni, r32, hi);
#pragma unroll
            for (int r = 0; r < 16; ++r) { const int tok = 32 * mi + crow(r, hi); const int t = c * 64 + (dir ? 63 - tok : tok);
                outp[(size_t)(sb + t) * DM + h * 128 + dv] = (bf16)f2bf(accO[r]); }
            const float egl = gcs[256]; const int mi2 = wid & 3;
#pragma unroll
            for (int xx = 0; xx < 2; ++xx) { const int ni2 = (wid >> 2) * 2 + xx;
#pragma unroll
                for (int r = 0; r < 16; ++r) st[xx][r] *= egl;
                tile_mma<4>(st[xx], L + OFF_KDT, SB, 32 * mi2, L + OFF_VBT, SB, 32 * ni2, r32, hi);
                const int dv2 = 32 * ni2 + r32;
#pragma unroll
                for (int r4 = 0; r4 < 4; ++r4) { u32x2 w; w.x = pk2(st[xx][4 * r4], st[xx][4 * r4 + 1]); w.y = pk2(st[xx][4 * r4 + 2], st[xx][4 * r4 + 3]);
                    *(LAS u32x2*)(L + OFF_ST + dv2 * SA + (32 * mi2 + 8 * r4 + 4 * hi) * 2) = w; }
            }
        }
        __syncthreads();
    }
#undef GDN_LOADRAW
#undef GDN_LOADAB
}
}

__device__ __forceinline__ void diffattn_unit(const float* da_lambda, const float* gqn, const float* gkn, int S, int sb, int h, int qb, int vh, const bf16* proj, bf16* aout, float* ssqg, char* lds) {
    using namespace att;
    int tid_ = threadIdx.x; asm volatile("" : "+v"(tid_));
    const int tid = tid_, wid = tid >> 6, lane = tid & 63;
    const int t0 = sb + qb * 256;
    const float slope2 = exp2f(-(float)(h + 1)) * LOG2E;
    int jlo, jhi;
    { float gq = fmaxf(fabsf(gqn[lane]), fabsf(gqn[64 + lane])), gk = fmaxf(fabsf(gkn[lane]), fabsf(gkn[64 + lane]));
#pragma unroll
      for (int o_ = 1; o_ < 64; o_ <<= 1) { gq = fmaxf(gq, __shfl_xor(gq, o_)); gk = fmaxf(gk, __shfl_xor(gk, o_)); }
      const float smax2 = 11.313708499f * gq * gk * LOG2E * 1.02f;
      const float Wf = fminf((2.f * smax2 + 40.f) / slope2, 1.0e6f); const int W = __builtin_amdgcn_readfirstlane((int)Wf + 1), q0 = qb * 256;
      const int lo = q0 - W, hi_ = q0 + 255 + W, NT = S / 64;
      jlo = lo > 0 ? (lo >> 6) : 0; jhi = (hi_ >> 6) + 1; jhi = jhi < NT ? jhi : NT;
      if ((jhi - jlo) & 1) { if (jlo > 0) --jlo; else ++jhi; } }
    unsigned* stash = (unsigned*)(lds + OFF_STASH);
#pragma unroll 1
    for (int map = 0; map < 2; ++map) {
        f32x16 o[4];
        attn_core<true>(proj + (size_t)t0 * NPROJ + C_DAQ + (h * 2 + map) * 128, NPROJ, proj + (size_t)sb * NPROJ + C_DAK + (h * 2 + map) * 128,
                        proj + (size_t)sb * NPROJ + C_DAV + h * 256 + vh * 128, NPROJ, jlo, jhi, lds, slope2, qb * 256, o);
        if (map == 0) {
#pragma unroll
            for (int d = 0; d < 4; ++d)
#pragma unroll
                for (int r2 = 0; r2 < 8; ++r2) stash[(d * 8 + r2) * NTHR + tid] = pk2(o[d][2 * r2], o[d][2 * r2 + 1]);
        } else {
            float lam;
            { const float* lp = da_lambda; const float s1 = wave_sum(lp[lane] * lp[128 + lane] + lp[64 + lane] * lp[192 + lane]), s2 = wave_sum(lp[256 + lane] * lp[384 + lane] + lp[320 + lane] * lp[448 + lane]);
              lam = __expf(s1) - __expf(s2) + 0.2f; }
            float ss[16];
#pragma unroll
            for (int r = 0; r < 16; ++r) ss[r] = 0.f;
#pragma unroll
            for (int d = 0; d < 4; ++d)
#pragma unroll
                for (int r2 = 0; r2 < 8; ++r2) { const unsigned w = stash[(d * 8 + r2) * NTHR + tid];
                    const float a = bflo(w) - lam * o[d][2 * r2], b = bfhi(w) - lam * o[d][2 * r2 + 1]; o[d][2 * r2] = a; o[d][2 * r2 + 1] = b; ss[2 * r2] += a * a; ss[2 * r2 + 1] += b * b; }
#pragma unroll
            for (int r = 0; r < 16; ++r) { float s = ss[r]; s += __shfl_xor(s, 1); s += __shfl_xor(s, 2); s += __shfl_xor(s, 4); s += __shfl_xor(s, 8); s += __shfl_xor(s, 16); ss[r] = s; }
            int lz = lane; asm volatile("" : "+v"(lz));
            const int r32 = lz & 31, hi = lz >> 5;
            bf16* orow = aout + (size_t)(t0 + wid * 32) * DM + h * 256 + vh * 128 + r32;
            if (r32 == 0) {
#pragma unroll
                for (int r = 0; r < 16; ++r) ssqg[(size_t)(t0 + wid * 32 + crow(r, hi)) * 16 + h * 2 + vh] = ss[r]; }
#pragma unroll
            for (int r = 0; r < 16; ++r)
#pragma unroll
                for (int d = 0; d < 4; ++d) orow[(size_t)crow(r, hi) * DM + d * 32] = (bf16)f2bf(o[d][r]);
        }
        __syncthreads();
    }
}
__device__ __forceinline__ void xattn_unit(int sb, int bl, int xh, int qb, const bf16* proj, const bf16* memkv, bf16* cout, char* lds) {
    using namespace att;
    int tid_ = threadIdx.x; asm volatile("" : "+v"(tid_));
    const int tid = tid_, wid = tid >> 6, lane = tid & 63, r32 = lane & 31, hi = lane >> 5;
    const int t0 = sb + qb * 256;
    f32x16 o[4];
    attn_core<false>(proj + (size_t)t0 * NPROJ + C_XAQ + xh * 128, NPROJ, memkv + (size_t)bl * 256 * 1024 + xh * 128, memkv + (size_t)bl * 256 * 1024 + 512 + xh * 128, 1024, 0, 4, lds, 0.f, 0, o);
    bf16* orow = cout + (size_t)(t0 + wid * 32) * 512 + xh * 128 + r32;
#pragma unroll
    for (int r = 0; r < 16; ++r)
#pragma unroll
        for (int d = 0; d < 4; ++d) orow[(size_t)crow(r, hi) * 512 + d * 32] = (bf16)f2bf(o[d][r]);
}

__device__ __forceinline__ void seg_norm_fin(bf16* p, u32x4 raw, const float* gain, float scale, int l16) {
    float v[8]; unpack8(raw, v);
    float ss = 0.f;
#pragma unroll
    for (int e = 0; e < 8; ++e) ss += v[e] * v[e];
    ss += __shfl_xor(ss, 1); ss += __shfl_xor(ss, 2); ss += __shfl_xor(ss, 4); ss += __shfl_xor(ss, 8);
    const float inv = (rsq_(ss * (1.f / 128.f) + EPS)) * scale;
    const f32x4 g0 = *(const f32x4*)(gain + l16 * 8), g1 = *(const f32x4*)(gain + l16 * 8 + 4);
#pragma unroll
    for (int e = 0; e < 4; ++e) { v[e] *= inv * g0[e]; v[4 + e] *= inv * g1[e]; }
    *(u32x4*)(p + l16 * 8) = pack8(v);
}
__device__ __forceinline__ void seg_norm(bf16* p, const float* gain, float scale, int l16) { seg_norm_fin(p, *(const u32x4*)(p + l16 * 8), gain, scale, l16); }

__device__ __forceinline__ void gdn_conv_item(bf16* proj, const bf16* halo, const float* conv_w, int S, int c, int cg, int l16dummy) {
    (void)l16dummy;
    const int part = cg >> 8, col = cg * 8;
    const int s0 = (c * 64) & (S - 1);
    f32x4 wc[5][2];
#pragma unroll
    for (int j = 0; j < 5; ++j) { wc[j][0] = *(const f32x4*)(conv_w + j * 6144 + col); wc[j][1] = *(const f32x4*)(conv_w + j * 6144 + col + 4); }
    bf16* base = proj + (size_t)c * 64 * NPROJ + C_GDN + col;
    const u32x4 zero4 = (u32x4){0u, 0u, 0u, 0u};
    u32x4 raw[12];
    raw[0] = (s0 == 0) ? zero4 : *(const u32x4*)(halo + ((size_t)(c - 1) * 4 + 2) * 6144 + col);
    raw[1] = (s0 == 0) ? zero4 : *(const u32x4*)(halo + ((size_t)(c - 1) * 4 + 3) * 6144 + col);
    raw[2] = *(const u32x4*)(base); raw[3] = *(const u32x4*)(base + NPROJ);
#pragma unroll 1
    for (int b = 0; b < 8; ++b) {
#pragma unroll
        for (int k = 0; k < 8; ++k) { const int r = 8 * b + 2 + k;
            raw[4 + k] = (r < 64) ? *(const u32x4*)(base + (size_t)r * NPROJ) : ((s0 + 64 == S) ? zero4 : *(const u32x4*)(halo + ((size_t)(c + 1) * 4 + (r - 64)) * 6144 + col)); }
        float y[8][8];
#pragma unroll
        for (int e = 0; e < 8; ++e) { float xr[12];
#pragma unroll
            for (int k = 0; k < 12; ++k) xr[k] = gdn::bfsel(raw[k], e);
#pragma unroll
            for (int rr = 0; rr < 8; ++rr) { float s = 0.f;
#pragma unroll
                for (int j = 0; j < 5; ++j) s = fmaf(wc[j][e >> 2][e & 3], xr[rr + j], s);
                y[rr][e] = s * sigmoidf_(s); } }
#pragma unroll
        for (int rr = 0; rr < 8; ++rr) { float sc = 1.f;
            if (part < 2) { float ss = 0.f;
#pragma unroll
                for (int e = 0; e < 8; ++e) ss += y[rr][e] * y[rr][e];
                ss += __shfl_xor(ss, 1); ss += __shfl_xor(ss, 2); ss += __shfl_xor(ss, 4); ss += __shfl_xor(ss, 8);
                sc = (rsq_(ss + EPS)) * (part == 0 ? 0.08838834764831845f : 1.f); }
            u32x4 w; w.x = pg8::cvt_pk_bf16(y[rr][0] * sc, y[rr][1] * sc); w.y = pg8::cvt_pk_bf16(y[rr][2] * sc, y[rr][3] * sc); w.z = pg8::cvt_pk_bf16(y[rr][4] * sc, y[rr][5] * sc); w.w = pg8::cvt_pk_bf16(y[rr][6] * sc, y[rr][7] * sc);
            *(u32x4*)(base + (size_t)(8 * b + rr) * NPROJ) = w; }
        raw[0] = raw[8]; raw[1] = raw[9]; raw[2] = raw[10]; raw[3] = raw[11];
    }
}


#define XB_TMO      128
#define XB_XCNT(j)  (256  + 64 * (j))
#define XB_XSUB(j)  (1280 + 64 * (j))
#define XB_XGEN(j)  (2304 + 64 * (j))
#define XB_TOP      3328
#define XB_TOPGEN   3392
#define XCD_BAR_WORDS 3456
#define XB_SPIN_CAP (1u << 18)

__device__ __forceinline__ unsigned xb_ld(unsigned* p)              { return __hip_atomic_load(p, __ATOMIC_RELAXED, __HIP_MEMORY_SCOPE_AGENT); }
__device__ __forceinline__ unsigned xb_add(unsigned* p, unsigned v) { return __hip_atomic_fetch_add(p, v, __ATOMIC_RELAXED, __HIP_MEMORY_SCOPE_AGENT); }
__device__ __forceinline__ unsigned xb_xcc_id() { return (unsigned)__builtin_amdgcn_s_getreg((3 << 11) | 20) & 0xFu; }
#define XB_SPIN(cond, bar) do { unsigned _sp = 0; while (cond) { __builtin_amdgcn_s_sleep(1); \
    if ((++_sp & 255u) == 0u) { if (xb_ld(&(bar)[XB_TMO])) break; if (_sp > XB_SPIN_CAP) { atomicAdd(&(bar)[XB_TMO], 1u); break; } } } } while (0)

struct XcdBarrier {
    unsigned* bar; unsigned x;
    volatile LAS unsigned* st;
};

__device__ __forceinline__ XcdBarrier xcd_barrier_post(unsigned* bar, volatile LAS unsigned* st) {
    XcdBarrier b; b.bar = bar; b.x = xb_xcc_id(); b.st = st;
    if (threadIdx.x == 0) (void)xb_add(&bar[XB_XCNT(b.x)], 1u);
    return b;
}
__device__ __forceinline__ void xcd_barrier_complete(unsigned* bar, unsigned x, unsigned& nloc, unsigned& nx) {
    const unsigned G = gridDim.x * gridDim.y * gridDim.z;
    unsigned sum, cnt, mine, sp = 0u;
    for (;;) {
        sum = 0u; cnt = 0u; mine = 0u;
#pragma unroll
        for (unsigned j = 0; j < 16; ++j) { const unsigned c = xb_ld(&bar[XB_XCNT(j)]); sum += c; cnt += (c > 0u) ? 1u : 0u; mine = (j == x) ? c : mine; }
        if (sum == G) break;
        __builtin_amdgcn_s_sleep(1);
        if ((++sp & 255u) == 0u) { if (xb_ld(&bar[XB_TMO])) break; if (sp > XB_SPIN_CAP) { atomicAdd(&bar[XB_TMO], 1u); break; } }
    }
    nloc = mine > 0u ? mine : 1u; nx = cnt > 0u ? cnt : 1u;
}

__device__ __forceinline__ void xcd_barrier(const XcdBarrier& b) {
    asm volatile("s_waitcnt vmcnt(0)" ::: "memory");
    __syncthreads();
    if (threadIdx.x == 0) {
        unsigned* bar = b.bar;
        __builtin_amdgcn_s_waitcnt(0);
        unsigned nloc = b.st[0], nx = b.st[1];
        if (nloc == 0u) { xcd_barrier_complete(bar, b.x, nloc, nx); b.st[0] = nloc; b.st[1] = nx; }
        const unsigned old = xb_add(&bar[XB_XSUB(b.x)], 1u);
        const unsigned gen = old / nloc;
        if (old + 1u == (gen + 1u) * nloc) {
            __builtin_amdgcn_fence(__ATOMIC_RELEASE, "agent");
            asm volatile("s_waitcnt vmcnt(0)" ::: "memory");
            const unsigned og = xb_add(&bar[XB_TOP], 1u);
            const unsigned tg = og / nx;
            if (og + 1u == (tg + 1u) * nx) xb_add(&bar[XB_TOPGEN], 1u);
            else XB_SPIN(xb_ld(&bar[XB_TOPGEN]) == tg, bar);
            __builtin_amdgcn_fence(__ATOMIC_ACQUIRE, "agent");
            xb_add(&bar[XB_XGEN(b.x)], 1u);
            asm volatile("s_waitcnt vmcnt(0)" ::: "memory");
        } else {
            XB_SPIN(xb_ld(&bar[XB_XGEN(b.x)]) == gen, bar);
            __builtin_amdgcn_fence(__ATOMIC_ACQUIRE, "agent");
            asm volatile("s_waitcnt vmcnt(0)" ::: "memory");
        }
    }
    __syncthreads();
}


__device__ __forceinline__ void p0_phase(LAS unsigned char* lds, int gg, int NGW) {
    int tq = threadIdx.x; asm volatile("" : "+v"(tq));
    const int lane = tq & 63, wave = __builtin_amdgcn_readfirstlane(tq >> 6), gw = blockIdx.x * NWV + wave;
    LAS float* scr = (LAS float*)(lds + LDS_PH + wave * 16896);
    unsigned char* wsb = (unsigned char*)tptr(lds, T_WS);
    bf16* WA = (bf16*)(wsb + WS_W + W_WINA); const float* win = tptr(lds, T_WIN);
    transpose_job(win, 21056, 0, 12288, DM, WA, 0, scr, gw, NGW, lane);
    transpose_job(win, 21056, 14400, 512, DM, WA, 12288, scr, gw, NGW, lane);
    transpose_job(win, 21056, 14336, 64, DM, WA, 12800, scr, gw, NGW, lane);
    transpose_job(tptr(lds, T_WMKV), 1024, 0, 1024, DM, (bf16*)(wsb + WS_W + W_WMKV), 0, scr, gw, NGW, lane);
    { const float* x = tptr(lds, T_X0 + gg); const float* gm = tptr(lds, T_GMIX); bf16* h = (bf16*)(wsb + WS_H);
      for (int m = gw; m < TG; m += NGW) rms_row(x + (size_t)m * DM, gm, h + (size_t)m * DM, lane); }
    { const int nmem = (gg ? 2 : 4) * 256; const float* mx = tptr(lds, T_MEM0 + gg); const float* gm = tptr(lds, T_GMEM); bf16* mn = (bf16*)(wsb + WS_MEMN);
      for (int m = gw; m < nmem; m += NGW) rms_row(mx + (size_t)m * DM, gm, mn + (size_t)m * DM, lane); }
}
__global__ void __launch_bounds__(NTHR, 2) hybrid_fwd(Params P) {
    extern __shared__ __attribute__((aligned(16))) unsigned char lds_raw[];
    cg::grid_group grid = cg::this_grid();
    LAS unsigned char* lds = (LAS unsigned char*)lds_raw;
    const int NGW = gridDim.x * NWV;
    if (threadIdx.x == 0) {
        LAS unsigned long long* t = (LAS unsigned long long*)(lds + LDS_TBL);
        t[T_X0] = (unsigned long long)P.x[0];
        t[T_X1] = (unsigned long long)P.x[1];
        t[T_MEM0] = (unsigned long long)P.mem[0];
        t[T_MEM1] = (unsigned long long)P.mem[1];
        t[T_OUT0] = (unsigned long long)P.out[0];
        t[T_OUT1] = (unsigned long long)P.out[1];
        t[T_GMIX] = (unsigned long long)P.g_mix;
        t[T_GMEM] = (unsigned long long)P.g_mem;
        t[T_WIN] = (unsigned long long)P.w_in;
        t[T_BGATE] = (unsigned long long)P.b_gate;
        t[T_DAQN] = (unsigned long long)P.da_q_norm;
        t[T_DAKN] = (unsigned long long)P.da_k_norm;
        t[T_DALAM] = (unsigned long long)P.da_lambda;
        t[T_DASUB] = (unsigned long long)P.da_subln;
        t[T_GCONV] = (unsigned long long)P.gdn_conv_w;
        t[T_GALOG] = (unsigned long long)P.gdn_A_log;
        t[T_GDT] = (unsigned long long)P.gdn_dt_bias;
        t[T_GON] = (unsigned long long)P.gdn_out_norm;
        t[T_XQN] = (unsigned long long)P.xa_q_norm;
        t[T_XKN] = (unsigned long long)P.xa_k_norm;
        t[T_WMKV] = (unsigned long long)P.w_mem_kv;
        t[T_PA] = (unsigned long long)P.p_attn;
        t[T_PD] = (unsigned long long)P.p_gdn;
        t[T_PM] = (unsigned long long)P.p_mem;
        t[T_WO] = (unsigned long long)P.w_o;
        t[T_GFFN] = (unsigned long long)P.g_ffn;
        t[T_WUP] = (unsigned long long)P.w_up;
        t[T_FCW] = (unsigned long long)P.ffn_conv_w;
        t[T_FCB] = (unsigned long long)P.ffn_conv_b;
        t[T_WDOWN] = (unsigned long long)P.w_down;
        t[T_WS] = (unsigned long long)P.ws;
    }
    if (threadIdx.x == 0) { ((LAS unsigned*)(lds + 272))[0] = 0u; ((LAS unsigned*)(lds + 272))[1] = 0u; }
    __syncthreads();
#define TP(i) tptr(lds, i)
    const XcdBarrier xbar = xcd_barrier_post((unsigned*)(P.ws + WS_CTL) + 1024, (volatile LAS unsigned*)(lds + 272));
#define GSYNC() xcd_barrier(xbar)
#define WSB ((unsigned char*)TP(T_WS))
#define H ((bf16*)(WSB + WS_H))
#define AB ((float*)(WSB + WS_AB))
#define MEMN ((bf16*)(WSB + WS_MEMN))
#define MEMKV ((bf16*)(WSB + WS_MEMKV))
#define COUT ((bf16*)(WSB + WS_COUT))
#define GDNB ((bf16*)(WSB + WS_GDNB))
#define RW (WSB + WS_W)
#define PROJ ((bf16*)(WSB + WS_BIG))
#define HALO ((bf16*)(WSB + WS_HALO))
#define SSQ ((float*)(WSB + WS_SSQ))
#define ZB ((bf16*)(WSB + WS_BIG))
#define GATES (ZB + (size_t)TG * DM)
#define GT ((bf16*)(WSB + WS_BIG))
#define UP (GT + (size_t)TG * DFF)
#define WDN ((bf16*)(WSB + WS_BIG + (size_t)369098752))
#define PHASE_IDS() int tq = threadIdx.x; asm volatile("" : "+v"(tq));   \
    const int tid = tq, lane = tid & 63, wave = __builtin_amdgcn_readfirstlane(tid >> 6), gw = blockIdx.x * NWV + wave; \
    LAS float* scr = (LAS float*)(lds + LDS_PH + wave * 16896); (void)lane; (void)gw; (void)scr; (void)tid
#pragma unroll 1
    for (int g = 0; g < 2; ++g) {
        const int B = g ? 2 : 4, S = g ? 8192 : 4096, NMEM = B * 256;

#define X (TP(T_X0 + g))
#define OUT ((float*)TP(T_OUT0 + g))
#define MEMX (TP(T_MEM0 + g))
#define GDNF ((bf16*)OUT)
#define AOUT (GDNF + (size_t)TG * DM)
        p0_phase(lds, g, NGW);
        GSYNC();
        if (gridDim.x == 0x7fffffffu) grid.sync();
#ifndef GEMM_REPS
#define GEMM_REPS 1
#endif
        for (int rp = 0; rp < GEMM_REPS; ++rp)
        { pg8::Gemm gm{H, (const bf16*)(RW + W_WINA), TG, NP1, DM}; pg8::StaticOrder So; So.init(TG, NP1, (int)gridDim.x, (int)blockIdx.x);
          EpiP1 Ep{PROJ, AB, TP(T_DAQN), TP(T_DAKN), TP(T_XQN), (LAS float*)(lds + LDS_PH + 131072), HALO};
          pg8::gemm_phase<EpiP1, pg8::StaticOrder, true, true>(lds + LDS_PH, gm, So, Ep); }
        GSYNC();
#ifndef P3_GDN_ONLY
#define P3_GDN_ONLY 0
#endif
        {
            { pg8::Gemm gm{MEMN, (const bf16*)(RW + W_WMKV), 1024, 1024, DM}; pg8::StaticOrder So; So.init(1024, 1024, (int)gridDim.x, (int)blockIdx.x);
              EpiMKV Ep{MEMKV, TP(T_XKN), (LAS float*)(lds + LDS_PH + 131072)};
              pg8::gemm_phase<EpiMKV, pg8::StaticOrder, true, true>(lds + LDS_PH, gm, So, Ep); }
            PHASE_IDS();
            volatile LAS unsigned* wq = (volatile LAS unsigned*)(lds + LDS_WQ);
            for (;;) {
                __syncthreads();
                if (tid == 0) wq[0] = atomicAdd((unsigned*)(WSB + WS_CTL) + 64 * g + 48, 1u);
                __syncthreads();
                const int ck = (int)wq[0];
                if (ck >= 256 * 768 / NTHR) break;
                const int it = ck * NTHR + tid;
                gdn_conv_item(PROJ, HALO, TP(T_GCONV), S, it / 768, it % 768, 0);
            }
        }
        GSYNC();
#ifndef P3_REPS
#define P3_REPS 1
#endif
        for (int rep = 0; rep < P3_REPS; ++rep) {
            PHASE_IDS();
            const int nG = B * 32, nA = B * 16 * (S / 256), nX = B * 4 * (S / 256), total = (rep > 0 && P3_GDN_ONLY) ? nG : nG + nA + nX;
            volatile LAS unsigned* wq = (volatile LAS unsigned*)(lds + LDS_WQ);
            for (;;) {
                __syncthreads();
                if (tid == 0) wq[0] = atomicAdd((unsigned*)(WSB + WS_CTL) + 64 * g + 16 * rep, 1u);
                __syncthreads();
                const int item = (int)wq[0];
                if (item >= total) break;
#ifndef NO_GDN
                if (item < nG) { const int dir = item & 1, h = (item >> 1) & 15, bl = item >> 5;
                    if (dir) gdn::gdn_unit<1>(TP(T_GALOG), TP(T_GDT), S, bl * S, h, PROJ, AB, GDNB, (LAS char*)lds + LDS_PH); else gdn::gdn_unit<0>(TP(T_GALOG), TP(T_GDT), S, bl * S, h, PROJ, AB, GDNF, (LAS char*)lds + LDS_PH);
                } else
#endif
#ifndef NO_DATT
                if (item < nG + nA) { const int u = item - nG, lq = g ? 5 : 4, lb = g ? 1 : 2, qb = u & ((1 << lq) - 1), bl = (u >> lq) & (B - 1), hv = u >> (lq + lb), h = 7 - (hv >> 1), vh = hv & 1;
                    diffattn_unit(TP(T_DALAM), TP(T_DAQN), TP(T_DAKN), S, bl * S, h, qb, vh, PROJ, AOUT, SSQ, (char*)lds_raw + LDS_PH);
                } else
#endif
#ifndef NO_XATT
                if (item >= nG + nA) { const int u = item - nG - nA, lq = g ? 5 : 4, qb = u & ((1 << lq) - 1), xh = (u >> lq) & 3, bl = u >> (lq + 2);
                    xattn_unit(bl * S, bl, xh, qb, PROJ, MEMKV, COUT, (char*)lds_raw + LDS_PH); }
#endif
                {}
            }
            if (rep == 0) {
                constexpr int NSL = 128;
                for (;;) {
                    __syncthreads();
                    if (tid == 0) wq[0] = atomicAdd((unsigned*)(WSB + WS_CTL) + 64 * g + 32, 1u);
                    __syncthreads();
                    const int sl = (int)wq[0];
                    if (sl >= NSL) break;
                    const int gw = sl * NWV + wave; const int NGW = NSL * NWV;
                    transpose_job(TP(T_WIN), 21056, 12288, 2048, DM, (bf16*)(RW + W_WINB), 0, scr, gw, NGW, lane);
                    transpose_job(TP(T_WIN), 21056, 14912, 6144, DM, (bf16*)(RW + W_WINB), 2048, scr, gw, NGW, lane);
                    transpose_job(TP(T_PA), DM, 0, DM, DM, (bf16*)(RW + W_PA), 0, scr, gw, NGW, lane);
                    transpose_job(TP(T_PD), DM, 0, DM, DM, (bf16*)(RW + W_PD), 0, scr, gw, NGW, lane);
                    transpose_job(TP(T_PM), DM, 0, DM, 512, (bf16*)(RW + W_PM), 0, scr, gw, NGW, lane);
                    transpose_job(TP(T_WO), DM, 0, DM, DM, (bf16*)(RW + W_WO), 0, scr, gw, NGW, lane);
                }
            }
            if (rep + 1 < P3_REPS) GSYNC();
        }
        GSYNC();
        for (int rp = 0; rp < GEMM_REPS; ++rp)
        run_gemm_l(lds + LDS_PH, H, (const bf16*)(RW + W_WINB), TG, NP1B, DM, F_P1b{ZB, GATES, TP(T_BGATE)});
        GSYNC();
        {
            PHASE_IDS();
            const int l16 = lane & 15, sub = lane >> 4; const float* gon = TP(T_GON);
            { bf16* gf = GDNF; const bf16* gb = GDNB; const bf16* zb = ZB;
              for (int it0 = gw; it0 < TG * 4; it0 += 4 * NGW) {
                size_t off[4]; u32x4 ra[4], rb[4], rz[4];
#pragma unroll
                for (int u = 0; u < 4; ++u) { const int it = it0 + u * NGW, row = it >> 2, hd = (it & 3) * 4 + sub; off[u] = (size_t)row * DM + hd * 128 + l16 * 8;
                    ra[u] = *(const u32x4*)(gf + off[u]); rb[u] = *(const u32x4*)(gb + off[u]); rz[u] = *(const u32x4*)(zb + off[u]); }
#pragma unroll
                for (int u = 0; u < 4; ++u) { float a[8], b[8], z[8]; unpack8(ra[u], a); unpack8(rb[u], b); unpack8(rz[u], z);
                    float ss = 0.f;
#pragma unroll
                    for (int e = 0; e < 8; ++e) { a[e] += b[e]; ss += a[e] * a[e]; }
                    ss += __shfl_xor(ss, 1); ss += __shfl_xor(ss, 2); ss += __shfl_xor(ss, 4); ss += __shfl_xor(ss, 8);
                    const float inv = rsq_(ss * (1.f / 128.f) + EPS);
#pragma unroll
                    for (int e = 0; e < 8; ++e) a[e] = a[e] * inv * gon[l16 * 8 + e] * (z[e] * sigmoidf_(z[e]));
                    *(u32x4*)(gf + off[u]) = pack8(a); } } }
        }
        {
            PHASE_IDS();
            const int l32 = lane & 31, sub = lane >> 5; const float* subln = TP(T_DASUB);
            { bf16* ao = AOUT; const float* sq = SSQ; const f32x4 g0 = *(const f32x4*)(subln + l32 * 8), g1 = *(const f32x4*)(subln + l32 * 8 + 4);
              for (int it0 = gw; it0 < TG * 4; it0 += 8 * NGW) {
                bf16* ap[8]; u32x4 ra[8]; float t0[8], t1[8];
#pragma unroll
                for (int u = 0; u < 8; ++u) { const int it = it0 + u * NGW, row = it >> 2, hd = (it & 3) * 2 + sub; ap[u] = ao + (size_t)row * DM + hd * 256 + l32 * 8;
                    ra[u] = *(const u32x4*)ap[u]; t0[u] = sq[(size_t)row * 16 + hd * 2]; t1[u] = sq[(size_t)row * 16 + hd * 2 + 1]; }
#pragma unroll
                for (int u = 0; u < 8; ++u) { float a[8]; unpack8(ra[u], a);
                    const float rinv = (rsq_((t0[u] + t1[u]) * (1.f / 256.f) + EPS)) * 0.8f;
#pragma unroll
                    for (int e = 0; e < 4; ++e) { a[e] *= rinv * g0[e]; a[4 + e] *= rinv * g1[e]; }
                    *(u32x4*)ap[u] = pack8(a); } } }
        }
        GSYNC();
        for (int rp = 0; rp < GEMM_REPS; ++rp) {
        run_gemm_l(lds + LDS_PH, AOUT, (const bf16*)(RW + W_PA), TG, DM, DM, F_Merge{GATES, H, 1});
        run_gemm_l(lds + LDS_PH, GDNF, (const bf16*)(RW + W_PD), TG, DM, DM, F_Merge{GATES + DM, H, 0});
        run_gemm_l(lds + LDS_PH, COUT, (const bf16*)(RW + W_PM), TG, DM, 512, F_Merge{GATES + 2 * DM, H, 0}); }
        GSYNC();
        for (int rp = 0; rp < GEMM_REPS; ++rp)
        run_gemm_l(lds + LDS_PH, H, (const bf16*)(RW + W_WO), TG, DM, DM, F_Wo{X, OUT});
        GSYNC();
        {
            PHASE_IDS();
            for (int m = gw; m < TG; m += NGW) rms_row(OUT + (size_t)m * DM, TP(T_GFFN), H + (size_t)m * DM, lane);
            transpose_job(TP(T_WUP), 2 * DFF, 0, 2 * DFF, DM, (bf16*)(RW + W_UP), 0, scr, gw, NGW, lane);
            transpose_job(TP(T_WDOWN), DM, 0, DM, DFF, WDN, 0, scr, gw, NGW, lane);
        }
        GSYNC();
        for (int rp = 0; rp < GEMM_REPS; ++rp)
        run_gemm(lds + LDS_PH, H, (const bf16*)(RW + W_UP), TG, 2 * DFF, DM, F_Up{GT, UP});
        GSYNC();
        {
            PHASE_IDS();
            const int ncg = DFF / 8;
            const float* fcw = TP(T_FCW); const float* fcb = TP(T_FCB); const bf16* gt = GT; bf16* up = UP;
            for (int it = blockIdx.x * NTHR + tid; it < (TG / 8) * ncg; it += gridDim.x * NTHR) { const int run = it / ncg, c0 = (it - run * ncg) * 8, row0 = run * 8, t0 = row0 & (S - 1);
                u32x4 g[10], uu[8];
                const u32x4 zero4 = (u32x4){0u, 0u, 0u, 0u};
#pragma unroll
                for (int r = 0; r < 10; ++r) { const int tt = t0 + r - 1; g[r] = (tt >= 0 && tt < S) ? *(const u32x4*)(gt + (size_t)(row0 + r - 1) * DFF + c0) : zero4; }
#pragma unroll
                for (int r = 0; r < 8; ++r) uu[r] = *(const u32x4*)(up + (size_t)(row0 + r) * DFF + c0);
                f32x4 w[3][2];
#pragma unroll
                for (int j = 0; j < 3; ++j) { w[j][0] = *(const f32x4*)(fcw + j * DFF + c0); w[j][1] = *(const f32x4*)(fcw + j * DFF + c0 + 4); }
                const f32x4 b0 = *(const f32x4*)(fcb + c0), b1 = *(const f32x4*)(fcb + c0 + 4);
#pragma unroll
                for (int r = 0; r < 8; ++r) { float acc[8], u[8], xv[8];
#pragma unroll
                    for (int e = 0; e < 4; ++e) { acc[e] = b0[e]; acc[4 + e] = b1[e]; }
#pragma unroll
                    for (int j = 0; j < 3; ++j) { unpack8(g[r + j], xv);
#pragma unroll
                        for (int e = 0; e < 4; ++e) { acc[e] = fmaf(w[j][0][e], xv[e], acc[e]); acc[4 + e] = fmaf(w[j][1][e], xv[4 + e], acc[4 + e]); } }
                    unpack8(uu[r], u);
#pragma unroll
                    for (int e = 0; e < 8; ++e) u[e] *= acc[e] * sigmoidf_(acc[e]);
                    *(u32x4*)(up + (size_t)(row0 + r) * DFF + c0) = pack8(u); } }
        }
        GSYNC();
        run_gemm_l(lds + LDS_PH, UP, (const bf16*)WDN, TG, DM, DFF, F_Down{OUT});
        GSYNC();
    }
}

extern "C" void kernel_launch(void* const* d_in, const int* in_sizes, int n_in, void* d_out, int out_size, void* d_ws, size_t ws_size, hipStream_t stream) {
    static int grid_blocks = 0;
    if (grid_blocks == 0) {
        if (n_in != 28 || ws_size < WS_END || out_size != 2 * TG * DM) { fprintf(stderr, "kernel_launch: unexpected shapes: n_in %d out %d ws %zu (need %zu)\n", n_in, out_size, ws_size, (size_t)WS_END); grid_blocks = -1; return; }
        int dev = 0, cus = 0, per_cu = 0;
        hipGetDevice(&dev); hipDeviceGetAttribute(&cus, hipDeviceAttributeMultiprocessorCount, dev);
        if (hipFuncSetAttribute((const void*)hybrid_fwd, hipFuncAttributeMaxDynamicSharedMemorySize, LDS_BYTES) != hipSuccess) { fprintf(stderr, "kernel_launch: hipFuncSetAttribute failed\n"); grid_blocks = -1; return; }
        if (hipOccupancyMaxActiveBlocksPerMultiprocessor(&per_cu, (const void*)hybrid_fwd, NTHR, LDS_BYTES) != hipSuccess || per_cu < 1) { fprintf(stderr, "kernel_launch: occupancy query gave %d\n", per_cu); per_cu = 1; }
        (void)hipGetLastError();
        grid_blocks = cus * 1;
        fprintf(stderr, "kernel_launch: grid %d (cus %d, per_cu %d), ws %zu need %zu\n", grid_blocks, cus, per_cu, ws_size, (size_t)WS_END);
    }
    if (grid_blocks < 0) return;
    hipMemsetAsync((char*)d_ws + WS_CTL, 0, 65536, stream);
    Params p{};
    const float* const* in = (const float* const*)d_in;
    p.x[0] = in[0]; p.x[1] = in[1]; p.mem[0] = in[2]; p.mem[1] = in[3]; p.out[0] = (float*)d_out; p.out[1] = (float*)d_out + (size_t)TG * DM;
    p.g_mix = in[4]; p.g_mem = in[5]; p.w_in = in[6]; p.b_gate = in[7]; p.da_q_norm = in[8]; p.da_k_norm = in[9]; p.da_lambda = in[10]; p.da_subln = in[11];
    p.gdn_conv_w = in[12]; p.gdn_A_log = in[13]; p.gdn_dt_bias = in[14]; p.gdn_out_norm = in[15]; p.xa_q_norm = in[16]; p.xa_k_norm = in[17]; p.w_mem_kv = in[18];
    p.p_attn = in[19]; p.p_gdn = in[20]; p.p_mem = in[21]; p.w_o = in[22]; p.g_ffn = in[23]; p.w_up = in[24]; p.ffn_conv_w = in[25]; p.ffn_conv_b = in[26]; p.w_down = in[27];
    p.ws = (unsigned char*)d_ws;
    void* args[] = {&p};
    hipError_t e = hipLaunchCooperativeKernel((const void*)hybrid_fwd, dim3(grid_blocks), dim3(NTHR), args, LDS_BYTES, stream);
    if (e != hipSuccess) fprintf(stderr, "cooperative launch failed: %s (grid %d)\n", hipGetErrorString(e), grid_blocks);
}
```

```cpp
#include <hip/hip_runtime.h>
#include <hip/hip_cooperative_groups.h>
#include <cstdio>
#include <cstdint>
namespace cg = cooperative_groups;

namespace pg8 {
#define PG8_LAS __attribute__((address_space(3)))
typedef unsigned short bf16_t;
typedef short bf16x8 __attribute__((ext_vector_type(8)));
typedef float f32x4 __attribute__((ext_vector_type(4)));
typedef unsigned u32x4 __attribute__((ext_vector_type(4)));
constexpr int BM = 256, BK = 64, HALF = 128, HTB = HALF * BK * 2  , STAGE_BYTES = 8 * HTB, NXCD = 8, WGM = 8;

__host__ __device__ __forceinline__ int lds_byte(int r, int c) { const int st = (r >> 4) * 2 + (c >> 5), rr = r & 15, cc = c & 31, ob = rr * 64 + cc * 2; return st * 1024 + (ob ^ (((ob >> 9) & 1) << 5)); }
__host__ __device__ __forceinline__ void stage_rc(int b, int& R, int& C) { const int st = b / 1024, sb = b % 1024, swz = sb ^ (((sb >> 9) & 1) << 5); R = (st >> 1) * 16 + swz / 64; C = (st & 1) * 32 + (swz % 64) / 2; }
__host__ __device__ __forceinline__ int perm32(int rho) { const int n = rho >> 4, i = rho & 15; return 8 * (i >> 2) + 4 * n + (i & 3); }

struct Unit { int pm, pn; };
struct Gemm { const bf16_t* A; const bf16_t* Bt; int M, N, K; };

struct StaticOrder {
    int nM, nN, nwg, G, c;
    __host__ __device__ void init(int M, int N, int G_, int c_) { nM = M / BM; nN = N / BM; nwg = nM * nN; G = G_; c = c_; }
    __host__ __device__ bool next(int i, Unit& u) const {
        const long L = (long)i * G + c; if (L >= nwg) return false;
        int wgid = (int)L; { const int q = nwg / NXCD, r = nwg % NXCD, xcd = wgid % NXCD, off = wgid / NXCD; wgid = (xcd < r ? xcd * (q + 1) : r * (q + 1) + (xcd - r) * q) + off; }
        const int nig = WGM * nN, gid = wgid / nig, fm = gid * WGM, gsz = (nM - fm) < WGM ? (nM - fm) : WGM;
        u.pm = fm + ((wgid % nig) % gsz); u.pn = (wgid % nig) / gsz; return true;
    }
    __device__ __forceinline__ void a_ready(const Unit&) const {}
    __device__ __forceinline__ void done(const Unit&) const {}
};

typedef float f32x2_cv __attribute__((ext_vector_type(2))); typedef __bf16 bf16x2_cv __attribute__((ext_vector_type(2)));
__device__ __forceinline__ unsigned cvt_pk_bf16(float lo, float hi) { f32x2_cv v = {lo, hi}; bf16x2_cv b = __builtin_convertvector(v, bf16x2_cv); return __builtin_bit_cast(unsigned, b); }
template <class F> struct EpiRow8L {
    static constexpr bool PERM = true, AFTER_DRAIN = false; F f;
    __device__ __forceinline__ void operator()(const f32x4 (&acc)[2][2][4][2], const Unit& u, int wr, int wc, int fr, int fq) const {
        const int row0 = u.pm * BM + wr * 64 + fr, col0 = u.pn * BM + wc * 32 + 8 * fq;
#pragma unroll
        for (int ai = 0; ai < 2; ++ai) { typename F::Ctx c[4][2];
#pragma unroll
            for (int m = 0; m < 4; ++m)
#pragma unroll
                for (int bj = 0; bj < 2; ++bj) c[m][bj] = f.load(row0 + ai * HALF + m * 16, col0 + bj * HALF);
#pragma unroll
            for (int m = 0; m < 4; ++m)
#pragma unroll
                for (int bj = 0; bj < 2; ++bj) f.apply(c[m][bj], row0 + ai * HALF + m * 16, col0 + bj * HALF, acc[ai][bj][m][0], acc[ai][bj][m][1]); }
    }
};
template <class F> struct EpiRow8 {
    static constexpr bool PERM = true, AFTER_DRAIN = false; F f;
    __device__ __forceinline__ void operator()(const f32x4 (&acc)[2][2][4][2], const Unit& u, int wr, int wc, int fr, int fq) const {
        const int row0 = u.pm * BM + wr * 64 + fr, col0 = u.pn * BM + wc * 32 + 8 * fq;
#pragma unroll
        for (int ai = 0; ai < 2; ++ai)
#pragma unroll
            for (int m = 0; m < 4; ++m)
#pragma unroll
                for (int bj = 0; bj < 2; ++bj) f(row0 + ai * HALF + m * 16, col0 + bj * HALF, acc[ai][bj][m][0], acc[ai][bj][m][1]);
    }
};
template <class Epi, class Sched, bool ALIGN_EPI = false, bool SP2 = false>
__device__ __forceinline__ void gemm_phase(PG8_LAS unsigned char* lds, const Gemm g, const Sched& S, const Epi& E) {
    int tid_ = threadIdx.x; asm volatile("" : "+v"(tid_));
    const int tid = tid_, wid = __builtin_amdgcn_readfirstlane(tid >> 6), lane = tid & 63, wr = wid >> 2, wc = wid & 3, fr = lane & 15, fq = lane >> 4;
    const int K = g.K, nt = K / BK;
    unsigned voffA[2], voffB[2];
#pragma unroll
    for (int i = 0; i < 2; ++i) { int R, C; stage_rc(tid * 16 + i * 8192, R, C); const int Rb = Epi::PERM ? ((R & ~31) + perm32(R & 31)) : R;
        voffA[i] = (unsigned)(R * K + C) * 2u; voffB[i] = (unsigned)(Rb * K + C) * 2u; }
    const size_t kstep = (size_t)(BK * 2);
    const size_t hstep = (size_t)HALF * K * 2;
    const size_t tstep = 2 * hstep;
    const unsigned ldsw = (unsigned)wid * 1024u;
    const int aoff = lds_byte(wr * 64 + fr, fq * 8), boff = lds_byte(wc * 32 + fr, fq * 8);
#define PG8_SA(b, h) (((b) * 2 + (h)) * HTB)
#define PG8_SB(b, h) ((4 + (b) * 2 + (h)) * HTB)
#define PG8_STAGE(bufoff, gbase, voff) do { _Pragma("unroll") for (int _i = 0; _i < 2; ++_i) \
        __builtin_amdgcn_global_load_lds((const unsigned*)((const char*)(gbase) + (voff)[_i]), (PG8_LAS unsigned*)(lds + (bufoff) + ldsw + _i * 8192), 16, 0, 0); } while (0)
#define PG8_LDA(dst, b, h) do { _Pragma("unroll") for (int m = 0; m < 4; ++m) _Pragma("unroll") for (int k = 0; k < 2; ++k) dst[m][k] = *(const PG8_LAS bf16x8*)(lds + PG8_SA(b, h) + aoff + m * 2048 + k * 1024); } while (0)
#define PG8_LDB(dst, b, h) do { _Pragma("unroll") for (int n = 0; n < 2; ++n) _Pragma("unroll") for (int k = 0; k < 2; ++k) dst[n][k] = *(const PG8_LAS bf16x8*)(lds + PG8_SB(b, h) + boff + n * 2048 + k * 1024); } while (0)
#define PG8_MMA(ai, bj, At, Bt) do { __builtin_amdgcn_s_setprio(1); _Pragma("unroll") for (int m = 0; m < 4; ++m) _Pragma("unroll") for (int n = 0; n < 2; ++n) _Pragma("unroll") for (int k = 0; k < 2; ++k) \
        acc[ai][bj][m][n] = __builtin_amdgcn_mfma_f32_16x16x32_bf16(Bt[n][k], At[m][k], acc[ai][bj][m][n], 0, 0, 0); __builtin_amdgcn_s_setprio(0); } while (0)
#define PG8_WAIT_V(n) asm volatile("s_waitcnt vmcnt(" #n ")" ::: "memory")
#define PG8_WAIT_L(n) asm volatile("s_waitcnt lgkmcnt(" #n ")" ::: "memory")
#define PG8_BAR __builtin_amdgcn_s_barrier()
#define PG8_SCHED __builtin_amdgcn_sched_barrier(0)
    Unit cur, nxt; int ui = 0;
    if (!S.next(0, cur)) return;
    f32x4 acc[2][2][4][2];
#pragma unroll
    for (int a = 0; a < 2; ++a)
#pragma unroll
        for (int b = 0; b < 2; ++b)
#pragma unroll
            for (int m = 0; m < 4; ++m)
#pragma unroll
                for (int n = 0; n < 2; ++n) acc[a][b][m][n] = (f32x4){0.f, 0.f, 0.f, 0.f};
    bf16x8 At[4][2], B0[2][2], B1[2][2];
    const char* cA = (const char*)g.A + (size_t)cur.pm * tstep; const char* cB = (const char*)g.Bt + (size_t)cur.pn * tstep;
    S.a_ready(cur);
    if constexpr (SP2) {
        PG8_STAGE(PG8_SB(0, 0), cB, voffB); PG8_STAGE(PG8_SB(0, 1), cB + hstep, voffB); PG8_STAGE(PG8_SA(0, 0), cA, voffA); PG8_STAGE(PG8_SA(0, 1), cA + hstep, voffA);
        if (wr == 1) PG8_BAR;
        PG8_WAIT_V(2); PG8_BAR;
        PG8_STAGE(PG8_SB(1, 0), cB + kstep, voffB); PG8_STAGE(PG8_SA(1, 0), cA + kstep, voffA); PG8_STAGE(PG8_SB(1, 1), cB + hstep + kstep, voffB);
        PG8_WAIT_V(6); PG8_BAR;
    } else {
        PG8_STAGE(PG8_SB(0, 0), cB, voffB); PG8_STAGE(PG8_SA(0, 0), cA, voffA); PG8_STAGE(PG8_SB(0, 1), cB + hstep, voffB); PG8_STAGE(PG8_SA(0, 1), cA + hstep, voffA);
        if (wr == 1) PG8_BAR;
        PG8_WAIT_V(4); PG8_BAR;
        PG8_STAGE(PG8_SB(1, 0), cB + kstep, voffB); PG8_STAGE(PG8_SA(1, 0), cA + kstep, voffA); PG8_STAGE(PG8_SB(1, 1), cB + hstep + kstep, voffB);
        PG8_WAIT_V(6); PG8_BAR;
    }
    for (;;) {
        const bool has_next = S.next(ui + 1, nxt);
        const char* nA = has_next ? (const char*)g.A + (size_t)nxt.pm * tstep : cA; const char* nB = has_next ? (const char*)g.Bt + (size_t)nxt.pn * tstep : cB;
        for (int t = 0; t < nt; t += 2) {
            const bool last = (t == nt - 2);
            const char* a1 = cA + (size_t)(t + 1) * kstep;
            const char* a2 = last ? nA : cA + (size_t)(t + 2) * kstep; const char* b2 = last ? nB : cB + (size_t)(t + 2) * kstep;
            const char* a3 = a2 + kstep; const char* b3 = b2 + kstep;
            if (last && has_next) S.a_ready(nxt);
            if constexpr (SP2) {
            PG8_LDB(B0, 0, 0); PG8_LDB(B1, 0, 1); PG8_SCHED; PG8_LDA(At, 0, 0); PG8_STAGE(PG8_SA(1, 1), a1 + hstep, voffA);
            PG8_WAIT_V(8); PG8_WAIT_L(0); PG8_BAR; PG8_MMA(0, 0, At, B0); PG8_MMA(0, 1, At, B1); PG8_BAR; PG8_SCHED;
            PG8_LDA(At, 0, 1); PG8_STAGE(PG8_SB(0, 0), b2, voffB); PG8_STAGE(PG8_SB(0, 1), b2 + hstep, voffB); PG8_STAGE(PG8_SA(0, 0), a2, voffA);
            PG8_WAIT_V(8); PG8_WAIT_L(0); PG8_BAR; PG8_MMA(1, 0, At, B0); PG8_MMA(1, 1, At, B1); PG8_BAR; PG8_SCHED;
            PG8_LDB(B0, 1, 0); PG8_LDB(B1, 1, 1); PG8_SCHED; PG8_LDA(At, 1, 0); PG8_STAGE(PG8_SA(0, 1), a2 + hstep, voffA);
            PG8_WAIT_V(8); PG8_WAIT_L(0); PG8_BAR; PG8_MMA(0, 0, At, B0); PG8_MMA(0, 1, At, B1); PG8_BAR; PG8_SCHED;
            PG8_LDA(At, 1, 1); PG8_STAGE(PG8_SB(1, 0), b3, voffB); PG8_STAGE(PG8_SB(1, 1), b3 + hstep, voffB); PG8_STAGE(PG8_SA(1, 0), a3, voffA);
            PG8_WAIT_V(8); PG8_WAIT_L(0); PG8_BAR; PG8_MMA(1, 0, At, B0); PG8_MMA(1, 1, At, B1); PG8_BAR; PG8_SCHED;
            } else {
            PG8_LDB(B0, 0, 0); PG8_SCHED; PG8_LDA(At, 0, 0); PG8_STAGE(PG8_SA(1, 1), a1 + hstep, voffA);
            PG8_WAIT_L(8); PG8_BAR; PG8_WAIT_L(0); PG8_MMA(0, 0, At, B0); PG8_BAR; PG8_SCHED;
            PG8_LDB(B1, 0, 1); PG8_STAGE(PG8_SB(0, 0), b2, voffB);
            PG8_BAR; PG8_WAIT_L(0); PG8_MMA(0, 1, At, B1); PG8_BAR;
            PG8_LDA(At, 0, 1); PG8_STAGE(PG8_SA(0, 0), a2, voffA);
            PG8_BAR; PG8_WAIT_L(0); PG8_MMA(1, 0, At, B0); PG8_BAR; PG8_SCHED;
            PG8_STAGE(PG8_SB(0, 1), b2 + hstep, voffB);
            PG8_WAIT_V(6); PG8_BAR; PG8_MMA(1, 1, At, B1); PG8_BAR;
            PG8_LDB(B0, 1, 0); PG8_SCHED; PG8_LDA(At, 1, 0); PG8_STAGE(PG8_SA(0, 1), a2 + hstep, voffA);
            PG8_WAIT_L(8); PG8_BAR; PG8_WAIT_L(0); PG8_MMA(0, 0, At, B0); PG8_BAR; PG8_SCHED;
            PG8_LDB(B1, 1, 1); PG8_STAGE(PG8_SB(1, 0), b3, voffB);
            PG8_BAR; PG8_WAIT_L(0); PG8_MMA(0, 1, At, B1); PG8_BAR;
            PG8_LDA(At, 1, 1); PG8_STAGE(PG8_SA(1, 0), a3, voffA);
            PG8_BAR; PG8_WAIT_L(0); PG8_MMA(1, 0, At, B0); PG8_BAR; PG8_SCHED;
            PG8_STAGE(PG8_SB(1, 1), b3 + hstep, voffB);
            PG8_WAIT_V(6); PG8_BAR; PG8_MMA(1, 1, At, B1); PG8_BAR;
            }
        }
        if constexpr (ALIGN_EPI) { if (wr == 0) PG8_BAR; }
        if constexpr (!Epi::AFTER_DRAIN) { E(acc, cur, wr, wc, fr, fq); S.done(cur); }
        if (!has_next) break;
#pragma unroll
        for (int a = 0; a < 2; ++a)
#pragma unroll
            for (int b = 0; b < 2; ++b)
#pragma unroll
                for (int m = 0; m < 4; ++m)
#pragma unroll
                    for (int n = 0; n < 2; ++n) acc[a][b][m][n] = (f32x4){0.f, 0.f, 0.f, 0.f};
        cur = nxt; cA = nA; cB = nB; ++ui;
        if constexpr (ALIGN_EPI) { if (wr == 1) PG8_BAR; }
    }
    PG8_WAIT_V(0);
    if constexpr (!ALIGN_EPI) { if (wr == 0) PG8_BAR; }
    PG8_BAR;
    if constexpr (Epi::AFTER_DRAIN) { E.fused(acc, cur, wr, wc, fr, fq, lds, wid, lane); S.done(cur); }
#undef PG8_SA
#undef PG8_SB
#undef PG8_STAGE
#undef PG8_LDA
#undef PG8_LDB
#undef PG8_MMA
#undef PG8_WAIT_V
#undef PG8_WAIT_L
#undef PG8_BAR
#undef PG8_SCHED
}
}

#define LAS __attribute__((address_space(3)))
typedef unsigned short bf16;
typedef short bf16x8 __attribute__((ext_vector_type(8)));
typedef short s16x4 __attribute__((ext_vector_type(4)));
typedef float f32x4 __attribute__((ext_vector_type(4)));
typedef float f32x16 __attribute__((ext_vector_type(16)));
typedef unsigned u32x4 __attribute__((ext_vector_type(4)));
typedef unsigned u32x2 __attribute__((ext_vector_type(2)));

constexpr int DM = 2048, TG = 16384, NPROJ = 12800, NP1 = 13056, NP1B = 8192, DFF = 5632;
constexpr int C_DAQ = 0, C_DAK = 2048, C_DAV = 4096, C_GDN = 6144, C_XAQ = 12288;
constexpr float EPS = 1e-6f, LOG2E = 1.4426950408889634f, QSCALE = 0.08838834764831845f * 1.4426950408889634f;
constexpr int NTHR = 512, NWV = 8;

constexpr size_t WS_CTL = 0, WS_H = 65536, WS_AB = WS_H + (size_t)TG * DM * 2, WS_MEMN = WS_AB + (size_t)TG * 64 * 4,
                 WS_MEMKV = WS_MEMN + (size_t)1024 * DM * 2, WS_COUT = WS_MEMKV + (size_t)1024 * 1024 * 2, WS_GDNB = WS_COUT + (size_t)TG * 512 * 2,
                 WS_W = WS_GDNB + (size_t)TG * DM * 2, WS_BIG = WS_W + (size_t)69206016, WS_HALO = WS_BIG + (size_t)TG * NPROJ * 2, WS_SSQ = WS_HALO + (size_t)256 * 4 * 6144 * 2, WS_END = WS_SSQ + (size_t)TG * 16 * 4;
constexpr size_t W_WINA = 0, W_WMKV = (size_t)NP1 * DM * 2;
constexpr size_t W_WINB = 0, W_PA = (size_t)NP1B * DM * 2, W_PD = W_PA + (size_t)DM * DM * 2, W_PM = W_PD + (size_t)DM * DM * 2, W_WO = W_PM + (size_t)DM * 512 * 2;
constexpr size_t W_UP = 0, W_DOWN = (size_t)2 * DFF * DM * 2;
static_assert(W_WO + (size_t)DM * DM * 2 <= 69206016 && W_DOWN + (size_t)DM * DFF * 2 <= 69206016 && W_WMKV + (size_t)1024 * DM * 2 <= 69206016, "R_W");
constexpr int LDS_BYTES = 159744;

struct Params {
    const float* x[2]; const float* mem[2]; float* out[2];
    const float *g_mix, *g_mem, *w_in, *b_gate, *da_q_norm, *da_k_norm, *da_lambda, *da_subln, *gdn_conv_w, *gdn_A_log, *gdn_dt_bias, *gdn_out_norm,
                *xa_q_norm, *xa_k_norm, *w_mem_kv, *p_attn, *p_gdn, *p_mem, *w_o, *g_ffn, *w_up, *ffn_conv_w, *ffn_conv_b, *w_down;
    unsigned char* ws;
};

constexpr int LDS_TBL = 0, LDS_WQ = 256, LDS_PH = 512;
enum { T_X0, T_X1, T_MEM0, T_MEM1, T_OUT0, T_OUT1, T_GMIX, T_GMEM, T_WIN, T_BGATE, T_DAQN, T_DAKN, T_DALAM, T_DASUB, T_GCONV, T_GALOG, T_GDT, T_GON, T_XQN, T_XKN, T_WMKV, T_PA, T_PD, T_PM, T_WO, T_GFFN, T_WUP, T_FCW, T_FCB, T_WDOWN, T_WS, T_N };
__device__ __forceinline__ const float* tptr(const LAS unsigned char* lds, int i) {
    const LAS unsigned* t = (const LAS unsigned*)(lds + LDS_TBL) + 2 * i; unsigned lo = t[0], hi = t[1];
    lo = __builtin_amdgcn_readfirstlane(lo); hi = __builtin_amdgcn_readfirstlane(hi);
    return (const float*)(((unsigned long long)hi << 32) | (unsigned long long)lo);
}
__device__ __forceinline__ unsigned f2bf(float f) { return pg8::cvt_pk_bf16(f, 0.f) & 0xffffu; }
__device__ __forceinline__ unsigned pk2(float lo, float hi) { return pg8::cvt_pk_bf16(lo, hi); }
__device__ __forceinline__ float bf2f(unsigned short b) { return __builtin_bit_cast(float, (unsigned)b << 16); }
__device__ __forceinline__ float bflo(unsigned w) { return __builtin_bit_cast(float, w << 16); }
__device__ __forceinline__ float bfhi(unsigned w) { return __builtin_bit_cast(float, w & 0xffff0000u); }
__device__ __forceinline__ float wave_sum(float v) {
#pragma unroll
    for (int o = 1; o < 64; o <<= 1) v += __shfl_xor(v, o);
    return v;
}
__device__ __forceinline__ void unpack8(u32x4 w, float* f) { f[0] = bflo(w.x); f[1] = bfhi(w.x); f[2] = bflo(w.y); f[3] = bfhi(w.y); f[4] = bflo(w.z); f[5] = bfhi(w.z); f[6] = bflo(w.w); f[7] = bfhi(w.w); }
__device__ __forceinline__ u32x4 pack8(const float* f) { u32x4 w; w.x = pk2(f[0], f[1]); w.y = pk2(f[2], f[3]); w.z = pk2(f[4], f[5]); w.w = pk2(f[6], f[7]); return w; }
__device__ __forceinline__ float sigmoidf_(float x) { return __builtin_amdgcn_rcpf(1.f + __expf(-x)); }
__device__ __forceinline__ float rsq_(float x) { return __builtin_amdgcn_rsqf(x); }

__device__ __forceinline__ void transpose_job(const float* W, int ldw, int col0, int ncols, int K, bf16* WT, int row0, LAS float* scr, int gw, int NGW, int lane) {
    typedef float f32x2t __attribute__((ext_vector_type(2)));
    const int nblk = ncols / 64, nitems = (K / 64) * nblk;
    const int lr = lane >> 4, lc = (lane & 15) * 4;
    const int sn = lane >> 3, sc = lane & 7;
#ifndef TR_REPS
#define TR_REPS 1
#endif
    if (gw >= nitems) return;
    f32x4 v[16];
#define TRJ_LOAD(it_) do { const int kb_ = (it_) / nblk, nb_ = (it_) - kb_ * nblk; const float* src_ = W + (size_t)(64 * kb_ + lr) * ldw + col0 + 64 * nb_ + lc; \
        _Pragma("unroll") for (int i = 0; i < 16; ++i) v[i] = *(const f32x4*)(src_ + (size_t)(4 * i) * ldw); } while (0)
    TRJ_LOAD(gw);
    for (int item = gw; item < nitems; item += NGW) {
        const int kb = item / nblk, nb = item - kb * nblk, k0 = 64 * kb, n0 = 64 * nb;
#pragma unroll
        for (int i = 0; i < 16; ++i) { LAS float* d = scr + (4 * i + lr) * 66 + lc; *(LAS f32x2t*)d = (f32x2t){v[i].x, v[i].y}; *(LAS f32x2t*)(d + 2) = (f32x2t){v[i].z, v[i].w}; }
        asm volatile("s_waitcnt lgkmcnt(0)" ::: "memory");
        if (item + NGW < nitems) TRJ_LOAD(item + NGW);
#pragma unroll
        for (int j = 0; j < 8; ++j) { const int n = sn + 8 * j; const LAS float* s = scr + (8 * sc) * 66 + n;
            u32x4 o; o.x = pk2(s[0 * 66], s[1 * 66]); o.y = pk2(s[2 * 66], s[3 * 66]); o.z = pk2(s[4 * 66], s[5 * 66]); o.w = pk2(s[6 * 66], s[7 * 66]);
            *(u32x4*)(WT + (size_t)(row0 + n0 + n) * K + k0 + 8 * sc) = o; }
        asm volatile("s_waitcnt lgkmcnt(0)" ::: "memory");
    }
#undef TRJ_LOAD
}
__device__ __forceinline__ void rms_row(const float* xrow, const float* gain, bf16* orow, int lane) {
    const f32x4* xr = (const f32x4*)xrow + lane; const f32x4* gr = (const f32x4*)gain + lane;
    f32x4 v[8]; float s = 0.f;
#pragma unroll
    for (int j = 0; j < 8; ++j) { v[j] = xr[64 * j]; s += (v[j].x * v[j].x + v[j].y * v[j].y) + (v[j].z * v[j].z + v[j].w * v[j].w); }
    const float inv = rsq_(wave_sum(s) * (1.f / DM) + EPS);
    u32x2* o8 = (u32x2*)orow + lane;
#pragma unroll
    for (int j = 0; j < 8; ++j) { const f32x4 g = gr[64 * j]; u32x2 w; w.x = pk2(v[j].x * inv * g.x, v[j].y * inv * g.y); w.y = pk2(v[j].z * inv * g.z, v[j].w * inv * g.w); o8[64 * j] = w; }
}

__device__ __forceinline__ u32x4 pack_v(f32x4 v0, f32x4 v1) { u32x4 w; w.x = pg8::cvt_pk_bf16(v0[0], v0[1]); w.y = pg8::cvt_pk_bf16(v0[2], v0[3]); w.z = pg8::cvt_pk_bf16(v1[0], v1[1]); w.w = pg8::cvt_pk_bf16(v1[2], v1[3]); return w; }
struct F_P1 { bf16* proj; float* ab;
    __device__ __forceinline__ void operator()(int row, int col, f32x4 v0, f32x4 v1) const {
        if (col < NPROJ) *(u32x4*)(proj + (size_t)row * NPROJ + col) = pack_v(v0, v1);
        else if (col < NPROJ + 64) { float* p = ab + (size_t)row * 64 + (col - NPROJ); *(f32x4*)p = v0; *(f32x4*)(p + 4) = v1; } } };
struct F_Bf16 { bf16* O; int ldc;
    __device__ __forceinline__ void operator()(int row, int col, f32x4 v0, f32x4 v1) const { *(u32x4*)(O + (size_t)row * ldc + col) = pack_v(v0, v1); } };
struct F_P1b { bf16* z; bf16* gates; const float* bg;
    struct Ctx { f32x4 b0, b1; };
    __device__ __forceinline__ Ctx load(int row, int col) const { Ctx c; const int c2 = col < DM ? 0 : col - DM; c.b0 = *(const f32x4*)(bg + c2); c.b1 = *(const f32x4*)(bg + c2 + 4); return c; }
    __device__ __forceinline__ void apply(const Ctx& c, int row, int col, f32x4 v0, f32x4 v1) const {
        if (col < DM) *(u32x4*)(z + (size_t)row * DM + col) = pack_v(v0, v1);
        else { const int c2 = col - DM;
#pragma unroll
            for (int e = 0; e < 4; ++e) { v0[e] = sigmoidf_(v0[e] + c.b0[e]); v1[e] = sigmoidf_(v1[e] + c.b1[e]); }
            *(u32x4*)(gates + (size_t)row * 6144 + c2) = pack_v(v0, v1); } } };
struct F_Merge { const bf16* gates; bf16* merged; int first;
    struct Ctx { u32x4 g, p; };
    __device__ __forceinline__ Ctx load(int row, int col) const { Ctx c; c.g = *(const u32x4*)(gates + (size_t)row * 6144 + col); c.p = first ? (u32x4){0u, 0u, 0u, 0u} : *(const u32x4*)(merged + (size_t)row * DM + col); return c; }
    __device__ __forceinline__ void apply(const Ctx& c, int row, int col, f32x4 v0, f32x4 v1) const {
        float g[8], pv[8], r[8]; unpack8(c.g, g); unpack8(c.p, pv);
#pragma unroll
        for (int e = 0; e < 4; ++e) { r[e] = fmaf(g[e], v0[e], pv[e]); r[4 + e] = fmaf(g[4 + e], v1[e], pv[4 + e]); }
        *(u32x4*)(merged + (size_t)row * DM + col) = pack8(r); } };
struct F_Wo { const float* x; float* out;
    struct Ctx { f32x4 a, b; };
    __device__ __forceinline__ Ctx load(int row, int col) const { Ctx c; const size_t o = (size_t)row * DM + col; c.a = *(const f32x4*)(x + o); c.b = *(const f32x4*)(x + o + 4); return c; }
    __device__ __forceinline__ void apply(const Ctx& c, int row, int col, f32x4 v0, f32x4 v1) const {
        const size_t o = (size_t)row * DM + col; *(f32x4*)(out + o) = c.a + v0; *(f32x4*)(out + o + 4) = c.b + v1; } };
struct F_Up { bf16* gt; bf16* up;
    __device__ __forceinline__ void operator()(int row, int col, f32x4 v0, f32x4 v1) const {
        if (col < DFF) *(u32x4*)(gt + (size_t)row * DFF + col) = pack_v(v0, v1); else *(u32x4*)(up + (size_t)row * DFF + (col - DFF)) = pack_v(v0, v1); } };
struct F_Down { float* out;
    struct Ctx { f32x4 a, b; };
    __device__ __forceinline__ Ctx load(int row, int col) const { Ctx c; const size_t o = (size_t)row * DM + col; c.a = *(const f32x4*)(out + o); c.b = *(const f32x4*)(out + o + 4); return c; }
    __device__ __forceinline__ void apply(const Ctx& c, int row, int col, f32x4 v0, f32x4 v1) const {
        const size_t o = (size_t)row * DM + col; *(f32x4*)(out + o) = c.a + v0; *(f32x4*)(out + o + 4) = c.b + v1; } };

struct EpiP1 {
    static constexpr bool PERM = true, AFTER_DRAIN = false;
    bf16* proj; float* ab; const float* gq; const float* gk; const float* gx; LAS float* exch; bf16* halo;
    __device__ __forceinline__ void operator()(const pg8::f32x4 (&acc)[2][2][4][2], const pg8::Unit& u, int wr, int wc, int fr, int fq) const {
        const int colt = u.pn * 256, row0 = u.pm * 256 + wr * 64 + fr, col0 = colt + wc * 32 + 8 * fq;
        const bool normed = (colt < C_DAV) || (colt >= C_XAQ && colt < NPROJ);
        if (normed) {
#pragma unroll
            for (int ai = 0; ai < 2; ++ai)
#pragma unroll
                for (int m = 0; m < 4; ++m)
#pragma unroll
                    for (int bj = 0; bj < 2; ++bj) { const pg8::f32x4 a = acc[ai][bj][m][0], b = acc[ai][bj][m][1];
                        float s = (a[0] * a[0] + a[1] * a[1]) + (a[2] * a[2] + a[3] * a[3]) + (b[0] * b[0] + b[1] * b[1]) + (b[2] * b[2] + b[3] * b[3]);
                        s += __shfl_xor(s, 16); s += __shfl_xor(s, 32);
                        if (fq == 0) exch[((ai * 128 + wr * 64 + m * 16 + fr) * 2 + bj) * 4 + wc] = s; }
            asm volatile("s_waitcnt lgkmcnt(0)" ::: "memory"); __builtin_amdgcn_s_barrier(); asm volatile("" ::: "memory");
            const float scale = (colt >= C_DAK && colt < C_DAV) ? 1.f : QSCALE; const int go = wc * 32 + 8 * fq;
            f32x4 g0, g1;
            if (colt < C_DAK) { g0 = *(const f32x4*)(gq + go); g1 = *(const f32x4*)(gq + go + 4); }
            else if (colt < C_DAV) { g0 = *(const f32x4*)(gk + go); g1 = *(const f32x4*)(gk + go + 4); }
            else { g0 = *(const f32x4*)(gx + go); g1 = *(const f32x4*)(gx + go + 4); }
#pragma unroll
            for (int ai = 0; ai < 2; ++ai)
#pragma unroll
                for (int m = 0; m < 4; ++m)
#pragma unroll
                    for (int bj = 0; bj < 2; ++bj) { const f32x4 t = *(const LAS f32x4*)(exch + ((ai * 128 + wr * 64 + m * 16 + fr) * 2 + bj) * 4);
                        const float inv = (rsq_(((t[0] + t[1]) + (t[2] + t[3])) * (1.f / 128.f) + EPS)) * scale;
                        pg8::f32x4 a = acc[ai][bj][m][0], b = acc[ai][bj][m][1];
#pragma unroll
                        for (int e = 0; e < 4; ++e) { a[e] *= inv * g0[e]; b[e] *= inv * g1[e]; }
                        *(u32x4*)(proj + (size_t)(row0 + ai * 128 + m * 16) * NPROJ + col0 + bj * 128) = pack_v(a, b); }
        } else {
#pragma unroll
            for (int ai = 0; ai < 2; ++ai)
#pragma unroll
                for (int m = 0; m < 4; ++m)
#pragma unroll
                    for (int bj = 0; bj < 2; ++bj) { const int row = row0 + ai * 128 + m * 16, col = col0 + bj * 128;
                        if (col < NPROJ) { const u32x4 w = pack_v(acc[ai][bj][m][0], acc[ai][bj][m][1]); *(u32x4*)(proj + (size_t)row * NPROJ + col) = w;
                            if (col >= C_GDN && col < C_XAQ) { const int r64 = row & 63;
                                if (r64 < 2 || r64 >= 62) *(u32x4*)(halo + ((size_t)(row >> 6) * 4 + (r64 < 2 ? r64 : r64 - 60)) * 6144 + (col - C_GDN)) = w; } }
                        else if (col < NPROJ + 64) { float* p = ab + (size_t)row * 64 + (col - NPROJ); *(f32x4*)p = acc[ai][bj][m][0]; *(f32x4*)(p + 4) = acc[ai][bj][m][1]; } }
        }
    }
};
struct EpiMKV {
    static constexpr bool PERM = true, AFTER_DRAIN = false;
    bf16* O; const float* gk; LAS float* exch;
    __device__ __forceinline__ void operator()(const pg8::f32x4 (&acc)[2][2][4][2], const pg8::Unit& u, int wr, int wc, int fr, int fq) const {
        const int colt = u.pn * 256, row0 = u.pm * 256 + wr * 64 + fr, col0 = colt + wc * 32 + 8 * fq;
        const bool normed = colt < 512;
        if (normed) {
#pragma unroll
            for (int ai = 0; ai < 2; ++ai)
#pragma unroll
                for (int m = 0; m < 4; ++m)
#pragma unroll
                    for (int bj = 0; bj < 2; ++bj) { const pg8::f32x4 a = acc[ai][bj][m][0], b = acc[ai][bj][m][1];
                        float s = (a[0] * a[0] + a[1] * a[1]) + (a[2] * a[2] + a[3] * a[3]) + (b[0] * b[0] + b[1] * b[1]) + (b[2] * b[2] + b[3] * b[3]);
                        s += __shfl_xor(s, 16); s += __shfl_xor(s, 32);
                        if (fq == 0) exch[((ai * 128 + wr * 64 + m * 16 + fr) * 2 + bj) * 4 + wc] = s; }
            asm volatile("s_waitcnt lgkmcnt(0)" ::: "memory"); __builtin_amdgcn_s_barrier(); asm volatile("" ::: "memory");
        }
        const int go = wc * 32 + 8 * fq; const f32x4 g0 = *(const f32x4*)(gk + go), g1 = *(const f32x4*)(gk + go + 4);
#pragma unroll
        for (int ai = 0; ai < 2; ++ai)
#pragma unroll
            for (int m = 0; m < 4; ++m)
#pragma unroll
                for (int bj = 0; bj < 2; ++bj) { pg8::f32x4 a = acc[ai][bj][m][0], b = acc[ai][bj][m][1];
                    if (normed) { const f32x4 t = *(const LAS f32x4*)(exch + ((ai * 128 + wr * 64 + m * 16 + fr) * 2 + bj) * 4);
                        const float inv = rsq_(((t[0] + t[1]) + (t[2] + t[3])) * (1.f / 128.f) + EPS);
#pragma unroll
                        for (int e = 0; e < 4; ++e) { a[e] *= inv * g0[e]; b[e] *= inv * g1[e]; } }
                    *(u32x4*)(O + (size_t)(row0 + ai * 128 + m * 16) * 1024 + col0 + bj * 128) = pack_v(a, b); }
    }
};
template <class F> __device__ __forceinline__ void run_gemm(LAS unsigned char* lds, const bf16* A, const bf16* Bt, int M, int N, int K, const F& f) {
    pg8::Gemm g{A, Bt, M, N, K}; pg8::StaticOrder S; S.init(M, N, (int)gridDim.x, (int)blockIdx.x);
    pg8::EpiRow8<F> E{f};
#ifndef NO_GEMM
    pg8::gemm_phase<pg8::EpiRow8<F>, pg8::StaticOrder, true, true>(lds, g, S, E);
#endif
}
template <class F> __device__ __forceinline__ void run_gemm_l(LAS unsigned char* lds, const bf16* A, const bf16* Bt, int M, int N, int K, const F& f) {
    pg8::Gemm g{A, Bt, M, N, K}; pg8::StaticOrder S; S.init(M, N, (int)gridDim.x, (int)blockIdx.x);
    pg8::EpiRow8L<F> E{f};
#ifndef NO_GEMM
    pg8::gemm_phase<pg8::EpiRow8L<F>, pg8::StaticOrder, true, true>(lds, g, S, E);
#endif
}

namespace att {
constexpr int D = 128, NW = 8, QBLK = 32, KVBLK = 64;
constexpr int SHM_V = KVBLK * D * 2, SHM_K = KVBLK * D * 2, SHM_ATTN = 2 * SHM_V + 2 * SHM_K + NW * 64 * 4;
constexpr int OFF_STASH = SHM_ATTN, OFF_SSQ = OFF_STASH + 65536, ATT_LDS = OFF_SSQ + 1024;
constexpr float THR2 = 11.5f;
#define KSWZ(row, colB) ((row) * 256 + ((colB) ^ (((row) & 7) << 4)))
#define SBAR() __builtin_amdgcn_sched_barrier(0)
__device__ __forceinline__ int crow(int r, int hi) { return (r & 3) + 8 * (r >> 2) + 4 * hi; }
__device__ __forceinline__ unsigned cvtpk(float lo, float hi) { return pg8::cvt_pk_bf16(lo, hi); }

template <bool ALIBI>
__device__ __forceinline__ void partialSM(f32x16& p0, f32x16& p1, float& m_reg, float& mn, float& alpha, float dq, float slope2, int mode) {
  float b0 = 0.f, b1 = 0.f;
  if (ALIBI) {
    if (mode != 0) {
      const float sl = mode > 0 ? slope2 : -slope2;
#pragma unroll
      for (int r = 0; r < 16; ++r) { const float c = (float)((r & 3) + 8 * (r >> 2)); p0[r] = fmaf(sl, c, p0[r]); p1[r] = fmaf(sl, c, p1[r]); }
      b0 = -sl * dq; b1 = -sl * (dq - 32.f);
    } else {
#pragma unroll
      for (int r = 0; r < 16; ++r) { const float c = (float)((r & 3) + 8 * (r >> 2)); p0[r] = fmaf(-slope2, fabsf(dq - c), p0[r]); p1[r] = fmaf(-slope2, fabsf(dq - 32.f - c), p1[r]);
        if ((r & 3) == 3) SBAR(); }
    }
  }
  float pm0 = p0[0], pm1 = p1[0];
#pragma unroll
  for (int r = 1; r < 16; ++r) { pm0 = fmaxf(pm0, p0[r]); pm1 = fmaxf(pm1, p1[r]); }
  float pmax = fmaxf(pm0 + b0, pm1 + b1);
  { auto rr = __builtin_amdgcn_permlane32_swap(__float_as_uint(pmax), __float_as_uint(pmax), false, false);
    pmax = fmaxf(__uint_as_float(rr[0]), __uint_as_float(rr[1])); }
  if (__builtin_expect(__all(pmax - m_reg <= THR2), 1)) { mn = m_reg; alpha = 1.f; }
  else { mn = fmaxf(m_reg, pmax); alpha = __builtin_amdgcn_exp2f(m_reg - mn); m_reg = mn; }
  const float d0 = b0 - mn, d1 = b1 - mn;
#pragma unroll
  for (int r = 0; r < 16; ++r) p0[r] = p0[r] + d0;
#pragma unroll
  for (int r = 0; r < 16; ++r) p1[r] = p1[r] + d1;
#pragma unroll
  for (int r = 0; r < 16; ++r) p0[r] = __builtin_amdgcn_exp2f(p0[r]);
}
__device__ __forceinline__ void finishSM(f32x16& p0, f32x16& p1, float alpha, float& l_reg, bf16x8& pa0, bf16x8& pa1, bf16x8& pa2, bf16x8& pa3) {
#pragma unroll
  for (int r = 0; r < 16; ++r) p1[r] = __builtin_amdgcn_exp2f(p1[r]);
  float ps = 0;
#pragma unroll
  for (int r = 0; r < 16; ++r) ps += p0[r];
#pragma unroll
  for (int r = 0; r < 16; ++r) ps += p1[r];
  { auto rr = __builtin_amdgcn_permlane32_swap(__float_as_uint(ps), __float_as_uint(ps), false, false);
    ps = __uint_as_float(rr[0]) + __uint_as_float(rr[1]); }
  l_reg = l_reg * alpha + ps;
#define PK4(P, BASE, OUT) do { unsigned a0 = cvtpk(P[BASE + 0], P[BASE + 1]), a1 = cvtpk(P[BASE + 2], P[BASE + 3]);   \
    unsigned b0 = cvtpk(P[BASE + 4], P[BASE + 5]), b1 = cvtpk(P[BASE + 6], P[BASE + 7]);                              \
    auto r0 = __builtin_amdgcn_permlane32_swap(a0, b0, false, false); auto r1 = __builtin_amdgcn_permlane32_swap(a1, b1, false, false); \
    u32x4 w = {r0[0], r1[0], r0[1], r1[1]}; OUT = *reinterpret_cast<bf16x8*>(&w); } while (0)
  PK4(p0, 0, pa0); PK4(p0, 8, pa1); PK4(p1, 0, pa2); PK4(p1, 8, pa3);
#undef PK4
}
__device__ __forceinline__ void qkt(f32x16& p0, f32x16& p1, const bf16* Ks, const bf16x8* qr, int r32, int hi) {
  p0 = f32x16{}; p1 = f32x16{};
#pragma unroll
  for (int d0 = 0; d0 < 8; ++d0) { int cb = (d0 * 16 + hi * 8) * 2;
    bf16x8 b0 = *reinterpret_cast<const bf16x8*>((const char*)Ks + KSWZ(r32, cb));
    bf16x8 b1 = *reinterpret_cast<const bf16x8*>((const char*)Ks + KSWZ(32 + r32, cb));
    p0 = __builtin_amdgcn_mfma_f32_32x32x16_bf16(b0, qr[d0], p0, 0, 0, 0);
    p1 = __builtin_amdgcn_mfma_f32_32x32x16_bf16(b1, qr[d0], p1, 0, 0, 0); }
}
__device__ __forceinline__ int v_st(int k, int c) { const int kk = (k & ~0xC) | ((k & 4) << 1) | ((k & 8) >> 1); return ((kk >> 3) * 4 + (c >> 5)) * 512 + ((kk & 7) * 32 + (c & 31)) * 2; }
__device__ __forceinline__ int v_rd_base(int lane) { return ((lane & 3) << 3) | (((lane >> 2) & 3) << 6) | (((lane >> 4) & 1) << 5) | (((lane >> 5) & 1) << 8); }
constexpr int v_rd_off(int d0, int ks, int half) { return d0 * 512 + ks * 4096 + half * 2048; }
template <int OFF> __device__ __forceinline__ s16x4 tr_read(int vb) {
  s16x4 r; asm volatile("ds_read_b64_tr_b16 %0, %1 offset:%2" : "=&v"(r) : "v"(vb), "i"(OFF) : "memory"); return r;
}
template <int D0> __device__ __forceinline__ void pv_one(f32x16& od, int vb, bf16x8 pa0, bf16x8 pa1, bf16x8 pa2, bf16x8 pa3) {
  const s16x4 l0 = tr_read<v_rd_off(D0, 0, 0)>(vb), h0 = tr_read<v_rd_off(D0, 0, 1)>(vb), l1 = tr_read<v_rd_off(D0, 1, 0)>(vb), h1 = tr_read<v_rd_off(D0, 1, 1)>(vb);
  const s16x4 l2 = tr_read<v_rd_off(D0, 2, 0)>(vb), h2 = tr_read<v_rd_off(D0, 2, 1)>(vb), l3 = tr_read<v_rd_off(D0, 3, 0)>(vb), h3 = tr_read<v_rd_off(D0, 3, 1)>(vb);
  asm volatile("s_waitcnt lgkmcnt(0)" ::: "memory"); SBAR();
#define PK(L, H) (bf16x8){L[0], L[1], L[2], L[3], H[0], H[1], H[2], H[3]}
  od = __builtin_amdgcn_mfma_f32_32x32x16_bf16(pa0, PK(l0, h0), od, 0, 0, 0);
  od = __builtin_amdgcn_mfma_f32_32x32x16_bf16(pa1, PK(l1, h1), od, 0, 0, 0);
  od = __builtin_amdgcn_mfma_f32_32x32x16_bf16(pa2, PK(l2, h2), od, 0, 0, 0);
  od = __builtin_amdgcn_mfma_f32_32x32x16_bf16(pa3, PK(l3, h3), od, 0, 0, 0);
#undef PK
}
__device__ __forceinline__ void pv_d0(f32x16* o, int vb, bf16x8 pa0, bf16x8 pa1, bf16x8 pa2, bf16x8 pa3) {
  pv_one<0>(o[0], vb, pa0, pa1, pa2, pa3); pv_one<1>(o[1], vb, pa0, pa1, pa2, pa3); pv_one<2>(o[2], vb, pa0, pa1, pa2, pa3); pv_one<3>(o[3], vb, pa0, pa1, pa2, pa3);
}

template <bool ALIBI>
__device__ __forceinline__ void attn_core(const bf16* __restrict__ Qb, int ldq, const bf16* __restrict__ Kh, const bf16* __restrict__ Vh, int ldk, int jlo, int jhi, char* lds,
                                          float slope2, int qpos0, f32x16 (&o)[4]) {
  int tid_ = threadIdx.x; asm volatile("" : "+v"(tid_));
  const int tid = tid_, wid = tid >> 6, lane = tid & 63, r32 = lane & 31, hi = lane >> 5;
  bf16* V_lds = (bf16*)lds; bf16* K_lds = (bf16*)(lds + 2 * SHM_V);
  float* ws = (float*)(lds + 2 * SHM_V + 2 * SHM_K) + wid * 64; float* li_l = ws; float* al_l = ws + 32;
  float m_reg = -1e30f, l_reg = 0; bf16x8 qr[8];
#pragma unroll
  for (int d = 0; d < 4; ++d) o[d] = f32x16{};
  const bf16* Qw = Qb + (long)(wid * QBLK + r32) * ldq + hi * 8;
#pragma unroll
  for (int d0 = 0; d0 < 8; ++d0) qr[d0] = *reinterpret_cast<const bf16x8*>(Qw + d0 * 16);
  const float dq0 = (float)(qpos0 + wid * QBLK + r32 - 4 * hi);
  const int qmin_w = __builtin_amdgcn_readfirstlane(qpos0 + wid * QBLK);
#define AMODE(j) ((((j) * KVBLK + 63) <= qmin_w) ? 1 : ((((j) * KVBLK) >= qmin_w + 31) ? -1 : 0))
  const int sr = tid >> 4, sc = (tid & 15) * 8, vst0 = v_st(sr, sc), vst1 = v_st(32 + sr, sc);
  const int vb0 = (int)(uintptr_t)V_lds + v_rd_base(lane);
  struct { bf16x8 vs0, vs1, ks0, ks1; } sr_[1];
  const unsigned voff = (unsigned)(sr * ldk + sc) * 2u;
#define SLOAD(i, k0) do { const char* vt_ = (const char*)Vh + (size_t)(k0) * ldk * 2; const char* kt_ = (const char*)Kh + (size_t)(k0) * ldk * 2; const size_t h32_ = (size_t)32 * ldk * 2; \
    sr_[i].vs0 = *reinterpret_cast<const bf16x8*>(vt_ + voff); sr_[i].vs1 = *reinterpret_cast<const bf16x8*>(vt_ + h32_ + voff); \
    sr_[i].ks0 = *reinterpret_cast<const bf16x8*>(kt_ + voff); sr_[i].ks1 = *reinterpret_cast<const bf16x8*>(kt_ + h32_ + voff); } while (0)
#define SWRITE(b, i) do { *(bf16x8*)((char*)V_lds + (b) * SHM_V + vst0) = sr_[i].vs0;          \
    *(bf16x8*)((char*)V_lds + (b) * SHM_V + vst1) = sr_[i].vs1; int kc = sc * 2;               \
    *(bf16x8*)((char*)K_lds + (b) * SHM_K + KSWZ(sr, kc)) = sr_[i].ks0;                       \
    *(bf16x8*)((char*)K_lds + (b) * SHM_K + KSWZ(32 + sr, kc)) = sr_[i].ks1; } while (0)
#define SWAIT() asm volatile("s_waitcnt vmcnt(0)" ::: "memory")
#define RESC(a) do { if (__any((a) < 1.f)) { if (hi == 0) al_l[r32] = (a); asm volatile("s_waitcnt lgkmcnt(0)" ::: "memory"); \
    _Pragma("unroll") for (int d = 0; d < 4; ++d) _Pragma("unroll") for (int r = 0; r < 16; ++r) o[d][r] *= al_l[crow(r, hi)]; } } while (0)
#ifdef ATT_SIMPLE
  f32x16 p0, p1; float mn, al; bf16x8 pa0, pa1, pa2, pa3;
  SLOAD(0, jlo * KVBLK); asm volatile("s_waitcnt vmcnt(0)" ::: "memory"); SWRITE(0, 0); __syncthreads();
#pragma unroll 1
  for (int j = jlo; j < jhi; ++j) {
    const int bsel = (j - jlo) & 1;
    if (j + 1 < jhi) SLOAD(0, (j + 1) * KVBLK);
    SBAR(); qkt(p0, p1, (bf16*)((char*)K_lds + bsel * SHM_K), qr, r32, hi);
    partialSM<ALIBI>(p0, p1, m_reg, mn, al, dq0 - (float)(j * KVBLK), slope2, AMODE(j));
    finishSM(p0, p1, al, l_reg, pa0, pa1, pa2, pa3);
    RESC(al); SBAR();
    pv_d0(o, vb0 + bsel * (int)SHM_V, pa0, pa1, pa2, pa3);
    if (j + 1 < jhi) { SWAIT(); SWRITE(bsel ^ 1, 0); }
    __syncthreads();
  }
#else
  f32x16 pA0, pA1, pB0, pB1; float mnA, mnB, alA, alB; bf16x8 pa0, pa1, pa2, pa3;
  SLOAD(0, jlo * KVBLK); asm volatile("s_waitcnt vmcnt(0)" ::: "memory"); SWRITE(0, 0); __syncthreads();
  qkt(pA0, pA1, K_lds, qr, r32, hi); partialSM<ALIBI>(pA0, pA1, m_reg, mnA, alA, dq0 - (float)(jlo * KVBLK), slope2, AMODE(jlo));
  SLOAD(0, (jlo + 1) * KVBLK);
  SWAIT(); SWRITE(1, 0); __syncthreads();
#pragma unroll 1
  for (int j = jlo + 1; j + 1 < jhi; j += 2) {
    SBAR(); qkt(pB0, pB1, (bf16*)((char*)K_lds + SHM_K), qr, r32, hi);
    finishSM(pA0, pA1, alA, l_reg, pa0, pa1, pa2, pa3); SBAR();
    SLOAD(0, (j + 1) * KVBLK); SBAR();
    pv_d0(o, vb0, pa0, pa1, pa2, pa3); partialSM<ALIBI>(pB0, pB1, m_reg, mnB, alB, dq0 - (float)(j * KVBLK), slope2, AMODE(j));
    __syncthreads(); SWAIT(); SWRITE(0, 0);
    RESC(alB); __syncthreads();
    SBAR(); qkt(pA0, pA1, K_lds, qr, r32, hi);
    finishSM(pB0, pB1, alB, l_reg, pa0, pa1, pa2, pa3); SBAR();
    SLOAD(0, (j + 2) * KVBLK); SBAR();
    pv_d0(o, vb0 + (int)SHM_V, pa0, pa1, pa2, pa3); partialSM<ALIBI>(pA0, pA1, m_reg, mnA, alA, dq0 - (float)((j + 1) * KVBLK), slope2, AMODE(j + 1));
    __syncthreads(); SWAIT(); SWRITE(1, 0);
    RESC(alA); __syncthreads();
  }
  SBAR(); qkt(pB0, pB1, (bf16*)((char*)K_lds + SHM_K), qr, r32, hi);
  finishSM(pA0, pA1, alA, l_reg, pa0, pa1, pa2, pa3); SBAR();
  pv_d0(o, vb0, pa0, pa1, pa2, pa3); partialSM<ALIBI>(pB0, pB1, m_reg, mnB, alB, dq0 - (float)((jhi - 1) * KVBLK), slope2, AMODE(jhi - 1));
  __syncthreads(); RESC(alB);
  finishSM(pB0, pB1, alB, l_reg, pa0, pa1, pa2, pa3); SBAR();
  pv_d0(o, vb0 + (int)SHM_V, pa0, pa1, pa2, pa3);
  __syncthreads();
#endif
  if (hi == 0) li_l[r32] = l_reg; asm volatile("s_waitcnt lgkmcnt(0)" ::: "memory");
#pragma unroll
  for (int r = 0; r < 16; ++r) { const float rl = __builtin_amdgcn_rcpf(li_l[crow(r, hi)]);
#pragma unroll
    for (int d = 0; d < 4; ++d) o[d][r] *= rl; }
#undef AMODE
#undef SLOAD
#undef SWRITE
#undef SWAIT
#undef RESC
}
}

namespace gdn {
constexpr int SA = 272, SB = 144;
constexpr int OFF_X0 = 0, OFF_X1 = 17408, OFF_KBG = 34816, OFF_VBT = 53248, OFF_QD = 71680, OFF_QKM = 89088, OFF_KDT = 98304, OFF_ST = 116736, OFF_SM = 151552, OFF_Y = 154112, GDN_LDS = OFF_Y + 4096;
constexpr int SMB = 1280;
using att::crow;
template <int KS> __device__ __forceinline__ void tile_mma(f32x16& acc, const LAS char* A, int sa, int ra, const LAS char* B, int sb, int rb, int r32, int hi) {
    const LAS char* ap = A + (ra + r32) * sa + hi * 16; const LAS char* bp = B + (rb + r32) * sb + hi * 16;
#pragma unroll
    for (int ks = 0; ks < KS; ++ks) { const bf16x8 a = *(const LAS bf16x8*)(ap + ks * 32), b = *(const LAS bf16x8*)(bp + ks * 32); acc = __builtin_amdgcn_mfma_f32_32x32x16_bf16(a, b, acc, 0, 0, 0); }
}
typedef float f32x2_ __attribute__((ext_vector_type(2)));
__device__ __forceinline__ void st_bf16(LAS char* p, float v) { *(LAS unsigned short*)p = (unsigned short)f2bf(v); }
__device__ __forceinline__ float bfsel(const u32x4& w, int e) { const unsigned x = (e < 2) ? w.x : (e < 4) ? w.y : (e < 6) ? w.z : w.w; return (e & 1) ? bfhi(x) : bflo(x); }

__device__ __forceinline__ void chunk_scalars(float bl, float a, float Aexp, float dtb, LAS float* sm, int lane) {
    const float xx = a + dtb; const float sp = xx > 20.f ? xx : log1pf(__expf(xx));
    float v = -Aexp * sp;
#pragma unroll
    for (int o = 1; o < 64; o <<= 1) { const float n = __shfl_up(v, o); if (lane >= o) v += n; }
    const float gl = __shfl(v, 63);
    sm[lane] = v; sm[64 + lane] = sigmoidf_(bl); sm[128 + lane] = __expf(v); sm[192 + lane] = __expf(gl - v); if (lane == 0) sm[256] = __expf(gl);
}
#define GDN_LOADAB(cc, ln, BL, AA) do { const int t_ = (cc) * 64 + (dir ? 63 - (ln) : (ln)); const float* abr_ = AB + (size_t)(sb + t_) * 64; BL = abr_[dir * 16 + h]; AA = abr_[32 + dir * 16 + h]; } while (0)

template <int DIRT> __device__ __forceinline__ void gdn_unit(const float* A_log, const float* dt_bias, int S, int sb, int h, const bf16* proj, const float* AB, bf16* outp, LAS char* L) {
    constexpr int dir = DIRT;
    int tid_ = threadIdx.x; asm volatile("" : "+v"(tid_));
    const float Aexp = __expf(A_log[dir * 16 + h]), dtb = dt_bias[dir * 16 + h];
    const int N = S / 64;
    const int cgp = tid_ % 48, run = tid_ / 48, part = cgp >> 4, c0 = (cgp & 15) * 8, ccol = part * 2048 + h * 128 + c0;
    const bool convt = tid_ < 384;
    u32x4 raw[8];
#define GDN_LOADRAW(cc, tsrc) do { if (convt) { const unsigned voff_ = ((unsigned)((tsrc) / 48) * 8u * (unsigned)NPROJ + (unsigned)(((tsrc) % 48) >> 4) * 2048u + (unsigned)(((tsrc) % 48) & 15) * 8u) * 2u; \
        _Pragma("unroll") for (int k_ = 0; k_ < 8; ++k_) { const char* rb_ = (const char*)proj + ((size_t)(sb + (cc) * 64 + k_) * NPROJ + C_GDN + h * 128) * 2; \
            raw[k_] = *(const u32x4*)(rb_ + voff_); } } } while (0)
    GDN_LOADRAW(dir ? N - 1 : 0, tid_);
    f32x16 st[2]; st[0] = f32x16{}; st[1] = f32x16{};
    for (int i = tid_; i < 34816 / 4; i += NTHR) ((LAS unsigned*)(L + OFF_ST))[i] = 0u;
    float ab_bl = 0.f, ab_a = 0.f;
    if ((tid_ >> 6) == 7) { GDN_LOADAB(dir ? N - 1 : 0, tid_ & 63, ab_bl, ab_a); chunk_scalars(ab_bl, ab_a, Aexp, dtb, (LAS float*)(L + OFF_SM), tid_ & 63); }
    __syncthreads();
#pragma unroll 1
    for (int ci = 0; ci < N; ++ci) {
        const int c = dir ? N - 1 - ci : ci;
        int tq = tid_; asm volatile("" : "+v"(tq));
        const int tid = tq, wid = __builtin_amdgcn_readfirstlane(tid >> 6), lane = tid & 63, r32 = lane & 31, hi = lane >> 5;
        LAS float* gcs = (LAS float*)(L + OFF_SM + (ci & 1) * SMB); LAS float* bet = gcs + 64; LAS float* eg = gcs + 128; LAS float* ekd = gcs + 192;
        if (wid == 7 && ci + 1 < N) GDN_LOADAB(dir ? c - 1 : c + 1, lane, ab_bl, ab_a);
        if (convt) {
            asm volatile("s_waitcnt vmcnt(0)" ::: "memory");
            float y[8][8];
#pragma unroll
            for (int rr = 0; rr < 8; ++rr) unpack8(raw[rr], y[rr]);
            u32x4 rawc[8];
#pragma unroll
            for (int rr = 0; rr < 8; ++rr) rawc[rr] = raw[rr];
            if (ci + 1 < N) GDN_LOADRAW(dir ? c - 1 : c + 1, tid);
            const int i0 = dir ? 56 - run * 8 : run * 8;
            float bi[8], egi[8], eki[8];
            { const f32x4 a0 = *(const LAS f32x4*)(bet + i0), a1 = *(const LAS f32x4*)(bet + i0 + 4), b0 = *(const LAS f32x4*)(eg + i0), b1 = *(const LAS f32x4*)(eg + i0 + 4), c0v = *(const LAS f32x4*)(ekd + i0), c1v = *(const LAS f32x4*)(ekd + i0 + 4);
#pragma unroll
              for (int p = 0; p < 4; ++p) { bi[p] = a0[p]; bi[4 + p] = a1[p]; egi[p] = b0[p]; egi[4 + p] = b1[p]; eki[p] = c0v[p]; eki[4 + p] = c1v[p]; } }
#define GDN_PK8(v) (u32x4){pg8::cvt_pk_bf16((v)[0], (v)[1]), pg8::cvt_pk_bf16((v)[2], (v)[3]), pg8::cvt_pk_bf16((v)[4], (v)[5]), pg8::cvt_pk_bf16((v)[6], (v)[7])}
            if (part == 0) {
#pragma unroll
                for (int rr = 0; rr < 8; ++rr) { const int p = dir ? 7 - rr : rr, i = i0 + p; float qd[8];
#pragma unroll
                    for (int e = 0; e < 8; ++e) qd[e] = y[rr][e] * egi[p];
                    *(LAS u32x4*)(L + OFF_X0 + i * SA + c0 * 2) = rawc[rr]; *(LAS u32x4*)(L + OFF_QD + i * SA + c0 * 2) = GDN_PK8(qd); }
            } else if (part == 1) {
#pragma unroll
                for (int rr = 0; rr < 8; ++rr) { const int p = dir ? 7 - rr : rr, i = i0 + p; *(LAS u32x4*)(L + OFF_X1 + i * SA + c0 * 2) = rawc[rr]; }
#pragma unroll
                for (int e = 0; e < 8; ++e) { float kb[8], kd[8];
#pragma unroll
                    for (int p = 0; p < 8; ++p) { const int rr = dir ? 7 - p : p; kb[p] = y[rr][e] * (bi[p] * egi[p]); kd[p] = y[rr][e] * eki[p]; }
                    *(LAS u32x4*)(L + OFF_KBG + (c0 + e) * SB + i0 * 2) = GDN_PK8(kb); *(LAS u32x4*)(L + OFF_KDT + (c0 + e) * SB + i0 * 2) = GDN_PK8(kd); }
            } else {
#pragma unroll
                for (int e = 0; e < 8; ++e) { float vb[8];
#pragma unroll
                    for (int p = 0; p < 8; ++p) { const int rr = dir ? 7 - p : p; vb[p] = y[rr][e] * bi[p]; }
                    *(LAS u32x4*)(L + OFF_VBT + (c0 + e) * SB + i0 * 2) = GDN_PK8(vb); }
            }
        }
        __syncthreads();
        {
            f32x16 acc = f32x16{};
            const int w4 = wid & 3, ma = w4 >> 1, nb = w4 & 1;
            if (wid < 4) { if (!(ma == 0 && nb == 1)) tile_mma<8>(acc, L + OFF_X1, SA, 32 * ma, L + OFF_X1, SA, 32 * nb, r32, hi); }
            else         { if (!(ma == 1 && nb == 0)) tile_mma<8>(acc, L + OFF_X1, SA, 32 * ma, L + OFF_X0, SA, 32 * nb, r32, hi); }
            __syncthreads();
            if (wid < 4) {
                if (!(ma == 0 && nb == 1)) {
                    const int j = 32 * nb + r32; const float gj = gcs[j];
#pragma unroll
                    for (int r = 0; r < 16; ++r) { const int i = 32 * ma + crow(r, hi); const float v = (i > j) ? bet[i] * acc[r] * __expf(gcs[i] - gj) : 0.f; *(LAS float*)(L + OFF_X1 + (i * 68 + j) * 4) = v; }
                }
            } else {
                const int i = 32 * nb + r32; const float gi = gcs[i];
#pragma unroll
                for (int r4 = 0; r4 < 4; ++r4) { float v[4];
#pragma unroll
                    for (int e = 0; e < 4; ++e) { const int j = 32 * ma + 8 * r4 + 4 * hi + e; v[e] = (i >= j) ? acc[4 * r4 + e] * __expf(gi - gcs[j]) : 0.f; }
                    u32x2 w; w.x = pk2(v[0], v[1]); w.y = pk2(v[2], v[3]); *(LAS u32x2*)(L + OFF_QKM + i * SB + (32 * ma + 8 * r4 + 4 * hi) * 2) = w; }
            }
        }
        __syncthreads();
        {
            const LAS float* Lf = (const LAS float*)(L + OFF_X1); LAS float* Tf = (LAS float*)(L + OFF_X0); LAS float* Yf = (LAS float*)(L + OFF_Y);
            if (tid < 64) { const int b = tid >> 4, cc = tid & 15; const LAS float* Lb = Lf + (16 * b) * 68 + 16 * b; float x[16];
#pragma unroll
                for (int i = 0; i < 16; ++i) { float s = (i == cc) ? 1.f : 0.f;
#pragma unroll
                    for (int j = 0; j < i; ++j) s = fmaf(-Lb[i * 68 + j], x[j], s);
                    x[i] = s; }
#pragma unroll
                for (int i = 0; i < 16; ++i) Tf[(16 * b + i) * 68 + 16 * b + cc] = x[i]; }
            if (wid == 7 && ci + 1 < N) chunk_scalars(ab_bl, ab_a, Aexp, dtb, (LAS float*)(L + OFF_SM + ((ci + 1) & 1) * SMB), lane);
            __syncthreads();
            { const int pr = tid >> 8, i = (tid >> 4) & 15, j = tid & 15, a = 2 * pr, b = 2 * pr + 1; float y = 0.f;
#pragma unroll
              for (int k = 0; k < 16; ++k) y = fmaf(Lf[(16 * b + i) * 68 + 16 * a + k], Tf[(16 * a + k) * 68 + 16 * a + j], y);
              Yf[tid] = y; __syncthreads();
              float z = 0.f;
#pragma unroll
              for (int k = 0; k < 16; ++k) z = fmaf(-Tf[(16 * b + i) * 68 + 16 * b + k], Yf[(pr * 16 + k) * 16 + j], z);
              Tf[(16 * b + i) * 68 + 16 * a + j] = z; Tf[(16 * a + i) * 68 + 16 * b + j] = 0.f; }
            __syncthreads();
            { const int i = tid >> 4, j0 = (tid & 15) * 2; float y0 = 0.f, y1 = 0.f;
#pragma unroll
              for (int k4 = 0; k4 < 8; ++k4) { const f32x4 l = *(const LAS f32x4*)(Lf + (32 + i) * 68 + 4 * k4);
#pragma unroll
                  for (int e = 0; e < 4; ++e) { const f32x2_ t = *(const LAS f32x2_*)(Tf + (4 * k4 + e) * 68 + j0); y0 = fmaf(l[e], t.x, y0); y1 = fmaf(l[e], t.y, y1); } }
              *(LAS f32x2_*)(Yf + i * 32 + j0) = (f32x2_){y0, y1}; __syncthreads();
              float z0 = 0.f, z1 = 0.f;
#pragma unroll
              for (int k4 = 0; k4 < 8; ++k4) { const f32x4 tb = *(const LAS f32x4*)(Tf + (32 + i) * 68 + 32 + 4 * k4);
#pragma unroll
                  for (int e = 0; e < 4; ++e) { const f32x2_ yv = *(const LAS f32x2_*)(Yf + (4 * k4 + e) * 32 + j0); z0 = fmaf(-tb[e], yv.x, z0); z1 = fmaf(-tb[e], yv.y, z1); } }
              *(LAS f32x2_*)(Tf + (32 + i) * 68 + j0) = (f32x2_){z0, z1}; }
            __syncthreads();
            { const int i = tid >> 3, j0 = (tid & 7) * 8; float v[8];
#pragma unroll
              for (int e = 0; e < 8; ++e) { const int j = j0 + e; v[e] = (j <= i) ? Tf[i * 68 + j] : 0.f; }
              *(LAS u32x4*)(L + OFF_X1 + i * SB + j0 * 2) = pack8(v); }
        }
        __syncthreads();
        const int mi = wid >> 2, ni = wid & 3;
        f32x16 accU = f32x16{};
        tile_mma<4>(accU, L + OFF_X1, SB, 32 * mi, L + OFF_VBT, SB, 32 * ni, r32, hi);
        { f32x16 accW = f32x16{};
          tile_mma<4>(accW, L + OFF_KBG, SB, 32 * ni, L + OFF_X1, SB, 32 * mi, r32, hi);
          const int tok = 32 * mi + r32;
#pragma unroll
          for (int r4 = 0; r4 < 4; ++r4) { u32x2 w; w.x = pk2(accW[4 * r4], accW[4 * r4 + 1]); w.y = pk2(accW[4 * r4 + 2], accW[4 * r4 + 3]);
              *(LAS u32x2*)(L + OFF_X0 + tok * SA + (32 * ni + 8 * r4 + 4 * hi) * 2) = w; } }
        __syncthreads();
        {
            f32x16 accV = f32x16{}, accO = f32x16{};
            {
                const LAS char* wp = L + OFF_X0 + (32 * mi + r32) * SA + hi * 16; const LAS char* qp = L + OFF_QD + (32 * mi + r32) * SA + hi * 16; const LAS char* sp = L + OFF_ST + (32 * ni + r32) * SA + hi * 16;
#pragma unroll
                for (int ks = 0; ks < 8; ++ks) { const bf16x8 b = *(const LAS bf16x8*)(sp + ks * 32), aw = *(const LAS bf16x8*)(wp + ks * 32), aq = *(const LAS bf16x8*)(qp + ks * 32);
                    accV = __builtin_amdgcn_mfma_f32_32x32x16_bf16(aw, b, accV, 0, 0, 0); accO = __builtin_amdgcn_mfma_f32_32x32x16_bf16(aq, b, accO, 0, 0, 0); }
            }
            const int dv = 32 * ni + r32;
#pragma unroll
            for (int r4 = 0; r4 < 4; ++r4) { u32x2 w; w.x = pk2(accU[4 * r4] - accV[4 * r4], accU[4 * r4 + 1] - accV[4 * r4 + 1]); w.y = pk2(accU[4 * r4 + 2] - accV[4 * r4 + 2], accU[4 * r4 + 3] - accV[4 * r4 + 3]);
                *(LAS u32x2*)(L + OFF_VBT + dv * SB + (32 * mi + 8 * r4 + 4 * hi) * 2) = w; }
            __syncthreads();
            tile_mma<4>(accO, L + OFF_QKM, SB, 32 * mi, L + OFF_VBT, SB, 32 * ni, r32, hi);
#pragma unroll
            for (int r = 0; r < 16; ++r) { const int tok = 32 * mi + crow(r, hi); const int t = c * 64 + (dir ? 63 - tok : tok);
                outp[(size_t)(sb + t) * DM + h * 128 + dv] = (bf16)f2bf(accO[r]); }
            const float egl = gcs[256]; const int mi2 = wid & 3;
#pragma unroll
            for (int xx = 0; xx < 2; ++xx) { const int ni2 = (wid >> 2) * 2 + xx;
#pragma unroll
                for (int r = 0; r < 16; ++r) st[xx][r] *= egl;
                tile_mma<4>(st[xx], L + OFF_KDT, SB, 32 * mi2, L + OFF_VBT, SB, 32 * ni2, r32, hi);
                const int dv2 = 32 * ni2 + r32;
#pragma unroll
                for (int r4 = 0; r4 < 4; ++r4) { u32x2 w; w.x = pk2(st[xx][4 * r4], st[xx][4 * r4 + 1]); w.y = pk2(st[xx][4 * r4 + 2], st[xx][4 * r4 + 3]);
                    *(LAS u32x2*)(L + OFF_ST + dv2 * SA + (32 * mi2 + 8 * r4 + 4 * hi) * 2) = w; }
            }
        }
        __syncthreads();
    }
#undef GDN_LOADRAW
#undef GDN_LOADAB
}
}

__device__ __forceinline__ void diffattn_unit(const float* da_lambda, const float* gqn, const float* gkn, int S, int sb, int h, int qb, int vh, const bf16* proj, bf16* aout, float* ssqg, char* lds) {
    using namespace att;
    int tid_ = threadIdx.x; asm volatile("" : "+v"(tid_));
    const int tid = tid_, wid = tid >> 6, lane = tid & 63;
    const int t0 = sb + qb * 256;
    const float slope2 = exp2f(-(float)(h + 1)) * LOG2E;
    int jlo, jhi;
    { float gq = fmaxf(fabsf(gqn[lane]), fabsf(gqn[64 + lane])), gk = fmaxf(fabsf(gkn[lane]), fabsf(gkn[64 + lane]));
#pragma unroll
      for (int o_ = 1; o_ < 64; o_ <<= 1) { gq = fmaxf(gq, __shfl_xor(gq, o_)); gk = fmaxf(gk, __shfl_xor(gk, o_)); }
      const float smax2 = 11.313708499f * gq * gk * LOG2E * 1.02f;
      const float Wf = fminf((2.f * smax2 + 40.f) / slope2, 1.0e6f); const int W = __builtin_amdgcn_readfirstlane((int)Wf + 1), q0 = qb * 256;
      const int lo = q0 - W, hi_ = q0 + 255 + W, NT = S / 64;
      jlo = lo > 0 ? (lo >> 6) : 0; jhi = (hi_ >> 6) + 1; jhi = jhi < NT ? jhi : NT;
      if ((jhi - jlo) & 1) { if (jlo > 0) --jlo; else ++jhi; } }
    unsigned* stash = (unsigned*)(lds + OFF_STASH);
#pragma unroll 1
    for (int map = 0; map < 2; ++map) {
        f32x16 o[4];
        attn_core<true>(proj + (size_t)t0 * NPROJ + C_DAQ + (h * 2 + map) * 128, NPROJ, proj + (size_t)sb * NPROJ + C_DAK + (h * 2 + map) * 128,
                        proj + (size_t)sb * NPROJ + C_DAV + h * 256 + vh * 128, NPROJ, jlo, jhi, lds, slope2, qb * 256, o);
        if (map == 0) {
#pragma unroll
            for (int d = 0; d < 4; ++d)
#pragma unroll
                for (int r2 = 0; r2 < 8; ++r2) stash[(d * 8 + r2) * NTHR + tid] = pk2(o[d][2 * r2], o[d][2 * r2 + 1]);
        } else {
            float lam;
            { const float* lp = da_lambda; const float s1 = wave_sum(lp[lane] * lp[128 + lane] + lp[64 + lane] * lp[192 + lane]), s2 = wave_sum(lp[256 + lane] * lp[384 + lane] + lp[320 + lane] * lp[448 + lane]);
              lam = __expf(s1) - __expf(s2) + 0.2f; }
            float ss[16];
#pragma unroll
            for (int r = 0; r < 16; ++r) ss[r] = 0.f;
#pragma unroll
            for (int d = 0; d < 4; ++d)
#pragma unroll
                for (int r2 = 0; r2 < 8; ++r2) { const unsigned w = stash[(d * 8 + r2) * NTHR + tid];
                    const float a = bflo(w) - lam * o[d][2 * r2], b = bfhi(w) - lam * o[d][2 * r2 + 1]; o[d][2 * r2] = a; o[d][2 * r2 + 1] = b; ss[2 * r2] += a * a; ss[2 * r2 + 1] += b * b; }
#pragma unroll
            for (int r = 0; r < 16; ++r) { float s = ss[r]; s += __shfl_xor(s, 1); s += __shfl_xor(s, 2); s += __shfl_xor(s, 4); s += __shfl_xor(s, 8); s += __shfl_xor(s, 16); ss[r] = s; }
            int lz = lane; asm volatile("" : "+v"(lz));
            const int r32 = lz & 31, hi = lz >> 5;
            bf16* orow = aout + (size_t)(t0 + wid * 32) * DM + h * 256 + vh * 128 + r32;
            if (r32 == 0) {
#pragma unroll
                for (int r = 0; r < 16; ++r) ssqg[(size_t)(t0 + wid * 32 + crow(r, hi)) * 16 + h * 2 + vh] = ss[r]; }
#pragma unroll
            for (int r = 0; r < 16; ++r)
#pragma unroll
                for (int d = 0; d < 4; ++d) orow[(size_t)crow(r, hi) * DM + d * 32] = (bf16)f2bf(o[d][r]);
        }
        __syncthreads();
    }
}
__device__ __forceinline__ void xattn_unit(int sb, int bl, int xh, int qb, const bf16* proj, const bf16* memkv, bf16* cout, char* lds) {
    using namespace att;
    int tid_ = threadIdx.x; asm volatile("" : "+v"(tid_));
    const int tid = tid_, wid = tid >> 6, lane = tid & 63, r32 = lane & 31, hi = lane >> 5;
    const int t0 = sb + qb * 256;
    f32x16 o[4];
    attn_core<false>(proj + (size_t)t0 * NPROJ + C_XAQ + xh * 128, NPROJ, memkv + (size_t)bl * 256 * 1024 + xh * 128, memkv + (size_t)bl * 256 * 1024 + 512 + xh * 128, 1024, 0, 4, lds, 0.f, 0, o);
    bf16* orow = cout + (size_t)(t0 + wid * 32) * 512 + xh * 128 + r32;
#pragma unroll
    for (int r = 0; r < 16; ++r)
#pragma unroll
        for (int d = 0; d < 4; ++d) orow[(size_t)crow(r, hi) * 512 + d * 32] = (bf16)f2bf(o[d][r]);
}

__device__ __forceinline__ void seg_norm_fin(bf16* p, u32x4 raw, const float* gain, float scale, int l16) {
    float v[8]; unpack8(raw, v);
    float ss = 0.f;
#pragma unroll
    for (int e = 0; e < 8; ++e) ss += v[e] * v[e];
    ss += __shfl_xor(ss, 1); ss += __shfl_xor(ss, 2); ss += __shfl_xor(ss, 4); ss += __shfl_xor(ss, 8);
    const float inv = (rsq_(ss * (1.f / 128.f) + EPS)) * scale;
    const f32x4 g0 = *(const f32x4*)(gain + l16 * 8), g1 = *(const f32x4*)(gain + l16 * 8 + 4);
#pragma unroll
    for (int e = 0; e < 4; ++e) { v[e] *= inv * g0[e]; v[4 + e] *= inv * g1[e]; }
    *(u32x4*)(p + l16 * 8) = pack8(v);
}
__device__ __forceinline__ void seg_norm(bf16* p, const float* gain, float scale, int l16) { seg_norm_fin(p, *(const u32x4*)(p + l16 * 8), gain, scale, l16); }

__device__ __forceinline__ void gdn_conv_item(bf16* proj, const bf16* halo, const float* conv_w, int S, int c, int cg, int l16dummy) {
    (void)l16dummy;
    const int part = cg >> 8, col = cg * 8;
    const int s0 = (c * 64) & (S - 1);
    f32x4 wc[5][2];
#pragma unroll
    for (int j = 0; j < 5; ++j) { wc[j][0] = *(const f32x4*)(conv_w + j * 6144 + col); wc[j][1] = *(const f32x4*)(conv_w + j * 6144 + col + 4); }
    bf16* base = proj + (size_t)c * 64 * NPROJ + C_GDN + col;
    const u32x4 zero4 = (u32x4){0u, 0u, 0u, 0u};
    u32x4 raw[12];
    raw[0] = (s0 == 0) ? zero4 : *(const u32x4*)(halo + ((size_t)(c - 1) * 4 + 2) * 6144 + col);
    raw[1] = (s0 == 0) ? zero4 : *(const u32x4*)(halo + ((size_t)(c - 1) * 4 + 3) * 6144 + col);
    raw[2] = *(const u32x4*)(base); raw[3] = *(const u32x4*)(base + NPROJ);
#pragma unroll 1
    for (int b = 0; b < 8; ++b) {
#pragma unroll
        for (int k = 0; k < 8; ++k) { const int r = 8 * b + 2 + k;
            raw[4 + k] = (r < 64) ? *(const u32x4*)(base + (size_t)r * NPROJ) : ((s0 + 64 == S) ? zero4 : *(const u32x4*)(halo + ((size_t)(c + 1) * 4 + (r - 64)) * 6144 + col)); }
        float y[8][8];
#pragma unroll
        for (int e = 0; e < 8; ++e) { float xr[12];
#pragma unroll
            for (int k = 0; k < 12; ++k) xr[k] = gdn::bfsel(raw[k], e);
#pragma unroll
            for (int rr = 0; rr < 8; ++rr) { float s = 0.f;
#pragma unroll
                for (int j = 0; j < 5; ++j) s = fmaf(wc[j][e >> 2][e & 3], xr[rr + j], s);
                y[rr][e] = s * sigmoidf_(s); } }
#pragma unroll
        for (int rr = 0; rr < 8; ++rr) { float sc = 1.f;
            if (part < 2) { float ss = 0.f;
#pragma unroll
                for (int e = 0; e < 8; ++e) ss += y[rr][e] * y[rr][e];
                ss += __shfl_xor(ss, 1); ss += __shfl_xor(ss, 2); ss += __shfl_xor(ss, 4); ss += __shfl_xor(ss, 8);
                sc = (rsq_(ss + EPS)) * (part == 0 ? 0.08838834764831845f : 1.f); }
            u32x4 w; w.x = pg8::cvt_pk_bf16(y[rr][0] * sc, y[rr][1] * sc); w.y = pg8::cvt_pk_bf16(y[rr][2] * sc, y[rr][3] * sc); w.z = pg8::cvt_pk_bf16(y[rr][4] * sc, y[rr][5] * sc); w.w = pg8::cvt_pk_bf16(y[rr][6] * sc, y[rr][7] * sc);
            *(u32x4*)(base + (size_t)(8 * b + rr) * NPROJ) = w; }
        raw[0] = raw[8]; raw[1] = raw[9]; raw[2] = raw[10]; raw[3] = raw[11];
    }
}


#define XB_TMO      128
#define XB_XCNT(j)  (256  + 64 * (j))
#define XB_XSUB(j)  (1280 + 64 * (j))
#define XB_XGEN(j)  (2304 + 64 * (j))
#define XB_TOP      3328
#define XB_TOPGEN   3392
#define XCD_BAR_WORDS 3456
#define XB_SPIN_CAP (1u << 18)

__device__ __forceinline__ unsigned xb_ld(unsigned* p)              { return __hip_atomic_load(p, __ATOMIC_RELAXED, __HIP_MEMORY_SCOPE_AGENT); }
__device__ __forceinline__ unsigned xb_add(unsigned* p, unsigned v) { return __hip_atomic_fetch_add(p, v, __ATOMIC_RELAXED, __HIP_MEMORY_SCOPE_AGENT); }
__device__ __forceinline__ unsigned xb_xcc_id() { return (unsigned)__builtin_amdgcn_s_getreg((3 << 11) | 20) & 0xFu; }
#define XB_SPIN(cond, bar) do { unsigned _sp = 0; while (cond) { __builtin_amdgcn_s_sleep(1); \
    if ((++_sp & 255u) == 0u) { if (xb_ld(&(bar)[XB_TMO])) break; if (_sp > XB_SPIN_CAP) { atomicAdd(&(bar)[XB_TMO], 1u); break; } } } } while (0)

struct XcdBarrier {
    unsigned* bar; unsigned x;
    volatile LAS unsigned* st;
};

__device__ __forceinline__ XcdBarrier xcd_barrier_post(unsigned* bar, volatile LAS unsigned* st) {
    XcdBarrier b; b.bar = bar; b.x = xb_xcc_id(); b.st = st;
    if (threadIdx.x == 0) (void)xb_add(&bar[XB_XCNT(b.x)], 1u);
    return b;
}
__device__ __forceinline__ void xcd_barrier_complete(unsigned* bar, unsigned x, unsigned& nloc, unsigned& nx) {
    const unsigned G = gridDim.x * gridDim.y * gridDim.z;
    unsigned sum, cnt, mine, sp = 0u;
    for (;;) {
        sum = 0u; cnt = 0u; mine = 0u;
#pragma unroll
        for (unsigned j = 0; j < 16; ++j) { const unsigned c = xb_ld(&bar[XB_XCNT(j)]); sum += c; cnt += (c > 0u) ? 1u : 0u; mine = (j == x) ? c : mine; }
        if (sum == G) break;
        __builtin_amdgcn_s_sleep(1);
        if ((++sp & 255u) == 0u) { if (xb_ld(&bar[XB_TMO])) break; if (sp > XB_SPIN_CAP) { atomicAdd(&bar[XB_TMO], 1u); break; } }
    }
    nloc = mine > 0u ? mine : 1u; nx = cnt > 0u ? cnt : 1u;
}

__device__ __forceinline__ void xcd_barrier(const XcdBarrier& b) {
    asm volatile("s_waitcnt vmcnt(0)" ::: "memory");
    __syncthreads();
    if (threadIdx.x == 0) {
        unsigned* bar = b.bar;
        __builtin_amdgcn_s_waitcnt(0);
        unsigned nloc = b.st[0], nx = b.st[1];
        if (nloc == 0u) { xcd_barrier_complete(bar, b.x, nloc, nx); b.st[0] = nloc; b.st[1] = nx; }
        const unsigned old = xb_add(&bar[XB_XSUB(b.x)], 1u);
        const unsigned gen = old / nloc;
        if (old + 1u == (gen + 1u) * nloc) {
            __builtin_amdgcn_fence(__ATOMIC_RELEASE, "agent");
            asm volatile("s_waitcnt vmcnt(0)" ::: "memory");
            const unsigned og = xb_add(&bar[XB_TOP], 1u);
            const unsigned tg = og / nx;
            if (og + 1u == (tg + 1u) * nx) xb_add(&bar[XB_TOPGEN], 1u);
            else XB_SPIN(xb_ld(&bar[XB_TOPGEN]) == tg, bar);
            __builtin_amdgcn_fence(__ATOMIC_ACQUIRE, "agent");
            xb_add(&bar[XB_XGEN(b.x)], 1u);
            asm volatile("s_waitcnt vmcnt(0)" ::: "memory");
        } else {
            XB_SPIN(xb_ld(&bar[XB_XGEN(b.x)]) == gen, bar);
            __builtin_amdgcn_fence(__ATOMIC_ACQUIRE, "agent");
            asm volatile("s_waitcnt vmcnt(0)" ::: "memory");
        }
    }
    __syncthreads();
}


__device__ __forceinline__ void p0_phase(LAS unsigned char* lds, int gg, int NGW) {
    int tq = threadIdx.x; asm volatile("" : "+v"(tq));
    const int lane = tq & 63, wave = __builtin_amdgcn_readfirstlane(tq >> 6), gw = blockIdx.x * NWV + wave;
    LAS float* scr = (LAS float*)(lds + LDS_PH + wave * 16896);
    unsigned char* wsb = (unsigned char*)tptr(lds, T_WS);
    bf16* WA = (bf16*)(wsb + WS_W + W_WINA); const float* win = tptr(lds, T_WIN);
    transpose_job(win, 21056, 0, 12288, DM, WA, 0, scr, gw, NGW, lane);
    transpose_job(win, 21056, 14400, 512, DM, WA, 12288, scr, gw, NGW, lane);
    transpose_job(win, 21056, 14336, 64, DM, WA, 12800, scr, gw, NGW, lane);
    transpose_job(tptr(lds, T_WMKV), 1024, 0, 1024, DM, (bf16*)(wsb + WS_W + W_WMKV), 0, scr, gw, NGW, lane);
    { const float* x = tptr(lds, T_X0 + gg); const float* gm = tptr(lds, T_GMIX); bf16* h = (bf16*)(wsb + WS_H);
      for (int m = gw; m < TG; m += NGW) rms_row(x + (size_t)m * DM, gm, h + (size_t)m * DM, lane); }
    { const int nmem = (gg ? 2 : 4) * 256; const float* mx = tptr(lds, T_MEM0 + gg); const float* gm = tptr(lds, T_GMEM); bf16* mn = (bf16*)(wsb + WS_MEMN);
      for (int m = gw; m < nmem; m += NGW) rms_row(mx + (size_t)m * DM, gm, mn + (size_t)m * DM, lane); }
}
__global__ void __launch_bounds__(NTHR, 2) hybrid_fwd(Params P) {
    extern __shared__ __attribute__((aligned(16))) unsigned char lds_raw[];
    cg::grid_group grid = cg::this_grid();
    LAS unsigned char* lds = (LAS unsigned char*)lds_raw;
    const int NGW = gridDim.x * NWV;
    if (threadIdx.x == 0) {
        LAS unsigned long long* t = (LAS unsigned long long*)(lds + LDS_TBL);
        t[T_X0] = (unsigned long long)P.x[0];
        t[T_X1] = (unsigned long long)P.x[1];
        t[T_MEM0] = (unsigned long long)P.mem[0];
        t[T_MEM1] = (unsigned long long)P.mem[1];
        t[T_OUT0] = (unsigned long long)P.out[0];
        t[T_OUT1] = (unsigned long long)P.out[1];
        t[T_GMIX] = (unsigned long long)P.g_mix;
        t[T_GMEM] = (unsigned long long)P.g_mem;
        t[T_WIN] = (unsigned long long)P.w_in;
        t[T_BGATE] = (unsigned long long)P.b_gate;
        t[T_DAQN] = (unsigned long long)P.da_q_norm;
        t[T_DAKN] = (unsigned long long)P.da_k_norm;
        t[T_DALAM] = (unsigned long long)P.da_lambda;
        t[T_DASUB] = (unsigned long long)P.da_subln;
        t[T_GCONV] = (unsigned long long)P.gdn_conv_w;
        t[T_GALOG] = (unsigned long long)P.gdn_A_log;
        t[T_GDT] = (unsigned long long)P.gdn_dt_bias;
        t[T_GON] = (unsigned long long)P.gdn_out_norm;
        t[T_XQN] = (unsigned long long)P.xa_q_norm;
        t[T_XKN] = (unsigned long long)P.xa_k_norm;
        t[T_WMKV] = (unsigned long long)P.w_mem_kv;
        t[T_PA] = (unsigned long long)P.p_attn;
        t[T_PD] = (unsigned long long)P.p_gdn;
        t[T_PM] = (unsigned long long)P.p_mem;
        t[T_WO] = (unsigned long long)P.w_o;
        t[T_GFFN] = (unsigned long long)P.g_ffn;
        t[T_WUP] = (unsigned long long)P.w_up;
        t[T_FCW] = (unsigned long long)P.ffn_conv_w;
        t[T_FCB] = (unsigned long long)P.ffn_conv_b;
        t[T_WDOWN] = (unsigned long long)P.w_down;
        t[T_WS] = (unsigned long long)P.ws;
    }
    if (threadIdx.x == 0) { ((LAS unsigned*)(lds + 272))[0] = 0u; ((LAS unsigned*)(lds + 272))[1] = 0u; }
    __syncthreads();
#define TP(i) tptr(lds, i)
    const XcdBarrier xbar = xcd_barrier_post((unsigned*)(P.ws + WS_CTL) + 1024, (volatile LAS unsigned*)(lds + 272));
#define GSYNC() xcd_barrier(xbar)
#define WSB ((unsigned char*)TP(T_WS))
#define H ((bf16*)(WSB + WS_H))
#define AB ((float*)(WSB + WS_AB))
#define MEMN ((bf16*)(WSB + WS_MEMN))
#define MEMKV ((bf16*)(WSB + WS_MEMKV))
#define COUT ((bf16*)(WSB + WS_COUT))
#define GDNB ((bf16*)(WSB + WS_GDNB))
#define RW (WSB + WS_W)
#define PROJ ((bf16*)(WSB + WS_BIG))
#define HALO ((bf16*)(WSB + WS_HALO))
#define SSQ ((float*)(WSB + WS_SSQ))
#define ZB ((bf16*)(WSB + WS_BIG))
#define GATES (ZB + (size_t)TG * DM)
#define GT ((bf16*)(WSB + WS_BIG))
#define UP (GT + (size_t)TG * DFF)
#define WDN ((bf16*)(WSB + WS_BIG + (size_t)369098752))
#define PHASE_IDS() int tq = threadIdx.x; asm volatile("" : "+v"(tq));   \
    const int tid = tq, lane = tid & 63, wave = __builtin_amdgcn_readfirstlane(tid >> 6), gw = blockIdx.x * NWV + wave; \
    LAS float* scr = (LAS float*)(lds + LDS_PH + wave * 16896); (void)lane; (void)gw; (void)scr; (void)tid
#pragma unroll 1
    for (int g = 0; g < 2; ++g) {
        const int B = g ? 2 : 4, S = g ? 8192 : 4096, NMEM = B * 256;

#define X (TP(T_X0 + g))
#define OUT ((float*)TP(T_OUT0 + g))
#define MEMX (TP(T_MEM0 + g))
#define GDNF ((bf16*)OUT)
#define AOUT (GDNF + (size_t)TG * DM)
        p0_phase(lds, g, NGW);
        GSYNC();
        if (gridDim.x == 0x7fffffffu) grid.sync();
#ifndef GEMM_REPS
#define GEMM_REPS 1
#endif
        for (int rp = 0; rp < GEMM_REPS; ++rp)
        { pg8::Gemm gm{H, (const bf16*)(RW + W_WINA), TG, NP1, DM}; pg8::StaticOrder So; So.init(TG, NP1, (int)gridDim.x, (int)blockIdx.x);
          EpiP1 Ep{PROJ, AB, TP(T_DAQN), TP(T_DAKN), TP(T_XQN), (LAS float*)(lds + LDS_PH + 131072), HALO};
          pg8::gemm_phase<EpiP1, pg8::StaticOrder, true, true>(lds + LDS_PH, gm, So, Ep); }
        GSYNC();
#ifndef P3_GDN_ONLY
#define P3_GDN_ONLY 0
#endif
        {
            { pg8::Gemm gm{MEMN, (const bf16*)(RW + W_WMKV), 1024, 1024, DM}; pg8::StaticOrder So; So.init(1024, 1024, (int)gridDim.x, (int)blockIdx.x);
              EpiMKV Ep{MEMKV, TP(T_XKN), (LAS float*)(lds + LDS_PH + 131072)};
              pg8::gemm_phase<EpiMKV, pg8::StaticOrder, true, true>(lds + LDS_PH, gm, So, Ep); }
            PHASE_IDS();
            volatile LAS unsigned* wq = (volatile LAS unsigned*)(lds + LDS_WQ);
            for (;;) {
                __syncthreads();
                if (tid == 0) wq[0] = atomicAdd((unsigned*)(WSB + WS_CTL) + 64 * g + 48, 1u);
                __syncthreads();
                const int ck = (int)wq[0];
                if (ck >= 256 * 768 / NTHR) break;
                const int it = ck * NTHR + tid;
                gdn_conv_item(PROJ, HALO, TP(T_GCONV), S, it / 768, it % 768, 0);
            }
        }
        GSYNC();
#ifndef P3_REPS
#define P3_REPS 1
#endif
        for (int rep = 0; rep < P3_REPS; ++rep) {
            PHASE_IDS();
            const int nG = B * 32, nA = B * 16 * (S / 256), nX = B * 4 * (S / 256), total = (rep > 0 && P3_GDN_ONLY) ? nG : nG + nA + nX;
            volatile LAS unsigned* wq = (volatile LAS unsigned*)(lds + LDS_WQ);
            for (;;) {
                __syncthreads();
                if (tid == 0) wq[0] = atomicAdd((unsigned*)(WSB + WS_CTL) + 64 * g + 16 * rep, 1u);
                __syncthreads();
                const int item = (int)wq[0];
                if (item >= total) break;
#ifndef NO_GDN
                if (item < nG) { const int dir = item & 1, h = (item >> 1) & 15, bl = item >> 5;
                    if (dir) gdn::gdn_unit<1>(TP(T_GALOG), TP(T_GDT), S, bl * S, h, PROJ, AB, GDNB, (LAS char*)lds + LDS_PH); else gdn::gdn_unit<0>(TP(T_GALOG), TP(T_GDT), S, bl * S, h, PROJ, AB, GDNF, (LAS char*)lds + LDS_PH);
                } else
#endif
#ifndef NO_DATT
                if (item < nG + nA) { const int u = item - nG, lq = g ? 5 : 4, lb = g ? 1 : 2, qb = u & ((1 << lq) - 1), bl = (u >> lq) & (B - 1), hv = u >> (lq + lb), h = 7 - (hv >> 1), vh = hv & 1;
                    diffattn_unit(TP(T_DALAM), TP(T_DAQN), TP(T_DAKN), S, bl * S, h, qb, vh, PROJ, AOUT, SSQ, (char*)lds_raw + LDS_PH);
                } else
#endif
#ifndef NO_XATT
                if (item >= nG + nA) { const int u = item - nG - nA, lq = g ? 5 : 4, qb = u & ((1 << lq) - 1), xh = (u >> lq) & 3, bl = u >> (lq + 2);
                    xattn_unit(bl * S, bl, xh, qb, PROJ, MEMKV, COUT, (char*)lds_raw + LDS_PH); }
#endif
                {}
            }
            if (rep == 0) {
                constexpr int NSL = 128;
                for (;;) {
                    __syncthreads();
                    if (tid == 0) wq[0] = atomicAdd((unsigned*)(WSB + WS_CTL) + 64 * g + 32, 1u);
                    __syncthreads();
                    const int sl = (int)wq[0];
                    if (sl >= NSL) break;
                    const int gw = sl * NWV + wave; const int NGW = NSL * NWV;
                    transpose_job(TP(T_WIN), 21056, 12288, 2048, DM, (bf16*)(RW + W_WINB), 0, scr, gw, NGW, lane);
                    transpose_job(TP(T_WIN), 21056, 14912, 6144, DM, (bf16*)(RW + W_WINB), 2048, scr, gw, NGW, lane);
                    transpose_job(TP(T_PA), DM, 0, DM, DM, (bf16*)(RW + W_PA), 0, scr, gw, NGW, lane);
                    transpose_job(TP(T_PD), DM, 0, DM, DM, (bf16*)(RW + W_PD), 0, scr, gw, NGW, lane);
                    transpose_job(TP(T_PM), DM, 0, DM, 512, (bf16*)(RW + W_PM), 0, scr, gw, NGW, lane);
                    transpose_job(TP(T_WO), DM, 0, DM, DM, (bf16*)(RW + W_WO), 0, scr, gw, NGW, lane);
                }
            }
            if (rep + 1 < P3_REPS) GSYNC();
        }
        GSYNC();
        for (int rp = 0; rp < GEMM_REPS; ++rp)
        run_gemm_l(lds + LDS_PH, H, (const bf16*)(RW + W_WINB), TG, NP1B, DM, F_P1b{ZB, GATES, TP(T_BGATE)});
        GSYNC();
        {
            PHASE_IDS();
            const int l16 = lane & 15, sub = lane >> 4; const float* gon = TP(T_GON);
            { bf16* gf = GDNF; const bf16* gb = GDNB; const bf16* zb = ZB;
              for (int it0 = gw; it0 < TG * 4; it0 += 4 * NGW) {
                size_t off[4]; u32x4 ra[4], rb[4], rz[4];
#pragma unroll
                for (int u = 0; u < 4; ++u) { const int it = it0 + u * NGW, row = it >> 2, hd = (it & 3) * 4 + sub; off[u] = (size_t)row * DM + hd * 128 + l16 * 8;
                    ra[u] = *(const u32x4*)(gf + off[u]); rb[u] = *(const u32x4*)(gb + off[u]); rz[u] = *(const u32x4*)(zb + off[u]); }
#pragma unroll
                for (int u = 0; u < 4; ++u) { float a[8], b[8], z[8]; unpack8(ra[u], a); unpack8(rb[u], b); unpack8(rz[u], z);
                    float ss = 0.f;
#pragma unroll
                    for (int e = 0; e < 8; ++e) { a[e] += b[e]; ss += a[e] * a[e]; }
                    ss += __shfl_xor(ss, 1); ss += __shfl_xor(ss, 2); ss += __shfl_xor(ss, 4); ss += __shfl_xor(ss, 8);
                    const float inv = rsq_(ss * (1.f / 128.f) + EPS);
#pragma unroll
                    for (int e = 0; e < 8; ++e) a[e] = a[e] * inv * gon[l16 * 8 + e] * (z[e] * sigmoidf_(z[e]));
                    *(u32x4*)(gf + off[u]) = pack8(a); } } }
        }
        {
            PHASE_IDS();
            const int l32 = lane & 31, sub = lane >> 5; const float* subln = TP(T_DASUB);
            { bf16* ao = AOUT; const float* sq = SSQ; const f32x4 g0 = *(const f32x4*)(subln + l32 * 8), g1 = *(const f32x4*)(subln + l32 * 8 + 4);
              for (int it0 = gw; it0 < TG * 4; it0 += 8 * NGW) {
                bf16* ap[8]; u32x4 ra[8]; float t0[8], t1[8];
#pragma unroll
                for (int u = 0; u < 8; ++u) { const int it = it0 + u * NGW, row = it >> 2, hd = (it & 3) * 2 + sub; ap[u] = ao + (size_t)row * DM + hd * 256 + l32 * 8;
                    ra[u] = *(const u32x4*)ap[u]; t0[u] = sq[(size_t)row * 16 + hd * 2]; t1[u] = sq[(size_t)row * 16 + hd * 2 + 1]; }
#pragma unroll
                for (int u = 0; u < 8; ++u) { float a[8]; unpack8(ra[u], a);
                    const float rinv = (rsq_((t0[u] + t1[u]) * (1.f / 256.f) + EPS)) * 0.8f;
#pragma unroll
                    for (int e = 0; e < 4; ++e) { a[e] *= rinv * g0[e]; a[4 + e] *= rinv * g1[e]; }
                    *(u32x4*)ap[u] = pack8(a); } } }
        }
        GSYNC();
        for (int rp = 0; rp < GEMM_REPS; ++rp) {
        run_gemm_l(lds + LDS_PH, AOUT, (const bf16*)(RW + W_PA), TG, DM, DM, F_Merge{GATES, H, 1});
        run_gemm_l(lds + LDS_PH, GDNF, (const bf16*)(RW + W_PD), TG, DM, DM, F_Merge{GATES + DM, H, 0});
        run_gemm_l(lds + LDS_PH, COUT, (const bf16*)(RW + W_PM), TG, DM, 512, F_Merge{GATES + 2 * DM, H, 0}); }
        GSYNC();
        for (int rp = 0; rp < GEMM_REPS; ++rp)
        run_gemm_l(lds + LDS_PH, H, (const bf16*)(RW + W_WO), TG, DM, DM, F_Wo{X, OUT});
        GSYNC();
        {
            PHASE_IDS();
            for (int m = gw; m < TG; m += NGW) rms_row(OUT + (size_t)m * DM, TP(T_GFFN), H + (size_t)m * DM, lane);
            transpose_job(TP(T_WUP), 2 * DFF, 0, 2 * DFF, DM, (bf16*)(RW + W_UP), 0, scr, gw, NGW, lane);
            transpose_job(TP(T_WDOWN), DM, 0, DM, DFF, WDN, 0, scr, gw, NGW, lane);
        }
        GSYNC();
        for (int rp = 0; rp < GEMM_REPS; ++rp)
        run_gemm(lds + LDS_PH, H, (const bf16*)(RW + W_UP), TG, 2 * DFF, DM, F_Up{GT, UP});
        GSYNC();
        {
            PHASE_IDS();
            const int ncg = DFF / 8;
            const float* fcw = TP(T_FCW); const float* fcb = TP(T_FCB); const bf16* gt = GT; bf16* up = UP;
            for (int it = blockIdx.x * NTHR + tid; it < (TG / 8) * ncg; it += gridDim.x * NTHR) { const int run = it / ncg, c0 = (it - run * ncg) * 8, row0 = run * 8, t0 = row0 & (S - 1);
                u32x4 g[10], uu[8];
                const u32x4 zero4 = (u32x4){0u, 0u, 0u, 0u};
#pragma unroll
                for (int r = 0; r < 10; ++r) { const int tt = t0 + r - 1; g[r] = (tt >= 0 && tt < S) ? *(const u32x4*)(gt + (size_t)(row0 + r - 1) * DFF + c0) : zero4; }
#pragma unroll
                for (int r = 0; r < 8; ++r) uu[r] = *(const u32x4*)(up + (size_t)(row0 + r) * DFF + c0);
                f32x4 w[3][2];
#pragma unroll
                for (int j = 0; j < 3; ++j) { w[j][0] = *(const f32x4*)(fcw + j * DFF + c0); w[j][1] = *(const f32x4*)(fcw + j * DFF + c0 + 4); }
                const f32x4 b0 = *(const f32x4*)(fcb + c0), b1 = *(const f32x4*)(fcb + c0 + 4);
#pragma unroll
                for (int r = 0; r < 8; ++r) { float acc[8], u[8], xv[8];
#pragma unroll
                    for (int e = 0; e < 4; ++e) { acc[e] = b0[e]; acc[4 + e] = b1[e]; }
#pragma unroll
                    for (int j = 0; j < 3; ++j) { unpack8(g[r + j], xv);
#pragma unroll
                        for (int e = 0; e < 4; ++e) { acc[e] = fmaf(w[j][0][e], xv[e], acc[e]); acc[4 + e] = fmaf(w[j][1][e], xv[4 + e], acc[4 + e]); } }
                    unpack8(uu[r], u);
#pragma unroll
                    for (int e = 0; e < 8; ++e) u[e] *= acc[e] * sigmoidf_(acc[e]);
                    *(u32x4*)(up + (size_t)(row0 + r) * DFF + c0) = pack8(u); } }
        }
        GSYNC();
        run_gemm_l(lds + LDS_PH, UP, (const bf16*)WDN, TG, DM, DFF, F_Down{OUT});
        GSYNC();
    }
}

extern "C" void kernel_launch(void* const* d_in, const int* in_sizes, int n_in, void* d_out, int out_size, void* d_ws, size_t ws_size, hipStream_t stream) {
    static int grid_blocks = 0;
    if (grid_blocks == 0) {
        if (n_in != 28 || ws_size < WS_END || out_size != 2 * TG * DM) { fprintf(stderr, "kernel_launch: unexpected shapes: n_in %d out %d ws %zu (need %zu)\n", n_in, out_size, ws_size, (size_t)WS_END); grid_blocks = -1; return; }
        int dev = 0, cus = 0, per_cu = 0;
        hipGetDevice(&dev); hipDeviceGetAttribute(&cus, hipDeviceAttributeMultiprocessorCount, dev);
        if (hipFuncSetAttribute((const void*)hybrid_fwd, hipFuncAttributeMaxDynamicSharedMemorySize, LDS_BYTES) != hipSuccess) { fprintf(stderr, "kernel_launch: hipFuncSetAttribute failed\n"); grid_blocks = -1; return; }
        if (hipOccupancyMaxActiveBlocksPerMultiprocessor(&per_cu, (const void*)hybrid_fwd, NTHR, LDS_BYTES) != hipSuccess || per_cu < 1) { fprintf(stderr, "kernel_launch: occupancy query gave %d\n", per_cu); per_cu = 1; }
        (void)hipGetLastError();
        grid_blocks = cus * 1;
        fprintf(stderr, "kernel_launch: grid %d (cus %d, per_cu %d), ws %zu need %zu\n", grid_blocks, cus, per_cu, ws_size, (size_t)WS_END);
    }
    if (grid_blocks < 0) return;
    hipMemsetAsync((char*)d_ws + WS_CTL, 0, 65536, stream);
    Params p{};
    const float* const* in = (const float* const*)d_in;
    p.x[0] = in[0]; p.x[1] = in[1]; p.mem[0] = in[2]; p.mem[1] = in[3]; p.out[0] = (float*)d_out; p.out[1] = (float*)d_out + (size_t)TG * DM;
    p.g_mix = in[4]; p.g_mem = in[5]; p.w_in = in[6]; p.b_gate = in[7]; p.da_q_norm = in[8]; p.da_k_norm = in[9]; p.da_lambda = in[10]; p.da_subln = in[11];
    p.gdn_conv_w = in[12]; p.gdn_A_log = in[13]; p.gdn_dt_bias = in[14]; p.gdn_out_norm = in[15]; p.xa_q_norm = in[16]; p.xa_k_norm = in[17]; p.w_mem_kv = in[18];
    p.p_attn = in[19]; p.p_gdn = in[20]; p.p_mem = in[21]; p.w_o = in[22]; p.g_ffn = in[23]; p.w_up = in[24]; p.ffn_conv_w = in[25]; p.ffn_conv_b = in[26]; p.w_down = in[27];
    p.ws = (unsigned char*)d_ws;
    void* args[] = {&p};
    hipError_t e = hipLaunchCooperativeKernel((const void*)hybrid_fwd, dim3(grid_blocks), dim3(NTHR), args, LDS_BYTES, stream);
    if (e != hipSuccess) fprintf(stderr, "cooperative launch failed: %s (grid %d)\n", hipGetErrorString(e), grid_blocks);
}
```

```cpp
#include <hip/hip_runtime.h>
#include <hip/hip_cooperative_groups.h>
#include <cstdio>
#include <cstdint>
namespace cg = cooperative_groups;

namespace pg8 {
#define PG8_LAS __attribute__((address_space(3)))
typedef unsigned short bf16_t;
typedef short bf16x8 __attribute__((ext_vector_type(8)));
typedef float f32x4 __attribute__((ext_vector_type(4)));
typedef unsigned u32x4 __attribute__((ext_vector_type(4)));
constexpr int BM = 256, BK = 64, HALF = 128, HTB = HALF * BK * 2  , STAGE_BYTES = 8 * HTB, NXCD = 8, WGM = 8;

__host__ __device__ __forceinline__ int lds_byte(int r, int c) { const int st = (r >> 4) * 2 + (c >> 5), rr = r & 15, cc = c & 31, ob = rr * 64 + cc * 2; return st * 1024 + (ob ^ (((ob >> 9) & 1) << 5)); }
__host__ __device__ __forceinline__ void stage_rc(int b, int& R, int& C) { const int st = b / 1024, sb = b % 1024, swz = sb ^ (((sb >> 9) & 1) << 5); R = (st >> 1) * 16 + swz / 64; C = (st & 1) * 32 + (swz % 64) / 2; }
__host__ __device__ __forceinline__ int perm32(int rho) { const int n = rho >> 4, i = rho & 15; return 8 * (i >> 2) + 4 * n + (i & 3); }

struct Unit { int pm, pn; };
struct Gemm { const bf16_t* A; const bf16_t* Bt; int M, N, K; };

struct StaticOrder {
    int nM, nN, nwg, G, c;
    __host__ __device__ void init(int M, int N, int G_, int c_) { nM = M / BM; nN = N / BM; nwg = nM * nN; G = G_; c = c_; }
    __host__ __device__ bool next(int i, Unit& u) const {
        const long L = (long)i * G + c; if (L >= nwg) return false;
        int wgid = (int)L; { const int q = nwg / NXCD, r = nwg % NXCD, xcd = wgid % NXCD, off = wgid / NXCD; wgid = (xcd < r ? xcd * (q + 1) : r * (q + 1) + (xcd - r) * q) + off; }
        const int nig = WGM * nN, gid = wgid / nig, fm = gid * WGM, gsz = (nM - fm) < WGM ? (nM - fm) : WGM;
        u.pm = fm + ((wgid % nig) % gsz); u.pn = (wgid % nig) / gsz; return true;
    }
    __device__ __forceinline__ void a_ready(const Unit&) const {}
    __device__ __forceinline__ void done(const Unit&) const {}
};

typedef float f32x2_cv __attribute__((ext_vector_type(2))); typedef __bf16 bf16x2_cv __attribute__((ext_vector_type(2)));
__device__ __forceinline__ unsigned cvt_pk_bf16(float lo, float hi) { f32x2_cv v = {lo, hi}; bf16x2_cv b = __builtin_convertvector(v, bf16x2_cv); return __builtin_bit_cast(unsigned, b); }
template <class F> struct EpiRow8L {
    static constexpr bool PERM = true, AFTER_DRAIN = false; F f;
    __device__ __forceinline__ void operator()(const f32x4 (&acc)[2][2][4][2], const Unit& u, int wr, int wc, int fr, int fq) const {
        const int row0 = u.pm * BM + wr * 64 + fr, col0 = u.pn * BM + wc * 32 + 8 * fq;
#pragma unroll
        for (int ai = 0; ai < 2; ++ai) { typename F::Ctx c[4][2];
#pragma unroll
            for (int m = 0; m < 4; ++m)
#pragma unroll
                for (int bj = 0; bj < 2; ++bj) c[m][bj] = f.load(row0 + ai * HALF + m * 16, col0 + bj * HALF);
#pragma unroll
            for (int m = 0; m < 4; ++m)
#pragma unroll
                for (int bj = 0; bj < 2; ++bj) f.apply(c[m][bj], row0 + ai * HALF + m * 16, col0 + bj * HALF, acc[ai][bj][m][0], acc[ai][bj][m][1]); }
    }
};
template <class F> struct EpiRow8 {
    static constexpr bool PERM = true, AFTER_DRAIN = false; F f;
    __device__ __forceinline__ void operator()(const f32x4 (&acc)[2][2][4][2], const Unit& u, int wr, int wc, int fr, int fq) const {
        const int row0 = u.pm * BM + wr * 64 + fr, col0 = u.pn * BM + wc * 32 + 8 * fq;
#pragma unroll
        for (int ai = 0; ai < 2; ++ai)
#pragma unroll
            for (int m = 0; m < 4; ++m)
#pragma unroll
                for (int bj = 0; bj < 2; ++bj) f(row0 + ai * HALF + m * 16, col0 + bj * HALF, acc[ai][bj][m][0], acc[ai][bj][m][1]);
    }
};
template <class Epi, class Sched, bool ALIGN_EPI = false, bool SP2 = false>
__device__ __forceinline__ void gemm_phase(PG8_LAS unsigned char* lds, const Gemm g, const Sched& S, const Epi& E) {
    int tid_ = threadIdx.x; asm volatile("" : "+v"(tid_));
    const int tid = tid_, wid = __builtin_amdgcn_readfirstlane(tid >> 6), lane = tid & 63, wr = wid >> 2, wc = wid & 3, fr = lane & 15, fq = lane >> 4;
    const int K = g.K, nt = K / BK;
    unsigned voffA[2], voffB[2];
#pragma unroll
    for (int i = 0; i < 2; ++i) { int R, C; stage_rc(tid * 16 + i * 8192, R, C); const int Rb = Epi::PERM ? ((R & ~31) + perm32(R & 31)) : R;
        voffA[i] = (unsigned)(R * K + C) * 2u; voffB[i] = (unsigned)(Rb * K + C) * 2u; }
    const size_t kstep = (size_t)(BK * 2);
    const size_t hstep = (size_t)HALF * K * 2;
    const size_t tstep = 2 * hstep;
    const unsigned ldsw = (unsigned)wid * 1024u;
    const int aoff = lds_byte(wr * 64 + fr, fq * 8), boff = lds_byte(wc * 32 + fr, fq * 8);
#define PG8_SA(b, h) (((b) * 2 + (h)) * HTB)
#define PG8_SB(b, h) ((4 + (b) * 2 + (h)) * HTB)
#define PG8_STAGE(bufoff, gbase, voff) do { _Pragma("unroll") for (int _i = 0; _i < 2; ++_i) \
        __builtin_amdgcn_global_load_lds((const unsigned*)((const char*)(gbase) + (voff)[_i]), (PG8_LAS unsigned*)(lds + (bufoff) + ldsw + _i * 8192), 16, 0, 0); } while (0)
#define PG8_LDA(dst, b, h) do { _Pragma("unroll") for (int m = 0; m < 4; ++m) _Pragma("unroll") for (int k = 0; k < 2; ++k) dst[m][k] = *(const PG8_LAS bf16x8*)(lds + PG8_SA(b, h) + aoff + m * 2048 + k * 1024); } while (0)
#define PG8_LDB(dst, b, h) do { _Pragma("unroll") for (int n = 0; n < 2; ++n) _Pragma("unroll") for (int k = 0; k < 2; ++k) dst[n][k] = *(const PG8_LAS bf16x8*)(lds + PG8_SB(b, h) + boff + n * 2048 + k * 1024); } while (0)
#define PG8_MMA(ai, bj, At, Bt) do { __builtin_amdgcn_s_setprio(1); _Pragma("unroll") for (int m = 0; m < 4; ++m) _Pragma("unroll") for (int n = 0; n < 2; ++n) _Pragma("unroll") for (int k = 0; k < 2; ++k) \
        acc[ai][bj][m][n] = __builtin_amdgcn_mfma_f32_16x16x32_bf16(Bt[n][k], At[m][k], acc[ai][bj][m][n], 0, 0, 0); __builtin_amdgcn_s_setprio(0); } while (0)
#define PG8_WAIT_V(n) asm volatile("s_waitcnt vmcnt(" #n ")" ::: "memory")
#define PG8_WAIT_L(n) asm volatile("s_waitcnt lgkmcnt(" #n ")" ::: "memory")
#define PG8_BAR __builtin_amdgcn_s_barrier()
#define PG8_SCHED __builtin_amdgcn_sched_barrier(0)
    Unit cur, nxt; int ui = 0;
    if (!S.next(0, cur)) return;
    f32x4 acc[2][2][4][2];
#pragma unroll
    for (int a = 0; a < 2; ++a)
#pragma unroll
        for (int b = 0; b < 2; ++b)
#pragma unroll
            for (int m = 0; m < 4; ++m)
#pragma unroll
                for (int n = 0; n < 2; ++n) acc[a][b][m][n] = (f32x4){0.f, 0.f, 0.f, 0.f};
    bf16x8 At[4][2], B0[2][2], B1[2][2];
    const char* cA = (const char*)g.A + (size_t)cur.pm * tstep; const char* cB = (const char*)g.Bt + (size_t)cur.pn * tstep;
    S.a_ready(cur);
    if constexpr (SP2) {
        PG8_STAGE(PG8_SB(0, 0), cB, voffB); PG8_STAGE(PG8_SB(0, 1), cB + hstep, voffB); PG8_STAGE(PG8_SA(0, 0), cA, voffA); PG8_STAGE(PG8_SA(0, 1), cA + hstep, voffA);
        if (wr == 1) PG8_BAR;
        PG8_WAIT_V(2); PG8_BAR;
        PG8_STAGE(PG8_SB(1, 0), cB + kstep, voffB); PG8_STAGE(PG8_SA(1, 0), cA + kstep, voffA); PG8_STAGE(PG8_SB(1, 1), cB + hstep + kstep, voffB);
        PG8_WAIT_V(6); PG8_BAR;
    } else {
        PG8_STAGE(PG8_SB(0, 0), cB, voffB); PG8_STAGE(PG8_SA(0, 0), cA, voffA); PG8_STAGE(PG8_SB(0, 1), cB + hstep, voffB); PG8_STAGE(PG8_SA(0, 1), cA + hstep, voffA);
        if (wr == 1) PG8_BAR;
        PG8_WAIT_V(4); PG8_BAR;
        PG8_STAGE(PG8_SB(1, 0), cB + kstep, voffB); PG8_STAGE(PG8_SA(1, 0), cA + kstep, voffA); PG8_STAGE(PG8_SB(1, 1), cB + hstep + kstep, voffB);
        PG8_WAIT_V(6); PG8_BAR;
    }
    for (;;) {
        const bool has_next = S.next(ui + 1, nxt);
        const char* nA = has_next ? (const char*)g.A + (size_t)nxt.pm * tstep : cA; const char* nB = has_next ? (const char*)g.Bt + (size_t)nxt.pn * tstep : cB;
        for (int t = 0; t < nt; t += 2) {
            const bool last = (t == nt - 2);
            const char* a1 = cA + (size_t)(t + 1) * kstep;
            const char* a2 = last ? nA : cA + (size_t)(t + 2) * kstep; const char* b2 = last ? nB : cB + (size_t)(t + 2) * kstep;
            const char* a3 = a2 + kstep; const char* b3 = b2 + kstep;
            if (last && has_next) S.a_ready(nxt);
            if constexpr (SP2) {
            PG8_LDB(B0, 0, 0); PG8_LDB(B1, 0, 1); PG8_SCHED; PG8_LDA(At, 0, 0); PG8_STAGE(PG8_SA(1, 1), a1 + hstep, voffA);
            PG8_WAIT_V(8); PG8_WAIT_L(0); PG8_BAR; PG8_MMA(0, 0, At, B0); PG8_MMA(0, 1, At, B1); PG8_BAR; PG8_SCHED;
            PG8_LDA(At, 0, 1); PG8_STAGE(PG8_SB(0, 0), b2, voffB); PG8_STAGE(PG8_SB(0, 1), b2 + hstep, voffB); PG8_STAGE(PG8_SA(0, 0), a2, voffA);
            PG8_WAIT_V(8); PG8_WAIT_L(0); PG8_BAR; PG8_MMA(1, 0, At, B0); PG8_MMA(1, 1, At, B1); PG8_BAR; PG8_SCHED;
            PG8_LDB(B0, 1, 0); PG8_LDB(B1, 1, 1); PG8_SCHED; PG8_LDA(At, 1, 0); PG8_STAGE(PG8_SA(0, 1), a2 + hstep, voffA);
            PG8_WAIT_V(8); PG8_WAIT_L(0); PG8_BAR; PG8_MMA(0, 0, At, B0); PG8_MMA(0, 1, At, B1); PG8_BAR; PG8_SCHED;
            PG8_LDA(At, 1, 1); PG8_STAGE(PG8_SB(1, 0), b3, voffB); PG8_STAGE(PG8_SB(1, 1), b3 + hstep, voffB); PG8_STAGE(PG8_SA(1, 0), a3, voffA);
            PG8_WAIT_V(8); PG8_WAIT_L(0); PG8_BAR; PG8_MMA(1, 0, At, B0); PG8_MMA(1, 1, At, B1); PG8_BAR; PG8_SCHED;
            } else {
            PG8_LDB(B0, 0, 0); PG8_SCHED; PG8_LDA(At, 0, 0); PG8_STAGE(PG8_SA(1, 1), a1 + hstep, voffA);
            PG8_WAIT_L(8); PG8_BAR; PG8_WAIT_L(0); PG8_MMA(0, 0, At, B0); PG8_BAR; PG8_SCHED;
            PG8_LDB(B1, 0, 1); PG8_STAGE(PG8_SB(0, 0), b2, voffB);
            PG8_BAR; PG8_WAIT_L(0); PG8_MMA(0, 1, At, B1); PG8_BAR;
            PG8_LDA(At, 0, 1); PG8_STAGE(PG8_SA(0, 0), a2, voffA);
            PG8_BAR; PG8_WAIT_L(0); PG8_MMA(1, 0, At, B0); PG8_BAR; PG8_SCHED;
            PG8_STAGE(PG8_SB(0, 1), b2 + hstep, voffB);
            PG8_WAIT_V(6); PG8_BAR; PG8_MMA(1, 1, At, B1); PG8_BAR;
            PG8_LDB(B0, 1, 0); PG8_SCHED; PG8_LDA(At, 1, 0); PG8_STAGE(PG8_SA(0, 1), a2 + hstep, voffA);
            PG8_WAIT_L(8); PG8_BAR; PG8_WAIT_L(0); PG8_MMA(0, 0, At, B0); PG8_BAR; PG8_SCHED;
            PG8_LDB(B1, 1, 1); PG8_STAGE(PG8_SB(1, 0), b3, voffB);
            PG8_BAR; PG8_WAIT_L(0); PG8_MMA(0, 1, At, B1); PG8_BAR;
            PG8_LDA(At, 1, 1); PG8_STAGE(PG8_SA(1, 0), a3, voffA);
            PG8_BAR; PG8_WAIT_L(0); PG8_MMA(1, 0, At, B0); PG8_BAR; PG8_SCHED;
            PG8_STAGE(PG8_SB(1, 1), b3 + hstep, voffB);
            PG8_WAIT_V(6); PG8_BAR; PG8_MMA(1, 1, At, B1); PG8_BAR;
            }
        }
        if constexpr (ALIGN_EPI) { if (wr == 0) PG8_BAR; }
        if constexpr (!Epi::AFTER_DRAIN) { E(acc, cur, wr, wc, fr, fq); S.done(cur); }
        if (!has_next) break;
#pragma unroll
        for (int a = 0; a < 2; ++a)
#pragma unroll
            for (int b = 0; b < 2; ++b)
#pragma unroll
                for (int m = 0; m < 4; ++m)
#pragma unroll
                    for (int n = 0; n < 2; ++n) acc[a][b][m][n] = (f32x4){0.f, 0.f, 0.f, 0.f};
        cur = nxt; cA = nA; cB = nB; ++ui;
        if constexpr (ALIGN_EPI) { if (wr == 1) PG8_BAR; }
    }
    PG8_WAIT_V(0);
    if constexpr (!ALIGN_EPI) { if (wr == 0) PG8_BAR; }
    PG8_BAR;
    if constexpr (Epi::AFTER_DRAIN) { E.fused(acc, cur, wr, wc, fr, fq, lds, wid, lane); S.done(cur); }
#undef PG8_SA
#undef PG8_SB
#undef PG8_STAGE
#undef PG8_LDA
#undef PG8_LDB
#undef PG8_MMA
#undef PG8_WAIT_V
#undef PG8_WAIT_L
#undef PG8_BAR
#undef PG8_SCHED
}
}

#define LAS __attribute__((address_space(3)))
typedef unsigned short bf16;
typedef short bf16x8 __attribute__((ext_vector_type(8)));
typedef short s16x4 __attribute__((ext_vector_type(4)));
typedef float f32x4 __attribute__((ext_vector_type(4)));
typedef float f32x16 __attribute__((ext_vector_type(16)));
typedef unsigned u32x4 __attribute__((ext_vector_type(4)));
typedef unsigned u32x2 __attribute__((ext_vector_type(2)));

constexpr int DM = 2048, TG = 16384, NPROJ = 12800, NP1 = 13056, NP1B = 8192, DFF = 5632;
constexpr int C_DAQ = 0, C_DAK = 2048, C_DAV = 4096, C_GDN = 6144, C_XAQ = 12288;
constexpr float EPS = 1e-6f, LOG2E = 1.4426950408889634f, QSCALE = 0.08838834764831845f * 1.4426950408889634f;
constexpr int NTHR = 512, NWV = 8;

constexpr size_t WS_CTL = 0, WS_H = 65536, WS_AB = WS_H + (size_t)TG * DM * 2, WS_MEMN = WS_AB + (size_t)TG * 64 * 4,
                 WS_MEMKV = WS_MEMN + (size_t)1024 * DM * 2, WS_COUT = WS_MEMKV + (size_t)1024 * 1024 * 2, WS_GDNB = WS_COUT + (size_t)TG * 512 * 2,
                 WS_W = WS_GDNB + (size_t)TG * DM * 2, WS_BIG = WS_W + (size_t)69206016, WS_HALO = WS_BIG + (size_t)TG * NPROJ * 2, WS_SSQ = WS_HALO + (size_t)256 * 4 * 6144 * 2, WS_END = WS_SSQ + (size_t)TG * 16 * 4;
constexpr size_t W_WINA = 0, W_WMKV = (size_t)NP1 * DM * 2;
constexpr size_t W_WINB = 0, W_PA = (size_t)NP1B * DM * 2, W_PD = W_PA + (size_t)DM * DM * 2, W_PM = W_PD + (size_t)DM * DM * 2, W_WO = W_PM + (size_t)DM * 512 * 2;
constexpr size_t W_UP = 0, W_DOWN = (size_t)2 * DFF * DM * 2;
static_assert(W_WO + (size_t)DM * DM * 2 <= 69206016 && W_DOWN + (size_t)DM * DFF * 2 <= 69206016 && W_WMKV + (size_t)1024 * DM * 2 <= 69206016, "R_W");
constexpr int LDS_BYTES = 159744;

struct Params {
    const float* x[2]; const float* mem[2]; float* out[2];
    const float *g_mix, *g_mem, *w_in, *b_gate, *da_q_norm, *da_k_norm, *da_lambda, *da_subln, *gdn_conv_w, *gdn_A_log, *gdn_dt_bias, *gdn_out_norm,
                *xa_q_norm, *xa_k_norm, *w_mem_kv, *p_attn, *p_gdn, *p_mem, *w_o, *g_ffn, *w_up, *ffn_conv_w, *ffn_conv_b, *w_down;
    unsigned char* ws;
};

constexpr int LDS_TBL = 0, LDS_WQ = 256, LDS_PH = 512;
enum { T_X0, T_X1, T_MEM0, T_MEM1, T_OUT0, T_OUT1, T_GMIX, T_GMEM, T_WIN, T_BGATE, T_DAQN, T_DAKN, T_DALAM, T_DASUB, T_GCONV, T_GALOG, T_GDT, T_GON, T_XQN, T_XKN, T_WMKV, T_PA, T_PD, T_PM, T_WO, T_GFFN, T_WUP, T_FCW, T_FCB, T_WDOWN, T_WS, T_N };
__device__ __forceinline__ const float* tptr(const LAS unsigned char* lds, int i) {
    const LAS unsigned* t = (const LAS unsigned*)(lds + LDS_TBL) + 2 * i; unsigned lo = t[0], hi = t[1];
    lo = __builtin_amdgcn_readfirstlane(lo); hi = __builtin_amdgcn_readfirstlane(hi);
    return (const float*)(((unsigned long long)hi << 32) | (unsigned long long)lo);
}
__device__ __forceinline__ unsigned f2bf(float f) { return pg8::cvt_pk_bf16(f, 0.f) & 0xffffu; }
__device__ __forceinline__ unsigned pk2(float lo, float hi) { return pg8::cvt_pk_bf16(lo, hi); }
__device__ __forceinline__ float bf2f(unsigned short b) { return __builtin_bit_cast(float, (unsigned)b << 16); }
__device__ __forceinline__ float bflo(unsigned w) { return __builtin_bit_cast(float, w << 16); }
__device__ __forceinline__ float bfhi(unsigned w) { return __builtin_bit_cast(float, w & 0xffff0000u); }
__device__ __forceinline__ float wave_sum(float v) {
#pragma unroll
    for (int o = 1; o < 64; o <<= 1) v += __shfl_xor(v, o);
    return v;
}
__device__ __forceinline__ void unpack8(u32x4 w, float* f) { f[0] = bflo(w.x); f[1] = bfhi(w.x); f[2] = bflo(w.y); f[3] = bfhi(w.y); f[4] = bflo(w.z); f[5] = bfhi(w.z); f[6] = bflo(w.w); f[7] = bfhi(w.w); }
__device__ __forceinline__ u32x4 pack8(const float* f) { u32x4 w; w.x = pk2(f[0], f[1]); w.y = pk2(f[2], f[3]); w.z = pk2(f[4], f[5]); w.w = pk2(f[6], f[7]); return w; }
__device__ __forceinline__ float sigmoidf_(float x) { return __builtin_amdgcn_rcpf(1.f + __expf(-x)); }
__device__ __forceinline__ float rsq_(float x) { return __builtin_amdgcn_rsqf(x); }

__device__ __forceinline__ void transpose_job(const float* W, int ldw, int col0, int ncols, int K, bf16* WT, int row0, LAS float* scr, int gw, int NGW, int lane) {
    typedef float f32x2t __attribute__((ext_vector_type(2)));
    const int nblk = ncols / 64, nitems = (K / 64) * nblk;
    const int lr = lane >> 4, lc = (lane & 15) * 4;
    const int sn = lane >> 3, sc = lane & 7;
#ifndef TR_REPS
#define TR_REPS 1
#endif
    if (gw >= nitems) return;
    f32x4 v[16];
#define TRJ_LOAD(it_) do { const int kb_ = (it_) / nblk, nb_ = (it_) - kb_ * nblk; const float* src_ = W + (size_t)(64 * kb_ + lr) * ldw + col0 + 64 * nb_ + lc; \
        _Pragma("unroll") for (int i = 0; i < 16; ++i) v[i] = *(const f32x4*)(src_ + (size_t)(4 * i) * ldw); } while (0)
    TRJ_LOAD(gw);
    for (int item = gw; item < nitems; item += NGW) {
        const int kb = item / nblk, nb = item - kb * nblk, k0 = 64 * kb, n0 = 64 * nb;
#pragma unroll
        for (int i = 0; i < 16; ++i) { LAS float* d = scr + (4 * i + lr) * 66 + lc; *(LAS f32x2t*)d = (f32x2t){v[i].x, v[i].y}; *(LAS f32x2t*)(d + 2) = (f32x2t){v[i].z, v[i].w}; }
        asm volatile("s_waitcnt lgkmcnt(0)" ::: "memory");
        if (item + NGW < nitems) TRJ_LOAD(item + NGW);
#pragma unroll
        for (int j = 0; j < 8; ++j) { const int n = sn + 8 * j; const LAS float* s = scr + (8 * sc) * 66 + n;
            u32x4 o; o.x = pk2(s[0 * 66], s[1 * 66]); o.y = pk2(s[2 * 66], s[3 * 66]); o.z = pk2(s[4 * 66], s[5 * 66]); o.w = pk2(s[6 * 66], s[7 * 66]);
            *(u32x4*)(WT + (size_t)(row0 + n0 + n) * K + k0 + 8 * sc) = o; }
        asm volatile("s_waitcnt lgkmcnt(0)" ::: "memory");
    }
#undef TRJ_LOAD
}
__device__ __forceinline__ void rms_row(const float* xrow, const float* gain, bf16* orow, int lane) {
    const f32x4* xr = (const f32x4*)xrow + lane; const f32x4* gr = (const f32x4*)gain + lane;
    f32x4 v[8]; float s = 0.f;
#pragma unroll
    for (int j = 0; j < 8; ++j) { v[j] = xr[64 * j]; s += (v[j].x * v[j].x + v[j].y * v[j].y) + (v[j].z * v[j].z + v[j].w * v[j].w); }
    const float inv = rsq_(wave_sum(s) * (1.f / DM) + EPS);
    u32x2* o8 = (u32x2*)orow + lane;
#pragma unroll
    for (int j = 0; j < 8; ++j) { const f32x4 g = gr[64 * j]; u32x2 w; w.x = pk2(v[j].x * inv * g.x, v[j].y * inv * g.y); w.y = pk2(v[j].z * inv * g.z, v[j].w * inv * g.w); o8[64 * j] = w; }
}

__device__ __forceinline__ u32x4 pack_v(f32x4 v0, f32x4 v1) { u32x4 w; w.x = pg8::cvt_pk_bf16(v0[0], v0[1]); w.y = pg8::cvt_pk_bf16(v0[2], v0[3]); w.z = pg8::cvt_pk_bf16(v1[0], v1[1]); w.w = pg8::cvt_pk_bf16(v1[2], v1[3]); return w; }
struct F_P1 { bf16* proj; float* ab;
    __device__ __forceinline__ void operator()(int row, int col, f32x4 v0, f32x4 v1) const {
        if (col < NPROJ) *(u32x4*)(proj + (size_t)row * NPROJ + col) = pack_v(v0, v1);
        else if (col < NPROJ + 64) { float* p = ab + (size_t)row * 64 + (col - NPROJ); *(f32x4*)p = v0; *(f32x4*)(p + 4) = v1; } } };
struct F_Bf16 { bf16* O; int ldc;
    __device__ __forceinline__ void operator()(int row, int col, f32x4 v0, f32x4 v1) const { *(u32x4*)(O + (size_t)row * ldc + col) = pack_v(v0, v1); } };
struct F_P1b { bf16* z; bf16* gates; const float* bg;
    struct Ctx { f32x4 b0, b1; };
    __device__ __forceinline__ Ctx load(int row, int col) const { Ctx c; const int c2 = col < DM ? 0 : col - DM; c.b0 = *(const f32x4*)(bg + c2); c.b1 = *(const f32x4*)(bg + c2 + 4); return c; }
    __device__ __forceinline__ void apply(const Ctx& c, int row, int col, f32x4 v0, f32x4 v1) const {
        if (col < DM) *(u32x4*)(z + (size_t)row * DM + col) = pack_v(v0, v1);
        else { const int c2 = col - DM;
#pragma unroll
            for (int e = 0; e < 4; ++e) { v0[e] = sigmoidf_(v0[e] + c.b0[e]); v1[e] = sigmoidf_(v1[e] + c.b1[e]); }
            *(u32x4*)(gates + (size_t)row * 6144 + c2) = pack_v(v0, v1); } } };
struct F_Merge { const bf16* gates; bf16* merged; int first;
    struct Ctx { u32x4 g, p; };
    __device__ __forceinline__ Ctx load(int row, int col) const { Ctx c; c.g = *(const u32x4*)(gates + (size_t)row * 6144 + col); c.p = first ? (u32x4){0u, 0u, 0u, 0u} : *(const u32x4*)(merged + (size_t)row * DM + col); return c; }
    __device__ __forceinline__ void apply(const Ctx& c, int row, int col, f32x4 v0, f32x4 v1) const {
        float g[8], pv[8], r[8]; unpack8(c.g, g); unpack8(c.p, pv);
#pragma unroll
        for (int e = 0; e < 4; ++e) { r[e] = fmaf(g[e], v0[e], pv[e]); r[4 + e] = fmaf(g[4 + e], v1[e], pv[4 + e]); }
        *(u32x4*)(merged + (size_t)row * DM + col) = pack8(r); } };
struct F_Wo { const float* x; float* out;
    struct Ctx { f32x4 a, b; };
    __device__ __forceinline__ Ctx load(int row, int col) const { Ctx c; const size_t o = (size_t)row * DM + col; c.a = *(const f32x4*)(x + o); c.b = *(const f32x4*)(x + o + 4); return c; }
    __device__ __forceinline__ void apply(const Ctx& c, int row, int col, f32x4 v0, f32x4 v1) const {
        const size_t o = (size_t)row * DM + col; *(f32x4*)(out + o) = c.a + v0; *(f32x4*)(out + o + 4) = c.b + v1; } };
struct F_Up { bf16* gt; bf16* up;
    __device__ __forceinline__ void operator()(int row, int col, f32x4 v0, f32x4 v1) const {
        if (col < DFF) *(u32x4*)(gt + (size_t)row * DFF + col) = pack_v(v0, v1); else *(u32x4*)(up + (size_t)row * DFF + (col - DFF)) = pack_v(v0, v1); } };
struct F_Down { float* out;
    struct Ctx { f32x4 a, b; };
    __device__ __forceinline__ Ctx load(int row, int col) const { Ctx c; const size_t o = (size_t)row * DM + col; c.a = *(const f32x4*)(out + o); c.b = *(const f32x4*)(out + o + 4); return c; }
    __device__ __forceinline__ void apply(const Ctx& c, int row, int col, f32x4 v0, f32x4 v1) const {
        const size_t o = (size_t)row * DM + col; *(f32x4*)(out + o) = c.a + v0; *(f32x4*)(out + o + 4) = c.b + v1; } };

struct EpiP1 {
    static constexpr bool PERM = true, AFTER_DRAIN = false;
    bf16* proj; float* ab; const float* gq; const float* gk; const float* gx; LAS float* exch; bf16* halo;
    __device__ __forceinline__ void operator()(const pg8::f32x4 (&acc)[2][2][4][2], const pg8::Unit& u, int wr, int wc, int fr, int fq) const {
        const int colt = u.pn * 256, row0 = u.pm * 256 + wr * 64 + fr, col0 = colt + wc * 32 + 8 * fq;
        const bool normed = (colt < C_DAV) || (colt >= C_XAQ && colt < NPROJ);
        if (normed) {
#pragma unroll
            for (int ai = 0; ai < 2; ++ai)
#pragma unroll
                for (int m = 0; m < 4; ++m)
#pragma unroll
                    for (int bj = 0; bj < 2; ++bj) { const pg8::f32x4 a = acc[ai][bj][m][0], b = acc[ai][bj][m][1];
                        float s = (a[0] * a[0] + a[1] * a[1]) + (a[2] * a[2] + a[3] * a[3]) + (b[0] * b[0] + b[1] * b[1]) + (b[2] * b[2] + b[3] * b[3]);
                        s += __shfl_xor(s, 16); s += __shfl_xor(s, 32);
                        if (fq == 0) exch[((ai * 128 + wr * 64 + m * 16 + fr) * 2 + bj) * 4 + wc] = s; }
            asm volatile("s_waitcnt lgkmcnt(0)" ::: "memory"); __builtin_amdgcn_s_barrier(); asm volatile("" ::: "memory");
            const float scale = (colt >= C_DAK && colt < C_DAV) ? 1.f : QSCALE; const int go = wc * 32 + 8 * fq;
            f32x4 g0, g1;
            if (colt < C_DAK) { g0 = *(const f32x4*)(gq + go); g1 = *(const f32x4*)(gq + go + 4); }
            else if (colt < C_DAV) { g0 = *(const f32x4*)(gk + go); g1 = *(const f32x4*)(gk + go + 4); }
            else { g0 = *(const f32x4*)(gx + go); g1 = *(const f32x4*)(gx + go + 4); }
#pragma unroll
            for (int ai = 0; ai < 2; ++ai)
#pragma unroll
                for (int m = 0; m < 4; ++m)
#pragma unroll
                    for (int bj = 0; bj < 2; ++bj) { const f32x4 t = *(const LAS f32x4*)(exch + ((ai * 128 + wr * 64 + m * 16 + fr) * 2 + bj) * 4);
                        const float inv = (rsq_(((t[0] + t[1]) + (t[2] + t[3])) * (1.f / 128.f) + EPS)) * scale;
                        pg8::f32x4 a = acc[ai][bj][m][0], b = acc[ai][bj][m][1];
#pragma unroll
                        for (int e = 0; e < 4; ++e) { a[e] *= inv * g0[e]; b[e] *= inv * g1[e]; }
                        *(u32x4*)(proj + (size_t)(row0 + ai * 128 + m * 16) * NPROJ + col0 + bj * 128) = pack_v(a, b); }
        } else {
#pragma unroll
            for (int ai = 0; ai < 2; ++ai)
#pragma unroll
                for (int m = 0; m < 4; ++m)
#pragma unroll
                    for (int bj = 0; bj < 2; ++bj) { const int row = row0 + ai * 128 + m * 16, col = col0 + bj * 128;
                        if (col < NPROJ) { const u32x4 w = pack_v(acc[ai][bj][m][0], acc[ai][bj][m][1]); *(u32x4*)(proj + (size_t)row * NPROJ + col) = w;
                            if (col >= C_GDN && col < C_XAQ) { const int r64 = row & 63;
                                if (r64 < 2 || r64 >= 62) *(u32x4*)(halo + ((size_t)(row >> 6) * 4 + (r64 < 2 ? r64 : r64 - 60)) * 6144 + (col - C_GDN)) = w; } }
                        else if (col < NPROJ + 64) { float* p = ab + (size_t)row * 64 + (col - NPROJ); *(f32x4*)p = acc[ai][bj][m][0]; *(f32x4*)(p + 4) = acc[ai][bj][m][1]; } }
        }
    }
};
struct EpiMKV {
    static constexpr bool PERM = true, AFTER_DRAIN = false;
    bf16* O; const float* gk; LAS float* exch;
    __device__ __forceinline__ void operator()(const pg8::f32x4 (&acc)[2][2][4][2], const pg8::Unit& u, int wr, int wc, int fr, int fq) const {
        const int colt = u.pn * 256, row0 = u.pm * 256 + wr * 64 + fr, col0 = colt + wc * 32 + 8 * fq;
        const bool normed = colt < 512;
        if (normed) {
#pragma unroll
            for (int ai = 0; ai < 2; ++ai)
#pragma unroll
                for (int m = 0; m < 4; ++m)
#pragma unroll
                    for (int bj = 0; bj < 2; ++bj) { const pg8::f32x4 a = acc[ai][bj][m][0], b = acc[ai][bj][m][1];
                        float s = (a[0] * a[0] + a[1] * a[1]) + (a[2] * a[2] + a[3] * a[3]) + (b[0] * b[0] + b[1] * b[1]) + (b[2] * b[2] + b[3] * b[3]);
                        s += __shfl_xor(s, 16); s += __shfl_xor(s, 32);
                        if (fq == 0) exch[((ai * 128 + wr * 64 + m * 16 + fr) * 2 + bj) * 4 + wc] = s; }
            asm volatile("s_waitcnt lgkmcnt(0)" ::: "memory"); __builtin_amdgcn_s_barrier(); asm volatile("" ::: "memory");
        }
        const int go = wc * 32 + 8 * fq; const f32x4 g0 = *(const f32x4*)(gk + go), g1 = *(const f32x4*)(gk + go + 4);
#pragma unroll
        for (int ai = 0; ai < 2; ++ai)
#pragma unroll
            for (int m = 0; m < 4; ++m)
#pragma unroll
                for (int bj = 0; bj < 2; ++bj) { pg8::f32x4 a = acc[ai][bj][m][0], b = acc[ai][bj][m][1];
                    if (normed) { const f32x4 t = *(const LAS f32x4*)(exch + ((ai * 128 + wr * 64 + m * 16 + fr) * 2 + bj) * 4);
                        const float inv = rsq_(((t[0] + t[1]) + (t[2] + t[3])) * (1.f / 128.f) + EPS);
#pragma unroll
                        for (int e = 0; e < 4; ++e) { a[e] *= inv * g0[e]; b[e] *= inv * g1[e]; } }
                    *(u32x4*)(O + (size_t)(row0 + ai * 128 + m * 16) * 1024 + col0 + bj * 128) = pack_v(a, b); }
    }
};
template <class F> __device__ __forceinline__ void run_gemm(LAS unsigned char* lds, const bf16* A, const bf16* Bt, int M, int N, int K, const F& f) {
    pg8::Gemm g{A, Bt, M, N, K}; pg8::StaticOrder S; S.init(M, N, (int)gridDim.x, (int)blockIdx.x);
    pg8::EpiRow8<F> E{f};
#ifndef NO_GEMM
    pg8::gemm_phase<pg8::EpiRow8<F>, pg8::StaticOrder, true, true>(lds, g, S, E);
#endif
}
template <class F> __device__ __forceinline__ void run_gemm_l(LAS unsigned char* lds, const bf16* A, const bf16* Bt, int M, int N, int K, const F& f) {
    pg8::Gemm g{A, Bt, M, N, K}; pg8::StaticOrder S; S.init(M, N, (int)gridDim.x, (int)blockIdx.x);
    pg8::EpiRow8L<F> E{f};
#ifndef NO_GEMM
    pg8::gemm_phase<pg8::EpiRow8L<F>, pg8::StaticOrder, true, true>(lds, g, S, E);
#endif
}

namespace att {
constexpr int D = 128, NW = 8, QBLK = 32, KVBLK = 64;
constexpr int SHM_V = KVBLK * D * 2, SHM_K = KVBLK * D * 2, SHM_ATTN = 2 * SHM_V + 2 * SHM_K + NW * 64 * 4;
constexpr int OFF_STASH = SHM_ATTN, OFF_SSQ = OFF_STASH + 65536, ATT_LDS = OFF_SSQ + 1024;
constexpr float THR2 = 11.5f;
#define KSWZ(row, colB) ((row) * 256 + ((colB) ^ (((row) & 7) << 4)))
#define SBAR() __builtin_amdgcn_sched_barrier(0)
__device__ __forceinline__ int crow(int r, int hi) { return (r & 3) + 8 * (r >> 2) + 4 * hi; }
__device__ __forceinline__ unsigned cvtpk(float lo, float hi) { return pg8::cvt_pk_bf16(lo, hi); }

template <bool ALIBI>
__device__ __forceinline__ void partialSM(f32x16& p0, f32x16& p1, float& m_reg, float& mn, float& alpha, float dq, float slope2, int mode) {
  float b0 = 0.f, b1 = 0.f;
  if (ALIBI) {
    if (mode != 0) {
      const float sl = mode > 0 ? slope2 : -slope2;
#pragma unroll
      for (int r = 0; r < 16; ++r) { const float c = (float)((r & 3) + 8 * (r >> 2)); p0[r] = fmaf(sl, c, p0[r]); p1[r] = fmaf(sl, c, p1[r]); }
      b0 = -sl * dq; b1 = -sl * (dq - 32.f);
    } else {
#pragma unroll
      for (int r = 0; r < 16; ++r) { const float c = (float)((r & 3) + 8 * (r >> 2)); p0[r] = fmaf(-slope2, fabsf(dq - c), p0[r]); p1[r] = fmaf(-slope2, fabsf(dq - 32.f - c), p1[r]);
        if ((r & 3) == 3) SBAR(); }
    }
  }
  float pm0 = p0[0], pm1 = p1[0];
#pragma unroll
  for (int r = 1; r < 16; ++r) { pm0 = fmaxf(pm0, p0[r]); pm1 = fmaxf(pm1, p1[r]); }
  float pmax = fmaxf(pm0 + b0, pm1 + b1);
  { auto rr = __builtin_amdgcn_permlane32_swap(__float_as_uint(pmax), __float_as_uint(pmax), false, false);
    pmax = fmaxf(__uint_as_float(rr[0]), __uint_as_float(rr[1])); }
  if (__builtin_expect(__all(pmax - m_reg <= THR2), 1)) { mn = m_reg; alpha = 1.f; }
  else { mn = fmaxf(m_reg, pmax); alpha = __builtin_amdgcn_exp2f(m_reg - mn); m_reg = mn; }
  const float d0 = b0 - mn, d1 = b1 - mn;
#pragma unroll
  for (int r = 0; r < 16; ++r) p0[r] = p0[r] + d0;
#pragma unroll
  for (int r = 0; r < 16; ++r) p1[r] = p1[r] + d1;
#pragma unroll
  for (int r = 0; r < 16; ++r) p0[r] = __builtin_amdgcn_exp2f(p0[r]);
}
__device__ __forceinline__ void finishSM(f32x16& p0, f32x16& p1, float alpha, float& l_reg, bf16x8& pa0, bf16x8& pa1, bf16x8& pa2, bf16x8& pa3) {
#pragma unroll
  for (int r = 0; r < 16; ++r) p1[r] = __builtin_amdgcn_exp2f(p1[r]);
  float ps = 0;
#pragma unroll
  for (int r = 0; r < 16; ++r) ps += p0[r];
#pragma unroll
  for (int r = 0; r < 16; ++r) ps += p1[r];
  { auto rr = __builtin_amdgcn_permlane32_swap(__float_as_uint(ps), __float_as_uint(ps), false, false);
    ps = __uint_as_float(rr[0]) + __uint_as_float(rr[1]); }
  l_reg = l_reg * alpha + ps;
#define PK4(P, BASE, OUT) do { unsigned a0 = cvtpk(P[BASE + 0], P[BASE + 1]), a1 = cvtpk(P[BASE + 2], P[BASE + 3]);   \
    unsigned b0 = cvtpk(P[BASE + 4], P[BASE + 5]), b1 = cvtpk(P[BASE + 6], P[BASE + 7]);                              \
    auto r0 = __builtin_amdgcn_permlane32_swap(a0, b0, false, false); auto r1 = __builtin_amdgcn_permlane32_swap(a1, b1, false, false); \
    u32x4 w = {r0[0], r1[0], r0[1], r1[1]}; OUT = *reinterpret_cast<bf16x8*>(&w); } while (0)
  PK4(p0, 0, pa0); PK4(p0, 8, pa1); PK4(p1, 0, pa2); PK4(p1, 8, pa3);
#undef PK4
}
__device__ __forceinline__ void qkt(f32x16& p0, f32x16& p1, const bf16* Ks, const bf16x8* qr, int r32, int hi) {
  p0 = f32x16{}; p1 = f32x16{};
#pragma unroll
  for (int d0 = 0; d0 < 8; ++d0) { int cb = (d0 * 16 + hi * 8) * 2;
    bf16x8 b0 = *reinterpret_cast<const bf16x8*>((const char*)Ks + KSWZ(r32, cb));
    bf16x8 b1 = *reinterpret_cast<const bf16x8*>((const char*)Ks + KSWZ(32 + r32, cb));
    p0 = __builtin_amdgcn_mfma_f32_32x32x16_bf16(b0, qr[d0], p0, 0, 0, 0);
    p1 = __builtin_amdgcn_mfma_f32_32x32x16_bf16(b1, qr[d0], p1, 0, 0, 0); }
}
__device__ __forceinline__ int v_st(int k, int c) { const int kk = (k & ~0xC) | ((k & 4) << 1) | ((k & 8) >> 1); return ((kk >> 3) * 4 + (c >> 5)) * 512 + ((kk & 7) * 32 + (c & 31)) * 2; }
__device__ __forceinline__ int v_rd_base(int lane) { return ((lane & 3) << 3) | (((lane >> 2) & 3) << 6) | (((lane >> 4) & 1) << 5) | (((lane >> 5) & 1) << 8); }
constexpr int v_rd_off(int d0, int ks, int half) { return d0 * 512 + ks * 4096 + half * 2048; }
template <int OFF> __device__ __forceinline__ s16x4 tr_read(int vb) {
  s16x4 r; asm volatile("ds_read_b64_tr_b16 %0, %1 offset:%2" : "=&v"(r) : "v"(vb), "i"(OFF) : "memory"); return r;
}
template <int D0> __device__ __forceinline__ void pv_one(f32x16& od, int vb, bf16x8 pa0, bf16x8 pa1, bf16x8 pa2, bf16x8 pa3) {
  const s16x4 l0 = tr_read<v_rd_off(D0, 0, 0)>(vb), h0 = tr_read<v_rd_off(D0, 0, 1)>(vb), l1 = tr_read<v_rd_off(D0, 1, 0)>(vb), h1 = tr_read<v_rd_off(D0, 1, 1)>(vb);
  const s16x4 l2 = tr_read<v_rd_off(D0, 2, 0)>(vb), h2 = tr_read<v_rd_off(D0, 2, 1)>(vb), l3 = tr_read<v_rd_off(D0, 3, 0)>(vb), h3 = tr_read<v_rd_off(D0, 3, 1)>(vb);
  asm volatile("s_waitcnt lgkmcnt(0)" ::: "memory"); SBAR();
#define PK(L, H) (bf16x8){L[0], L[1], L[2], L[3], H[0], H[1], H[2], H[3]}
  od = __builtin_amdgcn_mfma_f32_32x32x16_bf16(pa0, PK(l0, h0), od, 0, 0, 0);
  od = __builtin_amdgcn_mfma_f32_32x32x16_bf16(pa1, PK(l1, h1), od, 0, 0, 0);
  od = __builtin_amdgcn_mfma_f32_32x32x16_bf16(pa2, PK(l2, h2), od, 0, 0, 0);
  od = __builtin_amdgcn_mfma_f32_32x32x16_bf16(pa3, PK(l3, h3), od, 0, 0, 0);
#undef PK
}
__device__ __forceinline__ void pv_d0(f32x16* o, int vb, bf16x8 pa0, bf16x8 pa1, bf16x8 pa2, bf16x8 pa3) {
  pv_one<0>(o[0], vb, pa0, pa1, pa2, pa3); pv_one<1>(o[1], vb, pa0, pa1, pa2, pa3); pv_one<2>(o[2], vb, pa0, pa1, pa2, pa3); pv_one<3>(o[3], vb, pa0, pa1, pa2, pa3);
}

template <bool ALIBI>
__device__ __forceinline__ void attn_core(const bf16* __restrict__ Qb, int ldq, const bf16* __restrict__ Kh, const bf16* __restrict__ Vh, int ldk, int jlo, int jhi, char* lds,
                                          float slope2, int qpos0, f32x16 (&o)[4]) {
  int tid_ = threadIdx.x; asm volatile("" : "+v"(tid_));
  const int tid = tid_, wid = tid >> 6, lane = tid & 63, r32 = lane & 31, hi = lane >> 5;
  bf16* V_lds = (bf16*)lds; bf16* K_lds = (bf16*)(lds + 2 * SHM_V);
  float* ws = (float*)(lds + 2 * SHM_V + 2 * SHM_K) + wid * 64; float* li_l = ws; float* al_l = ws + 32;
  float m_reg = -1e30f, l_reg = 0; bf16x8 qr[8];
#pragma unroll
  for (int d = 0; d < 4; ++d) o[d] = f32x16{};
  const bf16* Qw = Qb + (long)(wid * QBLK + r32) * ldq + hi * 8;
#pragma unroll
  for (int d0 = 0; d0 < 8; ++d0) qr[d0] = *reinterpret_cast<const bf16x8*>(Qw + d0 * 16);
  const float dq0 = (float)(qpos0 + wid * QBLK + r32 - 4 * hi);
  const int qmin_w = __builtin_amdgcn_readfirstlane(qpos0 + wid * QBLK);
#define AMODE(j) ((((j) * KVBLK + 63) <= qmin_w) ? 1 : ((((j) * KVBLK) >= qmin_w + 31) ? -1 : 0))
  const int sr = tid >> 4, sc = (tid & 15) * 8, vst0 = v_st(sr, sc), vst1 = v_st(32 + sr, sc);
  const int vb0 = (int)(uintptr_t)V_lds + v_rd_base(lane);
  struct { bf16x8 vs0, vs1, ks0, ks1; } sr_[1];
  const unsigned voff = (unsigned)(sr * ldk + sc) * 2u;
#define SLOAD(i, k0) do { const char* vt_ = (const char*)Vh + (size_t)(k0) * ldk * 2; const char* kt_ = (const char*)Kh + (size_t)(k0) * ldk * 2; const size_t h32_ = (size_t)32 * ldk * 2; \
    sr_[i].vs0 = *reinterpret_cast<const bf16x8*>(vt_ + voff); sr_[i].vs1 = *reinterpret_cast<const bf16x8*>(vt_ + h32_ + voff); \
    sr_[i].ks0 = *reinterpret_cast<const bf16x8*>(kt_ + voff); sr_[i].ks1 = *reinterpret_cast<const bf16x8*>(kt_ + h32_ + voff); } while (0)
#define SWRITE(b, i) do { *(bf16x8*)((char*)V_lds + (b) * SHM_V + vst0) = sr_[i].vs0;          \
    *(bf16x8*)((char*)V_lds + (b) * SHM_V + vst1) = sr_[i].vs1; int kc = sc * 2;               \
    *(bf16x8*)((char*)K_lds + (b) * SHM_K + KSWZ(sr, kc)) = sr_[i].ks0;                       \
    *(bf16x8*)((char*)K_lds + (b) * SHM_K + KSWZ(32 + sr, kc)) = sr_[i].ks1; } while (0)
#define SWAIT() asm volatile("s_waitcnt vmcnt(0)" ::: "memory")
#define RESC(a) do { if (__any((a) < 1.f)) { if (hi == 0) al_l[r32] = (a); asm volatile("s_waitcnt lgkmcnt(0)" ::: "memory"); \
    _Pragma("unroll") for (int d = 0; d < 4; ++d) _Pragma("unroll") for (int r = 0; r < 16; ++r) o[d][r] *= al_l[crow(r, hi)]; } } while (0)
#ifdef ATT_SIMPLE
  f32x16 p0, p1; float mn, al; bf16x8 pa0, pa1, pa2, pa3;
  SLOAD(0, jlo * KVBLK); asm volatile("s_waitcnt vmcnt(0)" ::: "memory"); SWRITE(0, 0); __syncthreads();
#pragma unroll 1
  for (int j = jlo; j < jhi; ++j) {
    const int bsel = (j - jlo) & 1;
    if (j + 1 < jhi) SLOAD(0, (j + 1) * KVBLK);
    SBAR(); qkt(p0, p1, (bf16*)((char*)K_lds + bsel * SHM_K), qr, r32, hi);
    partialSM<ALIBI>(p0, p1, m_reg, mn, al, dq0 - (float)(j * KVBLK), slope2, AMODE(j));
    finishSM(p0, p1, al, l_reg, pa0, pa1, pa2, pa3);
    RESC(al); SBAR();
    pv_d0(o, vb0 + bsel * (int)SHM_V, pa0, pa1, pa2, pa3);
    if (j + 1 < jhi) { SWAIT(); SWRITE(bsel ^ 1, 0); }
    __syncthreads();
  }
#else
  f32x16 pA0, pA1, pB0, pB1; float mnA, mnB, alA, alB; bf16x8 pa0, pa1, pa2, pa3;
  SLOAD(0, jlo * KVBLK); asm volatile("s_waitcnt vmcnt(0)" ::: "memory"); SWRITE(0, 0); __syncthreads();
  qkt(pA0, pA1, K_lds, qr, r32, hi); partialSM<ALIBI>(pA0, pA1, m_reg, mnA, alA, dq0 - (float)(jlo * KVBLK), slope2, AMODE(jlo));
  SLOAD(0, (jlo + 1) * KVBLK);
  SWAIT(); SWRITE(1, 0); __syncthreads();
#pragma unroll 1
  for (int j = jlo + 1; j + 1 < jhi; j += 2) {
    SBAR(); qkt(pB0, pB1, (bf16*)((char*)K_lds + SHM_K), qr, r32, hi);
    finishSM(pA0, pA1, alA, l_reg, pa0, pa1, pa2, pa3); SBAR();
    SLOAD(0, (j + 1) * KVBLK); SBAR();
    pv_d0(o, vb0, pa0, pa1, pa2, pa3); partialSM<ALIBI>(pB0, pB1, m_reg, mnB, alB, dq0 - (float)(j * KVBLK), slope2, AMODE(j));
    __syncthreads(); SWAIT(); SWRITE(0, 0);
    RESC(alB); __syncthreads();
    SBAR(); qkt(pA0, pA1, K_lds, qr, r32, hi);
    finishSM(pB0, pB1, alB, l_reg, pa0, pa1, pa2, pa3); SBAR();
    SLOAD(0, (j + 2) * KVBLK); SBAR();
    pv_d0(o, vb0 + (int)SHM_V, pa0, pa1, pa2, pa3); partialSM<ALIBI>(pA0, pA1, m_reg, mnA, alA, dq0 - (float)((j + 1) * KVBLK), slope2, AMODE(j + 1));
    __syncthreads(); SWAIT(); SWRITE(1, 0);
    RESC(alA); __syncthreads();
  }
  SBAR(); qkt(pB0, pB1, (bf16*)((char*)K_lds + SHM_K), qr, r32, hi);
  finishSM(pA0, pA1, alA, l_reg, pa0, pa1, pa2, pa3); SBAR();
  pv_d0(o, vb0, pa0, pa1, pa2, pa3); partialSM<ALIBI>(pB0, pB1, m_reg, mnB, alB, dq0 - (float)((jhi - 1) * KVBLK), slope2, AMODE(jhi - 1));
  __syncthreads(); RESC(alB);
  finishSM(pB0, pB1, alB, l_reg, pa0, pa1, pa2, pa3); SBAR();
  pv_d0(o, vb0 + (int)SHM_V, pa0, pa1, pa2, pa3);
  __syncthreads();
#endif
  if (hi == 0) li_l[r32] = l_reg; asm volatile("s_waitcnt lgkmcnt(0)" ::: "memory");
#pragma unroll
  for (int r = 0; r < 16; ++r) { const float rl = __builtin_amdgcn_rcpf(li_l[crow(r, hi)]);
#pragma unroll
    for (int d = 0; d < 4; ++d) o[d][r] *= rl; }
#undef AMODE
#undef SLOAD
#undef SWRITE
#undef SWAIT
#undef RESC
}
}

namespace gdn {
constexpr int SA = 272, SB = 144;
constexpr int OFF_X0 = 0, OFF_X1 = 17408, OFF_KBG = 34816, OFF_VBT = 53248, OFF_QD = 71680, OFF_QKM = 89088, OFF_KDT = 98304, OFF_ST = 116736, OFF_SM = 151552, OFF_Y = 154112, GDN_LDS = OFF_Y + 4096;
constexpr int SMB = 1280;
using att::crow;
template <int KS> __device__ __forceinline__ void tile_mma(f32x16& acc, const LAS char* A, int sa, int ra, const LAS char* B, int sb, int rb, int r32, int hi) {
    const LAS char* ap = A + (ra + r32) * sa + hi * 16; const LAS char* bp = B + (rb + r32) * sb + hi * 16;
#pragma unroll
    for (int ks = 0; ks < KS; ++ks) { const bf16x8 a = *(const LAS bf16x8*)(ap + ks * 32), b = *(const LAS bf16x8*)(bp + ks * 32); acc = __builtin_amdgcn_mfma_f32_32x32x16_bf16(a, b, acc, 0, 0, 0); }
}
typedef float f32x2_ __attribute__((ext_vector_type(2)));
__device__ __forceinline__ void st_bf16(LAS char* p, float v) { *(LAS unsigned short*)p = (unsigned short)f2bf(v); }
__device__ __forceinline__ float bfsel(const u32x4& w, int e) { const unsigned x = (e < 2) ? w.x : (e < 4) ? w.y : (e < 6) ? w.z : w.w; return (e & 1) ? bfhi(x) : bflo(x); }

__device__ __forceinline__ void chunk_scalars(float bl, float a, float Aexp, float dtb, LAS float* sm, int lane) {
    const float xx = a + dtb; const float sp = xx > 20.f ? xx : log1pf(__expf(xx));
    float v = -Aexp * sp;
#pragma unroll
    for (int o = 1; o < 64; o <<= 1) { const float n = __shfl_up(v, o); if (lane >= o) v += n; }
    const float gl = __shfl(v, 63);
    sm[lane] = v; sm[64 + lane] = sigmoidf_(bl); sm[128 + lane] = __expf(v); sm[192 + lane] = __expf(gl - v); if (lane == 0) sm[256] = __expf(gl);
}
#define GDN_LOADAB(cc, ln, BL, AA) do { const int t_ = (cc) * 64 + (dir ? 63 - (ln) : (ln)); const float* abr_ = AB + (size_t)(sb + t_) * 64; BL = abr_[dir * 16 + h]; AA = abr_[32 + dir * 16 + h]; } while (0)

template <int DIRT> __device__ __forceinline__ void gdn_unit(const float* A_log, const float* dt_bias, int S, int sb, int h, const bf16* proj, const float* AB, bf16* outp, LAS char* L) {
    constexpr int dir = DIRT;
    int tid_ = threadIdx.x; asm volatile("" : "+v"(tid_));
    const float Aexp = __expf(A_log[dir * 16 + h]), dtb = dt_bias[dir * 16 + h];
    const int N = S / 64;
    const int cgp = tid_ % 48, run = tid_ / 48, part = cgp >> 4, c0 = (cgp & 15) * 8, ccol = part * 2048 + h * 128 + c0;
    const bool convt = tid_ < 384;
    u32x4 raw[8];
#define GDN_LOADRAW(cc, tsrc) do { if (convt) { const unsigned voff_ = ((unsigned)((tsrc) / 48) * 8u * (unsigned)NPROJ + (unsigned)(((tsrc) % 48) >> 4) * 2048u + (unsigned)(((tsrc) % 48) & 15) * 8u) * 2u; \
        _Pragma("unroll") for (int k_ = 0; k_ < 8; ++k_) { const char* rb_ = (const char*)proj + ((size_t)(sb + (cc) * 64 + k_) * NPROJ + C_GDN + h * 128) * 2; \
            raw[k_] = *(const u32x4*)(rb_ + voff_); } } } while (0)
    GDN_LOADRAW(dir ? N - 1 : 0, tid_);
    f32x16 st[2]; st[0] = f32x16{}; st[1] = f32x16{};
    for (int i = tid_; i < 34816 / 4; i += NTHR) ((LAS unsigned*)(L + OFF_ST))[i] = 0u;
    float ab_bl = 0.f, ab_a = 0.f;
    if ((tid_ >> 6) == 7) { GDN_LOADAB(dir ? N - 1 : 0, tid_ & 63, ab_bl, ab_a); chunk_scalars(ab_bl, ab_a, Aexp, dtb, (LAS float*)(L + OFF_SM), tid_ & 63); }
    __syncthreads();
#pragma unroll 1
    for (int ci = 0; ci < N; ++ci) {
        const int c = dir ? N - 1 - ci : ci;
        int tq = tid_; asm volatile("" : "+v"(tq));
        const int tid = tq, wid = __builtin_amdgcn_readfirstlane(tid >> 6), lane = tid & 63, r32 = lane & 31, hi = lane >> 5;
        LAS float* gcs = (LAS float*)(L + OFF_SM + (ci & 1) * SMB); LAS float* bet = gcs + 64; LAS float* eg = gcs + 128; LAS float* ekd = gcs + 192;
        if (wid == 7 && ci + 1 < N) GDN_LOADAB(dir ? c - 1 : c + 1, lane, ab_bl, ab_a);
        if (convt) {
            asm volatile("s_waitcnt vmcnt(0)" ::: "memory");
            float y[8][8];
#pragma unroll
            for (int rr = 0; rr < 8; ++rr) unpack8(raw[rr], y[rr]);
            u32x4 rawc[8];
#pragma unroll
            for (int rr = 0; rr < 8; ++rr) rawc[rr] = raw[rr];
            if (ci + 1 < N) GDN_LOADRAW(dir ? c - 1 : c + 1, tid);
            const int i0 = dir ? 56 - run * 8 : run * 8;
            float bi[8], egi[8], eki[8];
            { const f32x4 a0 = *(const LAS f32x4*)(bet + i0), a1 = *(const LAS f32x4*)(bet + i0 + 4), b0 = *(const LAS f32x4*)(eg + i0), b1 = *(const LAS f32x4*)(eg + i0 + 4), c0v = *(const LAS f32x4*)(ekd + i0), c1v = *(const LAS f32x4*)(ekd + i0 + 4);
#pragma unroll
              for (int p = 0; p < 4; ++p) { bi[p] = a0[p]; bi[4 + p] = a1[p]; egi[p] = b0[p]; egi[4 + p] = b1[p]; eki[p] = c0v[p]; eki[4 + p] = c1v[p]; } }
#define GDN_PK8(v) (u32x4){pg8::cvt_pk_bf16((v)[0], (v)[1]), pg8::cvt_pk_bf16((v)[2], (v)[3]), pg8::cvt_pk_bf16((v)[4], (v)[5]), pg8::cvt_pk_bf16((v)[6], (v)[7])}
            if (part == 0) {
#pragma unroll
                for (int rr = 0; rr < 8; ++rr) { const int p = dir ? 7 - rr : rr, i = i0 + p; float qd[8];
#pragma unroll
                    for (int e = 0; e < 8; ++e) qd[e] = y[rr][e] * egi[p];
                    *(LAS u32x4*)(L + OFF_X0 + i * SA + c0 * 2) = rawc[rr]; *(LAS u32x4*)(L + OFF_QD + i * SA + c0 * 2) = GDN_PK8(qd); }
            } else if (part == 1) {
#pragma unroll
                for (int rr = 0; rr < 8; ++rr) { const int p = dir ? 7 - rr : rr, i = i0 + p; *(LAS u32x4*)(L + OFF_X1 + i * SA + c0 * 2) = rawc[rr]; }
#pragma unroll
                for (int e = 0; e < 8; ++e) { float kb[8], kd[8];
#pragma unroll
                    for (int p = 0; p < 8; ++p) { const int rr = dir ? 7 - p : p; kb[p] = y[rr][e] * (bi[p] * egi[p]); kd[p] = y[rr][e] * eki[p]; }
                    *(LAS u32x4*)(L + OFF_KBG + (c0 + e) * SB + i0 * 2) = GDN_PK8(kb); *(LAS u32x4*)(L + OFF_KDT + (c0 + e) * SB + i0 * 2) = GDN_PK8(kd); }
            } else {
#pragma unroll
                for (int e = 0; e < 8; ++e) { float vb[8];
#pragma unroll
                    for (int p = 0; p < 8; ++p) { const int rr = dir ? 7 - p : p; vb[p] = y[rr][e] * bi[p]; }
                    *(LAS u32x4*)(L + OFF_VBT + (c0 + e) * SB + i0 * 2) = GDN_PK8(vb); }
            }
        }
        __syncthreads();
        {
            f32x16 acc = f32x16{};
            const int w4 = wid & 3, ma = w4 >> 1, nb = w4 & 1;
            if (wid < 4) { if (!(ma == 0 && nb == 1)) tile_mma<8>(acc, L + OFF_X1, SA, 32 * ma, L + OFF_X1, SA, 32 * nb, r32, hi); }
            else         { if (!(ma == 1 && nb == 0)) tile_mma<8>(acc, L + OFF_X1, SA, 32 * ma, L + OFF_X0, SA, 32 * nb, r32, hi); }
            __syncthreads();
            if (wid < 4) {
                if (!(ma == 0 && nb == 1)) {
                    const int j = 32 * nb + r32; const float gj = gcs[j];
#pragma unroll
                    for (int r = 0; r < 16; ++r) { const int i = 32 * ma + crow(r, hi); const float v = (i > j) ? bet[i] * acc[r] * __expf(gcs[i] - gj) : 0.f; *(LAS float*)(L + OFF_X1 + (i * 68 + j) * 4) = v; }
                }
            } else {
                const int i = 32 * nb + r32; const float gi = gcs[i];
#pragma unroll
                for (int r4 = 0; r4 < 4; ++r4) { float v[4];
#pragma unroll
                    for (int e = 0; e < 4; ++e) { const int j = 32 * ma + 8 * r4 + 4 * hi + e; v[e] = (i >= j) ? acc[4 * r4 + e] * __expf(gi - gcs[j]) : 0.f; }
                    u32x2 w; w.x = pk2(v[0], v[1]); w.y = pk2(v[2], v[3]); *(LAS u32x2*)(L + OFF_QKM + i * SB + (32 * ma + 8 * r4 + 4 * hi) * 2) = w; }
            }
        }
        __syncthreads();
        {
            const LAS float* Lf = (const LAS float*)(L + OFF_X1); LAS float* Tf = (LAS float*)(L + OFF_X0); LAS float* Yf = (LAS float*)(L + OFF_Y);
            if (tid < 64) { const int b = tid >> 4, cc = tid & 15; const LAS float* Lb = Lf + (16 * b) * 68 + 16 * b; float x[16];
#pragma unroll
                for (int i = 0; i < 16; ++i) { float s = (i == cc) ? 1.f : 0.f;
#pragma unroll
                    for (int j = 0; j < i; ++j) s = fmaf(-Lb[i * 68 + j], x[j], s);
                    x[i] = s; }
#pragma unroll
                for (int i = 0; i < 16; ++i) Tf[(16 * b + i) * 68 + 16 * b + cc] = x[i]; }
            if (wid == 7 && ci + 1 < N) chunk_scalars(ab_bl, ab_a, Aexp, dtb, (LAS float*)(L + OFF_SM + ((ci + 1) & 1) * SMB), lane);
            __syncthreads();
            { const int pr = tid >> 8, i = (tid >> 4) & 15, j = tid & 15, a = 2 * pr, b = 2 * pr + 1; float y = 0.f;
#pragma unroll
              for (int k = 0; k < 16; ++k) y = fmaf(Lf[(16 * b + i) * 68 + 16 * a + k], Tf[(16 * a + k) * 68 + 16 * a + j], y);
              Yf[tid] = y; __syncthreads();
              float z = 0.f;
#pragma unroll
              for (int k = 0; k < 16; ++k) z = fmaf(-Tf[(16 * b + i) * 68 + 16 * b + k], Yf[(pr * 16 + k) * 16 + j], z);
              Tf[(16 * b + i) * 68 + 16 * a + j] = z; Tf[(16 * a + i) * 68 + 16 * b + j] = 0.f; }
            __syncthreads();
            { const int i = tid >> 4, j0 = (tid & 15) * 2; float y0 = 0.f, y1 = 0.f;
#pragma unroll
              for (int k4 = 0; k4 < 8; ++k4) { const f32x4 l = *(const LAS f32x4*)(Lf + (32 + i) * 68 + 4 * k4);
#pragma unroll
                  for (int e = 0; e < 4; ++e) { const f32x2_ t = *(const LAS f32x2_*)(Tf + (4 * k4 + e) * 68 + j0); y0 = fmaf(l[e], t.x, y0); y1 = fmaf(l[e], t.y, y1); } }
              *(LAS f32x2_*)(Yf + i * 32 + j0) = (f32x2_){y0, y1}; __syncthreads();
              float z0 = 0.f, z1 = 0.f;
#pragma unroll
              for (int k4 = 0; k4 < 8; ++k4) { const f32x4 tb = *(const LAS f32x4*)(Tf + (32 + i) * 68 + 32 + 4 * k4);
#pragma unroll
                  for (int e = 0; e < 4; ++e) { const f32x2_ yv = *(const LAS f32x2_*)(Yf + (4 * k4 + e) * 32 + j0); z0 = fmaf(-tb[e], yv.x, z0); z1 = fmaf(-tb[e], yv.y, z1); } }
              *(LAS f32x2_*)(Tf + (32 + i) * 68 + j0) = (f32x2_){z0, z1}; }
            __syncthreads();
            { const int i = tid >> 3, j0 = (tid & 7) * 8; float v[8];
#pragma unroll
              for (int e = 0; e < 8; ++e) { const int j = j0 + e; v[e] = (j <= i) ? Tf[i * 68 + j] : 0.f; }
              *(LAS u32x4*)(L + OFF_X1 + i * SB + j0 * 2) = pack8(v); }
        }
        __syncthreads();
        const int mi = wid >> 2, ni = wid & 3;
        f32x16 accU = f32x16{};
        tile_mma<4>(accU, L + OFF_X1, SB, 32 * mi, L + OFF_VBT, SB, 32 * ni, r32, hi);
        { f32x16 accW = f32x16{};
          tile_mma<4>(accW, L + OFF_KBG, SB, 32 * ni, L + OFF_X1, SB, 32 * mi, r32, hi);
          const int tok = 32 * mi + r32;
#pragma unroll
          for (int r4 = 0; r4 < 4; ++r4) { u32x2 w; w.x = pk2(accW[4 * r4], accW[4 * r4 + 1]); w.y = pk2(accW[4 * r4 + 2], accW[4 * r4 + 3]);
              *(LAS u32x2*)(L + OFF_X0 + tok * SA + (32 * ni + 8 * r4 + 4 * hi) * 2) = w; } }
        __syncthreads();
        {
            f32x16 accV = f32x16{}, accO = f32x16{};
            {
                const LAS char* wp = L + OFF_X0 + (32 * mi + r32) * SA + hi * 16; const LAS char* qp = L + OFF_QD + (32 * mi + r32) * SA + hi * 16; const LAS char* sp = L + OFF_ST + (32 * ni + r32) * SA + hi * 16;
#pragma unroll
                for (int ks = 0; ks < 8; ++ks) { const bf16x8 b = *(const LAS bf16x8*)(sp + ks * 32), aw = *(const LAS bf16x8*)(wp + ks * 32), aq = *(const LAS bf16x8*)(qp + ks * 32);
                    accV = __builtin_amdgcn_mfma_f32_32x32x16_bf16(aw, b, accV, 0, 0, 0); accO = __builtin_amdgcn_mfma_f32_32x32x16_bf16(aq, b, accO, 0, 0, 0); }
            }
            const int dv = 32 * ni + r32;
#pragma unroll
            for (int r4 = 0; r4 < 4; ++r4) { u32x2 w; w.x = pk2(accU[4 * r4] - accV[4 * r4], accU[4 * r4 + 1] - accV[4 * r4 + 1]); w.y = pk2(accU[4 * r4 + 2] - accV[4 * r4 + 2], accU[4 * r4 + 3] - accV[4 * r4 + 3]);
                *(LAS u32x2*)(L + OFF_VBT + dv * SB + (32 * mi + 8 * r4 + 4 * hi) * 2) = w; }
            __syncthreads();
            tile_mma<4>(accO, L + OFF_QKM, SB, 32 * mi, L + OFF_VBT, SB, 32 * ni, r32, hi);
#pragma unroll
            for (int r = 0; r < 16; ++r) { const int tok = 32 * mi + crow(r, hi); const int t = c * 64 + (dir ? 63 - tok : tok);
                outp[(size_t)(sb + t) * DM + h * 128 + dv] = (bf16)f2bf(accO[r]); }
            const float egl = gcs[256]; const int mi2 = wid & 3;
#pragma unroll
            for (int xx = 0; xx < 2; ++xx) { const int ni2 = (wid >> 2) * 2 + xx;
#pragma unroll
                for (int r = 0; r < 16; ++r) st[xx][r] *= egl;
                tile_mma<4>(st[xx], L + OFF_KDT, SB, 32 * mi2, L + OFF_VBT, SB, 32 * ni2, r32, hi);
                const int dv2 = 32 * ni2 + r32;
#pragma unroll
                for (int r4 = 0; r4 < 4; ++r4) { u32x2 w; w.x = pk2(st[xx][4 * r4], st[xx][4 * r4 + 1]); w.y = pk2(st[xx][4 * r4 + 2], st[xx][4 * r4 + 3]);
                    *(LAS u32x2*)(L + OFF_ST + dv2 * SA + (32 * mi2 + 8 * r4 + 4 * hi) * 2) = w; }
            }
        }
        __syncthreads();
    }
#undef GDN_LOADRAW
#undef GDN_LOADAB
}
}

__device__ __forceinline__ void diffattn_unit(const float* da_lambda, const float* gqn, const float* gkn, int S, int sb, int h, int qb, int vh, const bf16* proj, bf16* aout, float* ssqg, char* lds) {
    using namespace att;
    int tid_ = threadIdx.x; asm volatile("" : "+v"(tid_));
    const int tid = tid_, wid = tid >> 6, lane = tid & 63;
    const int t0 = sb + qb * 256;
    const float slope2 = exp2f(-(float)(h + 1)) * LOG2E;
    int jlo, jhi;
    { float gq = fmaxf(fabsf(gqn[lane]), fabsf(gqn[64 + lane])), gk = fmaxf(fabsf(gkn[lane]), fabsf(gkn[64 + lane]));
#pragma unroll
      for (int o_ = 1; o_ < 64; o_ <<= 1) { gq = fmaxf(gq, __shfl_xor(gq, o_)); gk = fmaxf(gk, __shfl_xor(gk, o_)); }
      const float smax2 = 11.313708499f * gq * gk * LOG2E * 1.02f;
      const float Wf = fminf((2.f * smax2 + 40.f) / slope2, 1.0e6f); const int W = __builtin_amdgcn_readfirstlane((int)Wf + 1), q0 = qb * 256;
      const int lo = q0 - W, hi_ = q0 + 255 + W, NT = S / 64;
      jlo = lo > 0 ? (lo >> 6) : 0; jhi = (hi_ >> 6) + 1; jhi = jhi < NT ? jhi : NT;
      if ((jhi - jlo) & 1) { if (jlo > 0) --jlo; else ++jhi; } }
    unsigned* stash = (unsigned*)(lds + OFF_STASH);
#pragma unroll 1
    for (int map = 0; map < 2; ++map) {
        f32x16 o[4];
        attn_core<true>(proj + (size_t)t0 * NPROJ + C_DAQ + (h * 2 + map) * 128, NPROJ, proj + (size_t)sb * NPROJ + C_DAK + (h * 2 + map) * 128,
                        proj + (size_t)sb * NPROJ + C_DAV + h * 256 + vh * 128, NPROJ, jlo, jhi, lds, slope2, qb * 256, o);
        if (map == 0) {
#pragma unroll
            for (int d = 0; d < 4; ++d)
#pragma unroll
                for (int r2 = 0; r2 < 8; ++r2) stash[(d * 8 + r2) * NTHR + tid] = pk2(o[d][2 * r2], o[d][2 * r2 + 1]);
        } else {
            float lam;
            { const float* lp = da_lambda; const float s1 = wave_sum(lp[lane] * lp[128 + lane] + lp[64 + lane] * lp[192 + lane]), s2 = wave_sum(lp[256 + lane] * lp[384 + lane] + lp[320 + lane] * lp[448 + lane]);
              lam = __expf(s1) - __expf(s2) + 0.2f; }
            float ss[16];
#pragma unroll
            for (int r = 0; r < 16; ++r) ss[r] = 0.f;
#pragma unroll
            for (int d = 0; d < 4; ++d)
#pragma unroll
                for (int r2 = 0; r2 < 8; ++r2) { const unsigned w = stash[(d * 8 + r2) * NTHR + tid];
                    const float a = bflo(w) - lam * o[d][2 * r2], b = bfhi(w) - lam * o[d][2 * r2 + 1]; o[d][2 * r2] = a; o[d][2 * r2 + 1] = b; ss[2 * r2] += a * a; ss[2 * r2 + 1] += b * b; }
#pragma unroll
            for (int r = 0; r < 16; ++r) { float s = ss[r]; s += __shfl_xor(s, 1); s += __shfl_xor(s, 2); s += __shfl_xor(s, 4); s += __shfl_xor(s, 8); s += __shfl_xor(s, 16); ss[r] = s; }
            int lz = lane; asm volatile("" : "+v"(lz));
            const int r32 = lz & 31, hi = lz >> 5;
            bf16* orow = aout + (size_t)(t0 + wid * 32) * DM + h * 256 + vh * 128 + r32;
            if (r32 == 0) {
#pragma unroll
                for (int r = 0; r < 16; ++r) ssqg[(size_t)(t0 + wid * 32 + crow(r, hi)) * 16 + h * 2 + vh] = ss[r]; }
#pragma unroll
            for (int r = 0; r < 16; ++r)
#pragma unroll
                for (int d = 0; d < 4; ++d) orow[(size_t)crow(r, hi) * DM + d * 32] = (bf16)f2bf(o[d][r]);
        }
        __syncthreads();
    }
}
__device__ __forceinline__ void xattn_unit(int sb, int bl, int xh, int qb, const bf16* proj, const bf16* memkv, bf16* cout, char* lds) {
    using namespace att;
    int tid_ = threadIdx.x; asm volatile("" : "+v"(tid_));
    const int tid = tid_, wid = tid >> 6, lane = tid & 63, r32 = lane & 31, hi = lane >> 5;
    const int t0 = sb + qb * 256;
    f32x16 o[4];
    attn_core<false>(proj + (size_t)t0 * NPROJ + C_XAQ + xh * 128, NPROJ, memkv + (size_t)bl * 256 * 1024 + xh * 128, memkv + (size_t)bl * 256 * 1024 + 512 + xh * 128, 1024, 0, 4, lds, 0.f, 0, o);
    bf16* orow = cout + (size_t)(t0 + wid * 32) * 512 + xh * 128 + r32;
#pragma unroll
    for (int r = 0; r < 16; ++r)
#pragma unroll
        for (int d = 0; d < 4; ++d) orow[(size_t)crow(r, hi) * 512 + d * 32] = (bf16)f2bf(o[d][r]);
}

__device__ __forceinline__ void seg_norm_fin(bf16* p, u32x4 raw, const float* gain, float scale, int l16) {
    float v[8]; unpack8(raw, v);
    float ss = 0.f;
#pragma unroll
    for (int e = 0; e < 8; ++e) ss += v[e] * v[e];
    ss += __shfl_xor(ss, 1); ss += __shfl_xor(ss, 2); ss += __shfl_xor(ss, 4); ss += __shfl_xor(ss, 8);
    const float inv = (rsq_(ss * (1.f / 128.f) + EPS)) * scale;
    const f32x4 g0 = *(const f32x4*)(gain + l16 * 8), g1 = *(const f32x4*)(gain + l16 * 8 + 4);
#pragma unroll
    for (int e = 0; e < 4; ++e) { v[e] *= inv * g0[e]; v[4 + e] *= inv * g1[e]; }
    *(u32x4*)(p + l16 * 8) = pack8(v);
}
__device__ __forceinline__ void seg_norm(bf16* p, const float* gain, float scale, int l16) { seg_norm_fin(p, *(const u32x4*)(p + l16 * 8), gain, scale, l16); }

__device__ __forceinline__ void gdn_conv_item(bf16* proj, const bf16* halo, const float* conv_w, int S, int c, int cg, int l16dummy) {
    (void)l16dummy;
    const int part = cg >> 8, col = cg * 8;
    const int s0 = (c * 64) & (S - 1);
    f32x4 wc[5][2];
#pragma unroll
    for (int j = 0; j < 5; ++j) { wc[j][0] = *(const f32x4*)(conv_w + j * 6144 + col); wc[j][1] = *(const f32x4*)(conv_w + j * 6144 + col + 4); }
    bf16* base = proj + (size_t)c * 64 * NPROJ + C_GDN + col;
    const u32x4 zero4 = (u32x4){0u, 0u, 0u, 0u};
    u32x4 raw[12];
    raw[0] = (s0 == 0) ? zero4 : *(const u32x4*)(halo + ((size_t)(c - 1) * 4 + 2) * 6144 + col);
    raw[1] = (s0 == 0) ? zero4 : *(const u32x4*)(halo + ((size_t)(c - 1) * 4 + 3) * 6144 + col);
    raw[2] = *(const u32x4*)(base); raw[3] = *(const u32x4*)(base + NPROJ);
#define GCI_LOAD(bb) do { _Pragma("unroll") for (int k = 0; k < 8; ++k) { const int r = 8 * (bb) + 2 + k;         \
            raw[4 + k] = (r < 64) ? *(const u32x4*)(base + (size_t)r * NPROJ) : ((s0 + 64 == S) ? zero4 : *(const u32x4*)(halo + ((size_t)(c + 1) * 4 + (r - 64)) * 6144 + col)); } } while (0)
    GCI_LOAD(0);
#pragma unroll 1
    for (int b = 0; b < 8; ++b) {
        float y[8][8];
#pragma unroll
        for (int e = 0; e < 8; ++e) { float xr[12];
#pragma unroll
            for (int k = 0; k < 12; ++k) xr[k] = gdn::bfsel(raw[k], e);
#pragma unroll
            for (int rr = 0; rr < 8; ++rr) { float s = 0.f;
#pragma unroll
                for (int j = 0; j < 5; ++j) s = fmaf(wc[j][e >> 2][e & 3], xr[rr + j], s);
                y[rr][e] = s * sigmoidf_(s); } }
        raw[0] = raw[8]; raw[1] = raw[9]; raw[2] = raw[10]; raw[3] = raw[11];
        if (b < 7) GCI_LOAD(b + 1);
#pragma unroll
        for (int rr = 0; rr < 8; ++rr) { float sc = 1.f;
            if (part < 2) { float ss = 0.f;
#pragma unroll
                for (int e = 0; e < 8; ++e) ss += y[rr][e] * y[rr][e];
                ss += __shfl_xor(ss, 1); ss += __shfl_xor(ss, 2); ss += __shfl_xor(ss, 4); ss += __shfl_xor(ss, 8);
                sc = (rsq_(ss + EPS)) * (part == 0 ? 0.08838834764831845f : 1.f); }
            u32x4 w; w.x = pg8::cvt_pk_bf16(y[rr][0] * sc, y[rr][1] * sc); w.y = pg8::cvt_pk_bf16(y[rr][2] * sc, y[rr][3] * sc); w.z = pg8::cvt_pk_bf16(y[rr][4] * sc, y[rr][5] * sc); w.w = pg8::cvt_pk_bf16(y[rr][6] * sc, y[rr][7] * sc);
            *(u32x4*)(base + (size_t)(8 * b + rr) * NPROJ) = w; }
    }
#undef GCI_LOAD
}


#define XB_TMO      128
#define XB_XCNT(j)  (256  + 64 * (j))
#define XB_XSUB(j)  (1280 + 64 * (j))
#define XB_XGEN(j)  (2304 + 64 * (j))
#define XB_TOP      3328
#define XB_TOPGEN   3392
#define XCD_BAR_WORDS 3456
#define XB_SPIN_CAP (1u << 18)

__device__ __forceinline__ unsigned xb_ld(unsigned* p)              { return __hip_atomic_load(p, __ATOMIC_RELAXED, __HIP_MEMORY_SCOPE_AGENT); }
__device__ __forceinline__ unsigned xb_add(unsigned* p, unsigned v) { return __hip_atomic_fetch_add(p, v, __ATOMIC_RELAXED, __HIP_MEMORY_SCOPE_AGENT); }
__device__ __forceinline__ unsigned xb_xcc_id() { return (unsigned)__builtin_amdgcn_s_getreg((3 << 11) | 20) & 0xFu; }
#define XB_SPIN(cond, bar) do { unsigned _sp = 0; while (cond) { __builtin_amdgcn_s_sleep(1); \
    if ((++_sp & 255u) == 0u) { if (xb_ld(&(bar)[XB_TMO])) break; if (_sp > XB_SPIN_CAP) { atomicAdd(&(bar)[XB_TMO], 1u); break; } } } } while (0)

struct XcdBarrier {
    unsigned* bar; unsigned x;
    volatile LAS unsigned* st;
};

__device__ __forceinline__ XcdBarrier xcd_barrier_post(unsigned* bar, volatile LAS unsigned* st) {
    XcdBarrier b; b.bar = bar; b.x = xb_xcc_id(); b.st = st;
    if (threadIdx.x == 0) (void)xb_add(&bar[XB_XCNT(b.x)], 1u);
    return b;
}
__device__ __forceinline__ void xcd_barrier_complete(unsigned* bar, unsigned x, unsigned& nloc, unsigned& nx) {
    const unsigned G = gridDim.x * gridDim.y * gridDim.z;
    unsigned sum, cnt, mine, sp = 0u;
    for (;;) {
        sum = 0u; cnt = 0u; mine = 0u;
#pragma unroll
        for (unsigned j = 0; j < 16; ++j) { const unsigned c = xb_ld(&bar[XB_XCNT(j)]); sum += c; cnt += (c > 0u) ? 1u : 0u; mine = (j == x) ? c : mine; }
        if (sum == G) break;
        __builtin_amdgcn_s_sleep(1);
        if ((++sp & 255u) == 0u) { if (xb_ld(&bar[XB_TMO])) break; if (sp > XB_SPIN_CAP) { atomicAdd(&bar[XB_TMO], 1u); break; } }
    }
    nloc = mine > 0u ? mine : 1u; nx = cnt > 0u ? cnt : 1u;
}

__device__ __forceinline__ void xcd_barrier(const XcdBarrier& b) {
    asm volatile("s_waitcnt vmcnt(0)" ::: "memory");
    __syncthreads();
    if (threadIdx.x == 0) {
        unsigned* bar = b.bar;
        __builtin_amdgcn_s_waitcnt(0);
        unsigned nloc = b.st[0], nx = b.st[1];
        if (nloc == 0u) { xcd_barrier_complete(bar, b.x, nloc, nx); b.st[0] = nloc; b.st[1] = nx; }
        const unsigned old = xb_add(&bar[XB_XSUB(b.x)], 1u);
        const unsigned gen = old / nloc;
        if (old + 1u == (gen + 1u) * nloc) {
            __builtin_amdgcn_fence(__ATOMIC_RELEASE, "agent");
            asm volatile("s_waitcnt vmcnt(0)" ::: "memory");
            const unsigned og = xb_add(&bar[XB_TOP], 1u);
            const unsigned tg = og / nx;
            if (og + 1u == (tg + 1u) * nx) xb_add(&bar[XB_TOPGEN], 1u);
            else XB_SPIN(xb_ld(&bar[XB_TOPGEN]) == tg, bar);
            __builtin_amdgcn_fence(__ATOMIC_ACQUIRE, "agent");
            xb_add(&bar[XB_XGEN(b.x)], 1u);
            asm volatile("s_waitcnt vmcnt(0)" ::: "memory");
        } else {
            XB_SPIN(xb_ld(&bar[XB_XGEN(b.x)]) == gen, bar);
            __builtin_amdgcn_fence(__ATOMIC_ACQUIRE, "agent");
            asm volatile("s_waitcnt vmcnt(0)" ::: "memory");
        }
    }
    __syncthreads();
}


__device__ __forceinline__ void p0_phase(LAS unsigned char* lds, int gg, int NGW) {
    int tq = threadIdx.x; asm volatile("" : "+v"(tq));
    const int lane = tq & 63, wave = __builtin_amdgcn_readfirstlane(tq >> 6), gw = blockIdx.x * NWV + wave;
    LAS float* scr = (LAS float*)(lds + LDS_PH + wave * 16896);
    unsigned char* wsb = (unsigned char*)tptr(lds, T_WS);
    bf16* WA = (bf16*)(wsb + WS_W + W_WINA); const float* win = tptr(lds, T_WIN);
    transpose_job(win, 21056, 0, 12288, DM, WA, 0, scr, gw, NGW, lane);
    transpose_job(win, 21056, 14400, 512, DM, WA, 12288, scr, gw, NGW, lane);
    transpose_job(win, 21056, 14336, 64, DM, WA, 12800, scr, gw, NGW, lane);
    transpose_job(tptr(lds, T_WMKV), 1024, 0, 1024, DM, (bf16*)(wsb + WS_W + W_WMKV), 0, scr, gw, NGW, lane);
    { const float* x = tptr(lds, T_X0 + gg); const float* gm = tptr(lds, T_GMIX); bf16* h = (bf16*)(wsb + WS_H);
      for (int m = gw; m < TG; m += NGW) rms_row(x + (size_t)m * DM, gm, h + (size_t)m * DM, lane); }
    { const int nmem = (gg ? 2 : 4) * 256; const float* mx = tptr(lds, T_MEM0 + gg); const float* gm = tptr(lds, T_GMEM); bf16* mn = (bf16*)(wsb + WS_MEMN);
      for (int m = gw; m < nmem; m += NGW) rms_row(mx + (size_t)m * DM, gm, mn + (size_t)m * DM, lane); }
}
__global__ void __launch_bounds__(NTHR, 2) hybrid_fwd(Params P) {
    extern __shared__ __attribute__((aligned(16))) unsigned char lds_raw[];
    cg::grid_group grid = cg::this_grid();
    LAS unsigned char* lds = (LAS unsigned char*)lds_raw;
    const int NGW = gridDim.x * NWV;
    if (threadIdx.x == 0) {
        LAS unsigned long long* t = (LAS unsigned long long*)(lds + LDS_TBL);
        t[T_X0] = (unsigned long long)P.x[0];
        t[T_X1] = (unsigned long long)P.x[1];
        t[T_MEM0] = (unsigned long long)P.mem[0];
        t[T_MEM1] = (unsigned long long)P.mem[1];
        t[T_OUT0] = (unsigned long long)P.out[0];
        t[T_OUT1] = (unsigned long long)P.out[1];
        t[T_GMIX] = (unsigned long long)P.g_mix;
        t[T_GMEM] = (unsigned long long)P.g_mem;
        t[T_WIN] = (unsigned long long)P.w_in;
        t[T_BGATE] = (unsigned long long)P.b_gate;
        t[T_DAQN] = (unsigned long long)P.da_q_norm;
        t[T_DAKN] = (unsigned long long)P.da_k_norm;
        t[T_DALAM] = (unsigned long long)P.da_lambda;
        t[T_DASUB] = (unsigned long long)P.da_subln;
        t[T_GCONV] = (unsigned long long)P.gdn_conv_w;
        t[T_GALOG] = (unsigned long long)P.gdn_A_log;
        t[T_GDT] = (unsigned long long)P.gdn_dt_bias;
        t[T_GON] = (unsigned long long)P.gdn_out_norm;
        t[T_XQN] = (unsigned long long)P.xa_q_norm;
        t[T_XKN] = (unsigned long long)P.xa_k_norm;
        t[T_WMKV] = (unsigned long long)P.w_mem_kv;
        t[T_PA] = (unsigned long long)P.p_attn;
        t[T_PD] = (unsigned long long)P.p_gdn;
        t[T_PM] = (unsigned long long)P.p_mem;
        t[T_WO] = (unsigned long long)P.w_o;
        t[T_GFFN] = (unsigned long long)P.g_ffn;
        t[T_WUP] = (unsigned long long)P.w_up;
        t[T_FCW] = (unsigned long long)P.ffn_conv_w;
        t[T_FCB] = (unsigned long long)P.ffn_conv_b;
        t[T_WDOWN] = (unsigned long long)P.w_down;
        t[T_WS] = (unsigned long long)P.ws;
    }
    if (threadIdx.x == 0) { ((LAS unsigned*)(lds + 272))[0] = 0u; ((LAS unsigned*)(lds + 272))[1] = 0u; }
    __syncthreads();
#define TP(i) tptr(lds, i)
    const XcdBarrier xbar = xcd_barrier_post((unsigned*)(P.ws + WS_CTL) + 1024, (volatile LAS unsigned*)(lds + 272));
#define GSYNC() xcd_barrier(xbar)
#define WSB ((unsigned char*)TP(T_WS))
#define H ((bf16*)(WSB + WS_H))
#define AB ((float*)(WSB + WS_AB))
#define MEMN ((bf16*)(WSB + WS_MEMN))
#define MEMKV ((bf16*)(WSB + WS_MEMKV))
#define COUT ((bf16*)(WSB + WS_COUT))
#define GDNB ((bf16*)(WSB + WS_GDNB))
#define RW (WSB + WS_W)
#define PROJ ((bf16*)(WSB + WS_BIG))
#define HALO ((bf16*)(WSB + WS_HALO))
#define SSQ ((float*)(WSB + WS_SSQ))
#define ZB ((bf16*)(WSB + WS_BIG))
#define GATES (ZB + (size_t)TG * DM)
#define GT ((bf16*)(WSB + WS_BIG))
#define UP (GT + (size_t)TG * DFF)
#define WDN ((bf16*)(WSB + WS_BIG + (size_t)369098752))
#define PHASE_IDS() int tq = threadIdx.x; asm volatile("" : "+v"(tq));   \
    const int tid = tq, lane = tid & 63, wave = __builtin_amdgcn_readfirstlane(tid >> 6), gw = blockIdx.x * NWV + wave; \
    LAS float* scr = (LAS float*)(lds + LDS_PH + wave * 16896); (void)lane; (void)gw; (void)scr; (void)tid
#pragma unroll 1
    for (int g = 0; g < 2; ++g) {
        const int B = g ? 2 : 4, S = g ? 8192 : 4096, NMEM = B * 256;

#define X (TP(T_X0 + g))
#define OUT ((float*)TP(T_OUT0 + g))
#define MEMX (TP(T_MEM0 + g))
#define GDNF ((bf16*)OUT)
#define AOUT (GDNF + (size_t)TG * DM)
        p0_phase(lds, g, NGW);
        GSYNC();
        if (gridDim.x == 0x7fffffffu) grid.sync();
#ifndef GEMM_REPS
#define GEMM_REPS 1
#endif
        for (int rp = 0; rp < GEMM_REPS; ++rp)
        { pg8::Gemm gm{H, (const bf16*)(RW + W_WINA), TG, NP1, DM}; pg8::StaticOrder So; So.init(TG, NP1, (int)gridDim.x, (int)blockIdx.x);
          EpiP1 Ep{PROJ, AB, TP(T_DAQN), TP(T_DAKN), TP(T_XQN), (LAS float*)(lds + LDS_PH + 131072), HALO};
          pg8::gemm_phase<EpiP1, pg8::StaticOrder, true, true>(lds + LDS_PH, gm, So, Ep); }
        GSYNC();
#ifndef P3_GDN_ONLY
#define P3_GDN_ONLY 0
#endif
        {
            { pg8::Gemm gm{MEMN, (const bf16*)(RW + W_WMKV), 1024, 1024, DM}; pg8::StaticOrder So; So.init(1024, 1024, (int)gridDim.x, (int)blockIdx.x);
              EpiMKV Ep{MEMKV, TP(T_XKN), (LAS float*)(lds + LDS_PH + 131072)};
              pg8::gemm_phase<EpiMKV, pg8::StaticOrder, true, true>(lds + LDS_PH, gm, So, Ep); }
            PHASE_IDS();
            volatile LAS unsigned* wq = (volatile LAS unsigned*)(lds + LDS_WQ);
            for (;;) {
                __syncthreads();
                if (tid == 0) wq[0] = atomicAdd((unsigned*)(WSB + WS_CTL) + 64 * g + 48, 1u);
                __syncthreads();
                const int ck = (int)wq[0];
                if (ck >= 256 * 768 / NTHR) break;
                const int it = ck * NTHR + tid;
                gdn_conv_item(PROJ, HALO, TP(T_GCONV), S, it / 768, it % 768, 0);
            }
        }
        GSYNC();
#ifndef P3_REPS
#define P3_REPS 1
#endif
        for (int rep = 0; rep < P3_REPS; ++rep) {
            PHASE_IDS();
            const int nG = B * 32, nA = B * 16 * (S / 256), nX = B * 4 * (S / 256), total = (rep > 0 && P3_GDN_ONLY) ? nG : nG + nA + nX;
            volatile LAS unsigned* wq = (volatile LAS unsigned*)(lds + LDS_WQ);
            for (;;) {
                __syncthreads();
                if (tid == 0) wq[0] = atomicAdd((unsigned*)(WSB + WS_CTL) + 64 * g + 16 * rep, 1u);
                __syncthreads();
                const int item = (int)wq[0];
                if (item >= total) break;
#ifndef NO_GDN
                if (item < nG) { const int dir = item & 1, h = (item >> 1) & 15, bl = item >> 5;
                    if (dir) gdn::gdn_unit<1>(TP(T_GALOG), TP(T_GDT), S, bl * S, h, PROJ, AB, GDNB, (LAS char*)lds + LDS_PH); else gdn::gdn_unit<0>(TP(T_GALOG), TP(T_GDT), S, bl * S, h, PROJ, AB, GDNF, (LAS char*)lds + LDS_PH);
                } else
#endif
#ifndef NO_DATT
                if (item < nG + nA) { const int u = item - nG, lq = g ? 5 : 4, lb = g ? 1 : 2, qb = u & ((1 << lq) - 1), bl = (u >> lq) & (B - 1), hv = u >> (lq + lb), h = 7 - (hv >> 1), vh = hv & 1;
                    diffattn_unit(TP(T_DALAM), TP(T_DAQN), TP(T_DAKN), S, bl * S, h, qb, vh, PROJ, AOUT, SSQ, (char*)lds_raw + LDS_PH);
                } else
#endif
#ifndef NO_XATT
                if (item >= nG + nA) { const int u = item - nG - nA, lq = g ? 5 : 4, qb = u & ((1 << lq) - 1), xh = (u >> lq) & 3, bl = u >> (lq + 2);
                    xattn_unit(bl * S, bl, xh, qb, PROJ, MEMKV, COUT, (char*)lds_raw + LDS_PH); }
#endif
                {}
            }
            if (rep == 0) {
                constexpr int NSL = 128;
                for (;;) {
                    __syncthreads();
                    if (tid == 0) wq[0] = atomicAdd((unsigned*)(WSB + WS_CTL) + 64 * g + 32, 1u);
                    __syncthreads();
                    const int sl = (int)wq[0];
                    if (sl >= NSL) break;
                    const int gw = sl * NWV + wave; const int NGW = NSL * NWV;
                    transpose_job(TP(T_WIN), 21056, 12288, 2048, DM, (bf16*)(RW + W_WINB), 0, scr, gw, NGW, lane);
                    transpose_job(TP(T_WIN), 21056, 14912, 6144, DM, (bf16*)(RW + W_WINB), 2048, scr, gw, NGW, lane);
                    transpose_job(TP(T_PA), DM, 0, DM, DM, (bf16*)(RW + W_PA), 0, scr, gw, NGW, lane);
                    transpose_job(TP(T_PD), DM, 0, DM, DM, (bf16*)(RW + W_PD), 0, scr, gw, NGW, lane);
                    transpose_job(TP(T_PM), DM, 0, DM, 512, (bf16*)(RW + W_PM), 0, scr, gw, NGW, lane);
                    transpose_job(TP(T_WO), DM, 0, DM, DM, (bf16*)(RW + W_WO), 0, scr, gw, NGW, lane);
                }
            }
            if (rep + 1 < P3_REPS) GSYNC();
        }
        GSYNC();
        for (int rp = 0; rp < GEMM_REPS; ++rp)
        run_gemm_l(lds + LDS_PH, H, (const bf16*)(RW + W_WINB), TG, NP1B, DM, F_P1b{ZB, GATES, TP(T_BGATE)});
        GSYNC();
        {
            PHASE_IDS();
            const int l16 = lane & 15, sub = lane >> 4; const float* gon = TP(T_GON);
            { bf16* gf = GDNF; const bf16* gb = GDNB; const bf16* zb = ZB;
              for (int it0 = gw; it0 < TG * 4; it0 += 4 * NGW) {
                size_t off[4]; u32x4 ra[4], rb[4], rz[4];
#pragma unroll
                for (int u = 0; u < 4; ++u) { const int it = it0 + u * NGW, row = it >> 2, hd = (it & 3) * 4 + sub; off[u] = (size_t)row * DM + hd * 128 + l16 * 8;
                    ra[u] = *(const u32x4*)(gf + off[u]); rb[u] = *(const u32x4*)(gb + off[u]); rz[u] = *(const u32x4*)(zb + off[u]); }
#pragma unroll
                for (int u = 0; u < 4; ++u) { float a[8], b[8], z[8]; unpack8(ra[u], a); unpack8(rb[u], b); unpack8(rz[u], z);
                    float ss = 0.f;
#pragma unroll
                    for (int e = 0; e < 8; ++e) { a[e] += b[e]; ss += a[e] * a[e]; }
                    ss += __shfl_xor(ss, 1); ss += __shfl_xor(ss, 2); ss += __shfl_xor(ss, 4); ss += __shfl_xor(ss, 8);
                    const float inv = rsq_(ss * (1.f / 128.f) + EPS);
#pragma unroll
                    for (int e = 0; e < 8; ++e) a[e] = a[e] * inv * gon[l16 * 8 + e] * (z[e] * sigmoidf_(z[e]));
                    *(u32x4*)(gf + off[u]) = pack8(a); } } }
        }
        {
            PHASE_IDS();
            const int l32 = lane & 31, sub = lane >> 5; const float* subln = TP(T_DASUB);
            { bf16* ao = AOUT; const float* sq = SSQ; const f32x4 g0 = *(const f32x4*)(subln + l32 * 8), g1 = *(const f32x4*)(subln + l32 * 8 + 4);
              for (int it0 = gw; it0 < TG * 4; it0 += 8 * NGW) {
                bf16* ap[8]; u32x4 ra[8]; float t0[8], t1[8];
#pragma unroll
                for (int u = 0; u < 8; ++u) { const int it = it0 + u * NGW, row = it >> 2, hd = (it & 3) * 2 + sub; ap[u] = ao + (size_t)row * DM + hd * 256 + l32 * 8;
                    ra[u] = *(const u32x4*)ap[u]; t0[u] = sq[(size_t)row * 16 + hd * 2]; t1[u] = sq[(size_t)row * 16 + hd * 2 + 1]; }
#pragma unroll
                for (int u = 0; u < 8; ++u) { float a[8]; unpack8(ra[u], a);
                    const float rinv = (rsq_((t0[u] + t1[u]) * (1.f / 256.f) + EPS)) * 0.8f;
#pragma unroll
                    for (int e = 0; e < 4; ++e) { a[e] *= rinv * g0[e]; a[4 + e] *= rinv * g1[e]; }
                    *(u32x4*)ap[u] = pack8(a); } } }
        }
        GSYNC();
        for (int rp = 0; rp < GEMM_REPS; ++rp) {
        run_gemm_l(lds + LDS_PH, AOUT, (const bf16*)(RW + W_PA), TG, DM, DM, F_Merge{GATES, H, 1});
        run_gemm_l(lds + LDS_PH, GDNF, (const bf16*)(RW + W_PD), TG, DM, DM, F_Merge{GATES + DM, H, 0});
        run_gemm_l(lds + LDS_PH, COUT, (const bf16*)(RW + W_PM), TG, DM, 512, F_Merge{GATES + 2 * DM, H, 0}); }
        GSYNC();
        for (int rp = 0; rp < GEMM_REPS; ++rp)
        run_gemm_l(lds + LDS_PH, H, (const bf16*)(RW + W_WO), TG, DM, DM, F_Wo{X, OUT});
        GSYNC();
        {
            PHASE_IDS();
            for (int m = gw; m < TG; m += NGW) rms_row(OUT + (size_t)m * DM, TP(T_GFFN), H + (size_t)m * DM, lane);
            transpose_job(TP(T_WUP), 2 * DFF, 0, 2 * DFF, DM, (bf16*)(RW + W_UP), 0, scr, gw, NGW, lane);
            transpose_job(TP(T_WDOWN), DM, 0, DM, DFF, WDN, 0, scr, gw, NGW, lane);
        }
        GSYNC();
        for (int rp = 0; rp < GEMM_REPS; ++rp)
        run_gemm(lds + LDS_PH, H, (const bf16*)(RW + W_UP), TG, 2 * DFF, DM, F_Up{GT, UP});
        GSYNC();
        {
            PHASE_IDS();
            const int ncg = DFF / 8;
            const float* fcw = TP(T_FCW); const float* fcb = TP(T_FCB); const bf16* gt = GT; bf16* up = UP;
            for (int it = blockIdx.x * NTHR + tid; it < (TG / 8) * ncg; it += gridDim.x * NTHR) { const int run = it / ncg, c0 = (it - run * ncg) * 8, row0 = run * 8, t0 = row0 & (S - 1);
                u32x4 g[10], uu[8];
                const u32x4 zero4 = (u32x4){0u, 0u, 0u, 0u};
#pragma unroll
                for (int r = 0; r < 10; ++r) { const int tt = t0 + r - 1; g[r] = (tt >= 0 && tt < S) ? *(const u32x4*)(gt + (size_t)(row0 + r - 1) * DFF + c0) : zero4; }
#pragma unroll
                for (int r = 0; r < 8; ++r) uu[r] = *(const u32x4*)(up + (size_t)(row0 + r) * DFF + c0);
                f32x4 w[3][2];
#pragma unroll
                for (int j = 0; j < 3; ++j) { w[j][0] = *(const f32x4*)(fcw + j * DFF + c0); w[j][1] = *(const f32x4*)(fcw + j * DFF + c0 + 4); }
                const f32x4 b0 = *(const f32x4*)(fcb + c0), b1 = *(const f32x4*)(fcb + c0 + 4);
#pragma unroll
                for (int r = 0; r < 8; ++r) { float acc[8], u[8], xv[8];
#pragma unroll
                    for (int e = 0; e < 4; ++e) { acc[e] = b0[e]; acc[4 + e] = b1[e]; }
#pragma unroll
                    for (int j = 0; j < 3; ++j) { unpack8(g[r + j], xv);
#pragma unroll
                        for (int e = 0; e < 4; ++e) { acc[e] = fmaf(w[j][0][e], xv[e], acc[e]); acc[4 + e] = fmaf(w[j][1][e], xv[4 + e], acc[4 + e]); } }
                    unpack8(uu[r], u);
#pragma unroll
                    for (int e = 0; e < 8; ++e) u[e] *= acc[e] * sigmoidf_(acc[e]);
                    *(u32x4*)(up + (size_t)(row0 + r) * DFF + c0) = pack8(u); } }
        }
        GSYNC();
        run_gemm_l(lds + LDS_PH, UP, (const bf16*)WDN, TG, DM, DFF, F_Down{OUT});
        GSYNC();
    }
}

extern "C" void kernel_launch(void* const* d_in, const int* in_sizes, int n_in, void* d_out, int out_size, void* d_ws, size_t ws_size, hipStream_t stream) {
    static int grid_blocks = 0;
    if (grid_blocks == 0) {
        if (n_in != 28 || ws_size < WS_END || out_size != 2 * TG * DM) { fprintf(stderr, "kernel_launch: unexpected shapes: n_in %d out %d ws %zu (need %zu)\n", n_in, out_size, ws_size, (size_t)WS_END); grid_blocks = -1; return; }
        int dev = 0, cus = 0, per_cu = 0;
        hipGetDevice(&dev); hipDeviceGetAttribute(&cus, hipDeviceAttributeMultiprocessorCount, dev);
        if (hipFuncSetAttribute((const void*)hybrid_fwd, hipFuncAttributeMaxDynamicSharedMemorySize, LDS_BYTES) != hipSuccess) { fprintf(stderr, "kernel_launch: hipFuncSetAttribute failed\n"); grid_blocks = -1; return; }
        if (hipOccupancyMaxActiveBlocksPerMultiprocessor(&per_cu, (const void*)hybrid_fwd, NTHR, LDS_BYTES) != hipSuccess || per_cu < 1) { fprintf(stderr, "kernel_launch: occupancy query gave %d\n", per_cu); per_cu = 1; }
        (void)hipGetLastError();
        grid_blocks = cus * 1;
        fprintf(stderr, "kernel_launch: grid %d (cus %d, per_cu %d), ws %zu need %zu\n", grid_blocks, cus, per_cu, ws_size, (size_t)WS_END);
    }
    if (grid_blocks < 0) return;
    hipMemsetAsync((char*)d_ws + WS_CTL, 0, 65536, stream);
    Params p{};
    const float* const* in = (const float* const*)d_in;
    p.x[0] = in[0]; p.x[1] = in[1]; p.mem[0] = in[2]; p.mem[1] = in[3]; p.out[0] = (float*)d_out; p.out[1] = (float*)d_out + (size_t)TG * DM;
    p.g_mix = in[4]; p.g_mem = in[5]; p.w_in = in[6]; p.b_gate = in[7]; p.da_q_norm = in[8]; p.da_k_norm = in[9]; p.da_lambda = in[10]; p.da_subln = in[11];
    p.gdn_conv_w = in[12]; p.gdn_A_log = in[13]; p.gdn_dt_bias = in[14]; p.gdn_out_norm = in[15]; p.xa_q_norm = in[16]; p.xa_k_norm = in[17]; p.w_mem_kv = in[18];
    p.p_attn = in[19]; p.p_gdn = in[20]; p.p_mem = in[21]; p.w_o = in[22]; p.g_ffn = in[23]; p.w_up = in[24]; p.ffn_conv_w = in[25]; p.ffn_conv_b = in[26]; p.w_down = in[27];
    p.ws = (unsigned char*)d_ws;
    void* args[] = {&p};
    hipError_t e = hipLaunchCooperativeKernel((const void*)hybrid_fwd, dim3(grid_blocks), dim3(NTHR), args, LDS_BYTES, stream);
    if (e != hipSuccess) fprintf(stderr, "cooperative launch failed: %s (grid %d)\n", hipGetErrorString(e), grid_blocks);
}
```
